# Optimizing an MI355X kernel written in HIP

```python
import math
import jax, jax.numpy as jnp
from jax import lax
import numpy as np

D_MODEL = 2048
BATCH = 2
SEQ = 4096
DEPTH = 2

GRID_W = 64
CTX_LEN = 256
N_MIXERS = 2
MIXER_S5 = 0
MIXER_POOL = 1
S5_GROUP = 16
S5_GROUPS = D_MODEL // S5_GROUP
S5_STATE = 64
S5_DT_MIN = 0.001
S5_DT_MAX = 0.1
POOL_WINDOWS = (2, 4, 8, 16)
POOL_GROUPS = len(POOL_WINDOWS)
POOL_CH = D_MODEL // POOL_GROUPS
D_FF = ((8 * D_MODEL // 3 + 255) // 256) * 256
N_MOD = 6
RMS_EPS = 1e-6
POS_BASE = 10000.0
N_S5_LAYERS = (DEPTH + 1) // 2
N_POOL_LAYERS = DEPTH // 2

kernel_name = "hybrid_s5_pool_convffn_dit"


def _rmsnorm(x, g):
    xf = x.astype(jnp.float32)
    y = xf * lax.rsqrt(jnp.mean(xf * xf, axis=-1, keepdims=True) + RMS_EPS)
    return (y * g.astype(jnp.float32)).astype(x.dtype)


def _modulate(xn, shift, scale):
    return xn * (1 + scale) + shift


def _grid_pos_emb(n_tokens, dim):
    rows = n_tokens // GRID_W
    r, col = jnp.meshgrid(jnp.arange(rows, dtype=jnp.float32),
                          jnp.arange(GRID_W, dtype=jnp.float32), indexing="ij")
    quarter = dim // 4
    omega = 1.0 / (POS_BASE ** (jnp.arange(quarter, dtype=jnp.float32) / quarter))

    def enc(p):
        ang = p.reshape(-1, 1) * omega[None, :]
        return jnp.concatenate([jnp.sin(ang), jnp.cos(ang)], axis=-1)

    return jnp.concatenate([enc(r), enc(col)], axis=-1)


def _ssm_combine(e1, e2):
    a1r, a1i, b1r, b1i = e1
    a2r, a2i, b2r, b2i = e2
    return (a2r * a1r - a2i * a1i,
            a2r * a1i + a2i * a1r,
            a2r * b1r - a2i * b1i + b2r,
            a2r * b1i + a2i * b1r + b2i)


def _s5_discretize(lam_re, lam_im, log_step, b_re, b_im):
    f32 = jnp.float32
    lam_re, lam_im = lam_re.astype(f32), lam_im.astype(f32)
    b_re, b_im = b_re.astype(f32), b_im.astype(f32)
    dt = jnp.exp(log_step.astype(f32))[:, None]
    mag = jnp.exp(lam_re * dt)
    abar_re = mag * jnp.cos(lam_im * dt)
    abar_im = mag * jnp.sin(lam_im * dt)
    nr, ni = abar_re - 1.0, abar_im
    den = lam_re * lam_re + lam_im * lam_im
    fr = (nr * lam_re + ni * lam_im) / den
    fi = (ni * lam_re - nr * lam_im) / den
    bbar_re = fr[..., None] * b_re - fi[..., None] * b_im
    bbar_im = fr[..., None] * b_im + fi[..., None] * b_re
    return abar_re, abar_im, bbar_re, bbar_im


def _s5_states(u_g, abar_re, abar_im, bbar_re, bbar_im, reverse, h0=None):
    b_re = jnp.einsum("blgc,gpc->blgp", u_g, bbar_re)
    b_im = jnp.einsum("blgc,gpc->blgp", u_g, bbar_im)
    if h0 is not None:
        h0_re, h0_im = h0
        first = -1 if reverse else 0
        b_re = b_re.at[:, first].add(abar_re * h0_re - abar_im * h0_im)
        b_im = b_im.at[:, first].add(abar_re * h0_im + abar_im * h0_re)
    a_re = jnp.broadcast_to(abar_re, b_re.shape)
    a_im = jnp.broadcast_to(abar_im, b_im.shape)
    _, _, h_re, h_im = lax.associative_scan(_ssm_combine, (a_re, a_im, b_re, b_im),
                                            reverse=reverse, axis=1)
    return h_re, h_im


def _s5_readout(h_re, h_im, c_re, c_im):
    return (jnp.einsum("blgp,gcp->blgc", h_re, c_re.astype(jnp.float32))
            - jnp.einsum("blgp,gcp->blgc", h_im, c_im.astype(jnp.float32)))


def _s5_glu(y, glu_w, dtype):
    z = jax.nn.gelu(y).astype(dtype)
    val, gate = jnp.split(z @ glu_w, 2, axis=-1)
    return val * jax.nn.sigmoid(gate)


def _s5_mixer(u, u_c, lam_re, lam_im, log_step, b_re, b_im, c_re, c_im, d_skip, glu_w,
              with_ctx_out):
    bsz, n_lat, dim = u.shape
    n_ctx = u_c.shape[1]
    u_g = u.astype(jnp.float32).reshape(bsz, n_lat, S5_GROUPS, S5_GROUP)
    uc_g = u_c.astype(jnp.float32).reshape(bsz, n_ctx, S5_GROUPS, S5_GROUP)
    dsk = d_skip.astype(jnp.float32).reshape(S5_GROUPS, S5_GROUP)
    y = u_g * dsk
    y_c = uc_g * dsk if with_ctx_out else None
    for direction, rev in ((0, False), (1, True)):
        disc = _s5_discretize(lam_re[direction], lam_im[direction], log_step[direction],
                              b_re[direction], b_im[direction])
        hc_re, hc_im = _s5_states(uc_g, *disc, reverse=rev)
        end = 0 if rev else -1
        h_re, h_im = _s5_states(u_g, *disc, reverse=rev, h0=(hc_re[:, end], hc_im[:, end]))
        y = y + _s5_readout(h_re, h_im, c_re[direction], c_im[direction])
        if with_ctx_out:
            y_c = y_c + _s5_readout(hc_re, hc_im, c_re[direction], c_im[direction])
    out = _s5_glu(y.reshape(bsz, n_lat, dim), glu_w, u.dtype)
    out_c = _s5_glu(y_c.reshape(bsz, n_ctx, dim), glu_w, u.dtype) if with_ctx_out else None
    return out, out_c


def _pool_mixer(u, w, scale):
    bsz, n_tok, dim = u.shape
    uf = u.astype(jnp.float32)
    csum = jnp.concatenate([jnp.zeros((bsz, 1, dim), jnp.float32),
                            jnp.cumsum(uf, axis=1)], axis=1)
    t = jnp.arange(n_tok)
    groups = []
    for g, win in enumerate(POOL_WINDOWS):
        lo = jnp.clip(t - win // 2, 0, n_tok - 1)
        hi = jnp.clip(t + win // 2 - 1, 0, n_tok - 1)
        ch = slice(g * POOL_CH, (g + 1) * POOL_CH)
        cs = csum[:, :, ch]
        cnt = (hi - lo + 1).astype(jnp.float32)[None, :, None]
        groups.append((cs[:, hi + 1] - cs[:, lo]) / cnt - uf[:, :, ch])
    p = jnp.stack(groups, axis=2).astype(u.dtype)
    y = jnp.einsum("blgc,gcd->blgd", p, w).reshape(bsz, n_tok, dim)
    return y * scale


def _conv_ffn(u, up, conv, conv_b, down):
    h = u @ up
    hp = jnp.pad(h, ((0, 0), (1, 1), (0, 0)))
    h = hp[:, :-2] * conv[0] + hp[:, 1:-1] * conv[1] + hp[:, 2:] * conv[2] + conv_b
    val, gate = jnp.split(h, 2, axis=-1)
    return (jax.nn.silu(gate) * val) @ down


def setup_inputs(seed: int = 0) -> dict:
    key = jax.random.key(seed)
    ks = jax.random.split(key, 24)
    f32 = jnp.float32
    nrm = lambda k, shp: jax.random.normal(k, shp, f32)
    G, P, C = S5_GROUPS, S5_STATE, S5_GROUP
    s5_lam_re = -0.5 + 0.01 * nrm(ks[5], (N_S5_LAYERS, 2, G, P))
    s5_lam_im = math.pi * jnp.arange(P, dtype=f32) + 0.01 * nrm(ks[6], (N_S5_LAYERS, 2, G, P))
    s5_log_step = jax.random.uniform(ks[7], (N_S5_LAYERS, 2, G), f32,
                                     math.log(S5_DT_MIN), math.log(S5_DT_MAX))
    ffn_conv = 0.3 * nrm(ks[18], (DEPTH, 3, 2 * D_FF))
    ffn_conv = ffn_conv.at[:, 1].add(1.0)
    return {
        "x": nrm(ks[0], (BATCH, SEQ, D_MODEL)),
        "c": nrm(ks[1], (BATCH, D_MODEL)),
        "ctx": nrm(ks[2], (BATCH, CTX_LEN, D_MODEL)),
        "c_ctx": nrm(ks[3], (D_MODEL,)),
        "ada_w": 0.5 * D_MODEL ** -0.5 * nrm(ks[4], (DEPTH, D_MODEL, N_MOD * D_MODEL)),
        "ada_b": 0.01 * nrm(ks[8], (DEPTH, N_MOD * D_MODEL)),
        "norm_g": 1.0 + 0.05 * nrm(ks[9], (DEPTH, 4, D_MODEL)),
        "s5_lam_re": s5_lam_re,
        "s5_lam_im": s5_lam_im,
        "s5_log_step": s5_log_step,
        "s5_b_re": (2 * C) ** -0.5 * nrm(ks[10], (N_S5_LAYERS, 2, G, P, C)),
        "s5_b_im": (2 * C) ** -0.5 * nrm(ks[11], (N_S5_LAYERS, 2, G, P, C)),
        "s5_c_re": P ** -0.5 * nrm(ks[12], (N_S5_LAYERS, 2, G, C, P)),
        "s5_c_im": P ** -0.5 * nrm(ks[13], (N_S5_LAYERS, 2, G, C, P)),
        "s5_d": nrm(ks[14], (N_S5_LAYERS, D_MODEL)),
        "s5_glu_w": D_MODEL ** -0.5 * nrm(ks[15], (N_S5_LAYERS, D_MODEL, 2 * D_MODEL)),
        "pool_w": POOL_CH ** -0.5 * nrm(ks[16], (N_POOL_LAYERS, POOL_GROUPS, POOL_CH, POOL_CH)),
        "pool_scale": 1.0 + 0.1 * nrm(ks[17], (N_POOL_LAYERS, D_MODEL)),
        "ffn_up": D_MODEL ** -0.5 * nrm(ks[19], (DEPTH, D_MODEL, 2 * D_FF)),
        "ffn_conv": ffn_conv,
        "ffn_conv_b": 0.01 * nrm(ks[20], (DEPTH, 2 * D_FF)),
        "ffn_down": D_FF ** -0.5 * nrm(ks[21], (DEPTH, D_FF, D_MODEL)),
    }


def reference(x, c, ctx, c_ctx, ada_w, ada_b, norm_g, s5_lam_re, s5_lam_im, s5_log_step,
              s5_b_re, s5_b_im, s5_c_re, s5_c_im, s5_d, s5_glu_w, pool_w, pool_scale,
              ffn_up, ffn_conv, ffn_conv_b, ffn_down):
    n_lat = x.shape[1]
    x = x + _grid_pos_emb(n_lat, D_MODEL).astype(x.dtype)[None]
    cond = jax.nn.silu(c)
    cond_ctx = jax.nn.silu(c_ctx)
    h_ctx = ctx
    for i in range(DEPTH):
        kind = i % N_MIXERS
        k = i // N_MIXERS
        ctx_read = kind == MIXER_S5
        ctx_later = any(j % N_MIXERS == MIXER_S5 for j in range(i + 1, DEPTH))
        mod = jnp.split((cond @ ada_w[i] + ada_b[i])[:, None, :], N_MOD, axis=-1)
        u = _modulate(_rmsnorm(x, norm_g[i, 0]), mod[0], mod[1])
        if ctx_read or ctx_later:
            mod_c = jnp.split(cond_ctx @ ada_w[i] + ada_b[i], N_MOD)
            u_c = _modulate(_rmsnorm(h_ctx, norm_g[i, 0]), mod_c[0], mod_c[1])
        if kind == MIXER_S5:
            y, y_c = _s5_mixer(u, u_c, s5_lam_re[k], s5_lam_im[k], s5_log_step[k],
                               s5_b_re[k], s5_b_im[k], s5_c_re[k], s5_c_im[k],
                               s5_d[k], s5_glu_w[k], ctx_later)
        else:
            y = _pool_mixer(u, pool_w[k], pool_scale[k])
            y_c = _pool_mixer(u_c, pool_w[k], pool_scale[k]) if ctx_later else None
        x = x + mod[2] * _rmsnorm(y, norm_g[i, 1])
        f = _conv_ffn(_modulate(_rmsnorm(x, norm_g[i, 2]), mod[3], mod[4]),
                      ffn_up[i], ffn_conv[i], ffn_conv_b[i], ffn_down[i])
        x = x + mod[5] * _rmsnorm(f, norm_g[i, 3])
        if ctx_later:
            h_ctx = h_ctx + mod_c[2] * _rmsnorm(y_c, norm_g[i, 1])
            fc = _conv_ffn(_modulate(_rmsnorm(h_ctx, norm_g[i, 2]), mod_c[3], mod_c[4]),
                           ffn_up[i], ffn_conv[i], ffn_conv_b[i], ffn_down[i])
            h_ctx = h_ctx + mod_c[5] * _rmsnorm(fc, norm_g[i, 3])
    return x
```

```cpp
#include <hip/hip_runtime.h>
#include <cstdio>
#include <cstdint>

#ifndef MK_N_LAUNCHES
#define MK_N_LAUNCHES 0
#endif

namespace pg8 {
#define PG8_LAS __attribute__((address_space(3)))
typedef unsigned short bf16_t;
typedef short bf16x8 __attribute__((ext_vector_type(8)));
typedef float f32x4 __attribute__((ext_vector_type(4)));
typedef float f32x16 __attribute__((ext_vector_type(16)));
typedef unsigned u32x4 __attribute__((ext_vector_type(4)));
typedef unsigned u32x2 __attribute__((ext_vector_type(2)));
constexpr int BM = 256, BK = 64, HALF = 128, HTB = HALF * BK * 2  , STAGE_BYTES = 8 * HTB, NXCD = 8, WGM = 8;

__host__ __device__ __forceinline__ int lds_byte(int r, int c) { const int st = (r >> 4) * 2 + (c >> 5), rr = r & 15, cc = c & 31, ob = rr * 64 + cc * 2; return st * 1024 + (ob ^ (((ob >> 9) & 1) << 5)); }
__host__ __device__ __forceinline__ void stage_rc(int b, int& R, int& C) { const int st = b / 1024, sb = b % 1024, swz = sb ^ (((sb >> 9) & 1) << 5); R = (st >> 1) * 16 + swz / 64; C = (st & 1) * 32 + (swz % 64) / 2; }
__host__ __device__ __forceinline__ int perm32(int rho) { const int n = rho >> 4, i = rho & 15; return 8 * (i >> 2) + 4 * n + (i & 3); }

struct Unit { int pm, pn, g; };
struct Gemm { const bf16_t* A; const bf16_t* Bt; int lda, ldb, K; size_t gsA, gsB; };

struct StaticOrder {
    int nM, nN, nwg, G, c;
    __device__ void init(int M, int N, int G_, int c_) { nM = M / BM; nN = N / BM; nwg = nM * nN; G = G_; c = c_; }
    __device__ bool next(int i, Unit& u) const {
        const long L = (long)i * G + c; if (L >= nwg) return false;
        int wgid = (int)L; { const int q = nwg / NXCD, r = nwg % NXCD, xcd = wgid % NXCD, off = wgid / NXCD; wgid = (xcd < r ? xcd * (q + 1) : r * (q + 1) + (xcd - r) * q) + off; }
        const int nig = WGM * nN, gid = wgid / nig, fm = gid * WGM, gsz = (nM - fm) < WGM ? (nM - fm) : WGM;
        u.pm = fm + ((wgid % nig) % gsz); u.pn = (wgid % nig) / gsz; u.g = 0; return true;
    }
};
struct GroupedOrder {
    int nG, nM, nN, G, c;
    __device__ void init(int nG_, int nM_, int nN_, int G_, int c_) { nG = nG_; nM = nM_; nN = nN_; G = G_; c = c_; }
    __device__ bool next(int i, Unit& u) const {
        const long L = (long)i * G + c; if (L >= (long)nG * nM * nN) return false;
        const int per = nM * nN, r = (int)(L % per); u.g = (int)(L / per); u.pn = r / nM; u.pm = r % nM; return true;
    }
};

__device__ __forceinline__ unsigned cvt_pk_bf16(float lo, float hi) { unsigned r; asm volatile("v_cvt_pk_bf16_f32 %0, %1, %2" : "=v"(r) : "v"(lo), "v"(hi)); return r; }
__device__ __forceinline__ float sigmoidf_fast(float x) { return __builtin_amdgcn_rcpf(1.0f + __builtin_amdgcn_exp2f(-1.44269504089f * x)); }
__device__ __forceinline__ float gelu_tanh(float y) { const float z = 0.7978845608f * (y + 0.044715f * y * y * y); return y * sigmoidf_fast(2.0f * z); }

struct EpiF32G {
    static constexpr bool PERM = false;
    float* C; int ldc; size_t gsC;
    __device__ __forceinline__ void operator()(const f32x4 (&acc)[2][2][4][2], const Unit& u, int wr, int wc, int fr, int fq) const {
        const int row0 = u.pm * BM + wr * 64 + fr, col0 = u.pn * BM + wc * 32 + 4 * fq; float* rowp = C + (size_t)u.g * gsC + (size_t)row0 * ldc + col0;
#pragma unroll
        for (int ai = 0; ai < 2; ++ai) {
#pragma unroll
            for (int m = 0; m < 4; ++m) {
#pragma unroll
                for (int bj = 0; bj < 2; ++bj)
#pragma unroll
                    for (int n = 0; n < 2; ++n) *(f32x4*)(rowp + bj * HALF + n * 16) = acc[ai][bj][m][n];
                asm volatile("" : "+v"(rowp)); rowp += (size_t)16 * ldc; }
            rowp += (size_t)64 * ldc; }
    }
};
struct EpiBf16G {
    static constexpr bool PERM = true;
    bf16_t* O; int ldc; size_t gsO;
    __device__ __forceinline__ void operator()(const f32x4 (&acc)[2][2][4][2], const Unit& u, int wr, int wc, int fr, int fq) const {
        const int row0 = u.pm * BM + wr * 64 + fr, col0 = u.pn * BM + wc * 32 + 8 * fq; bf16_t* rowp = O + (size_t)u.g * gsO + (size_t)row0 * ldc + col0;
#pragma unroll
        for (int ai = 0; ai < 2; ++ai) {
#pragma unroll
            for (int m = 0; m < 4; ++m) {
#pragma unroll
                for (int bj = 0; bj < 2; ++bj) { const f32x4 v0 = acc[ai][bj][m][0], v1 = acc[ai][bj][m][1];
                    u32x4 w; w.x = cvt_pk_bf16(v0[0], v0[1]); w.y = cvt_pk_bf16(v0[2], v0[3]); w.z = cvt_pk_bf16(v1[0], v1[1]); w.w = cvt_pk_bf16(v1[2], v1[3]);
                    *(u32x4*)(rowp + bj * HALF) = w; }
                asm volatile("" : "+v"(rowp)); rowp += (size_t)16 * ldc; }
            rowp += (size_t)64 * ldc; }
    }
};
struct EpiGeluZ {
    static constexpr bool PERM = true;
    bf16_t* Z;
    __device__ __forceinline__ void operator()(const f32x4 (&acc)[2][2][4][2], const Unit& u, int wr, int wc, int fr, int fq) const {
        bf16_t* rowp = Z + ((size_t)(u.pm * 4096 + (wr * 64 + fr) * 16 + 2 * wc + (fq >> 1))) * 2048 + u.g * 16 + 8 * (fq & 1);
#pragma unroll
        for (int ai = 0; ai < 2; ++ai) {
#pragma unroll
            for (int m = 0; m < 4; ++m) {
#pragma unroll
                for (int bj = 0; bj < 2; ++bj) {
                    const f32x4 v0 = acc[ai][bj][m][0], v1 = acc[ai][bj][m][1];
                    u32x4 w; w.x = cvt_pk_bf16(gelu_tanh(v0[0]), gelu_tanh(v0[1])); w.y = cvt_pk_bf16(gelu_tanh(v0[2]), gelu_tanh(v0[3]));
                    w.z = cvt_pk_bf16(gelu_tanh(v1[0]), gelu_tanh(v1[1])); w.w = cvt_pk_bf16(gelu_tanh(v1[2]), gelu_tanh(v1[3]));
                    *(u32x4*)(rowp + (size_t)bj * 8 * 2048) = w; }
                asm volatile("" : "+v"(rowp)); rowp += (size_t)16 * 16 * 2048; }
            rowp += (size_t)64 * 16 * 2048; }
    }
};
struct EpiGlu {
    static constexpr bool PERM = true;
    bf16_t* O; int ldc;
    __device__ __forceinline__ void operator()(const f32x4 (&acc)[2][2][4][2], const Unit& u, int wr, int wc, int fr, int fq) const {
        const int row0 = u.pm * BM + wr * 64 + fr, col0 = u.pn * HALF + wc * 32 + 8 * fq; bf16_t* rowp = O + (size_t)row0 * ldc + col0;
#pragma unroll
        for (int ai = 0; ai < 2; ++ai) {
#pragma unroll
            for (int m = 0; m < 4; ++m) {
                const f32x4 v0 = acc[ai][0][m][0], v1 = acc[ai][0][m][1], g0 = acc[ai][1][m][0], g1 = acc[ai][1][m][1];
                u32x4 w; w.x = cvt_pk_bf16(v0[0] * sigmoidf_fast(g0[0]), v0[1] * sigmoidf_fast(g0[1])); w.y = cvt_pk_bf16(v0[2] * sigmoidf_fast(g0[2]), v0[3] * sigmoidf_fast(g0[3]));
                w.z = cvt_pk_bf16(v1[0] * sigmoidf_fast(g1[0]), v1[1] * sigmoidf_fast(g1[1])); w.w = cvt_pk_bf16(v1[2] * sigmoidf_fast(g1[2]), v1[3] * sigmoidf_fast(g1[3]));
                *(u32x4*)rowp = w;
                asm volatile("" : "+v"(rowp)); rowp += (size_t)16 * ldc; }
            rowp += (size_t)64 * ldc; }
    }
};

template <class Epi, class Sched, bool ALIGN_EPI = false, bool SP2 = false>
__device__ __forceinline__ void gemm_phase(PG8_LAS unsigned char* lds, const Gemm g, const Sched& S, const Epi& E, const int tid) {
    const int wid = __builtin_amdgcn_readfirstlane(tid >> 6), lane = tid & 63, wr = wid >> 2, wc = wid & 3, fr = lane & 15, fq = lane >> 4;
    const int K = g.K, nt = K / BK;
    unsigned voffA[2], voffB[2];
#pragma unroll
    for (int i = 0; i < 2; ++i) { int R, C; stage_rc(tid * 16 + i * 8192, R, C); const int Rb = Epi::PERM ? ((R & ~31) + perm32(R & 31)) : R;
        voffA[i] = (unsigned)(R * g.lda + C) * 2u; voffB[i] = (unsigned)(Rb * g.ldb + C) * 2u; }
    const size_t kstep = (size_t)(BK * 2);
    const size_t hstepA = (size_t)HALF * g.lda * 2, hstepB = (size_t)HALF * g.ldb * 2;
    const size_t tstepA = 2 * hstepA, tstepB = 2 * hstepB;
    const unsigned ldsw = (unsigned)wid * 1024u;
    const int aoff = lds_byte(wr * 64 + fr, fq * 8), boff = lds_byte(wc * 32 + fr, fq * 8);
#define PG8_SA(b, h) (((b) * 2 + (h)) * HTB)
#define PG8_SB(b, h) ((4 + (b) * 2 + (h)) * HTB)
#define PG8_STAGE(bufoff, gbase, voff) do { _Pragma("unroll") for (int _i = 0; _i < 2; ++_i) \
        __builtin_amdgcn_global_load_lds((const unsigned*)((const char*)(gbase) + (voff)[_i]), (PG8_LAS unsigned*)(lds + (bufoff) + ldsw + _i * 8192), 16, 0, 0); } while (0)
#define PG8_LDA(dst, b, h) do { _Pragma("unroll") for (int m = 0; m < 4; ++m) _Pragma("unroll") for (int k = 0; k < 2; ++k) dst[m][k] = *(const PG8_LAS bf16x8*)(lds + PG8_SA(b, h) + aoff + m * 2048 + k * 1024); } while (0)
#define PG8_LDB(dst, b, h) do { _Pragma("unroll") for (int n = 0; n < 2; ++n) _Pragma("unroll") for (int k = 0; k < 2; ++k) dst[n][k] = *(const PG8_LAS bf16x8*)(lds + PG8_SB(b, h) + boff + n * 2048 + k * 1024); } while (0)
#define PG8_MMA(ai, bj, At, Bt) do { __builtin_amdgcn_s_setprio(1); _Pragma("unroll") for (int m = 0; m < 4; ++m) _Pragma("unroll") for (int n = 0; n < 2; ++n) _Pragma("unroll") for (int k = 0; k < 2; ++k) \
        acc[ai][bj][m][n] = __builtin_amdgcn_mfma_f32_16x16x32_bf16(Bt[n][k], At[m][k], acc[ai][bj][m][n], 0, 0, 0); __builtin_amdgcn_s_setprio(0); } while (0)
#define PG8_WAIT_V(n) asm volatile("s_waitcnt vmcnt(" #n ")" ::: "memory")
#define PG8_WAIT_L(n) asm volatile("s_waitcnt lgkmcnt(" #n ")" ::: "memory")
#define PG8_BAR __builtin_amdgcn_s_barrier()
#define PG8_SCHED __builtin_amdgcn_sched_barrier(0)
    Unit cur, nxt; int ui = 0;
    if (!S.next(0, cur)) return;
    f32x4 acc[2][2][4][2];
#pragma unroll
    for (int a = 0; a < 2; ++a)
#pragma unroll
        for (int b = 0; b < 2; ++b)
#pragma unroll
            for (int m = 0; m < 4; ++m)
#pragma unroll
                for (int n = 0; n < 2; ++n) acc[a][b][m][n] = (f32x4){0.f, 0.f, 0.f, 0.f};
    bf16x8 At[4][2], B0[2][2], B1[2][2];
    const char* cA = (const char*)g.A + ((size_t)cur.g * g.gsA) * 2 + (size_t)cur.pm * tstepA; const char* cB = (const char*)g.Bt + ((size_t)cur.g * g.gsB) * 2 + (size_t)cur.pn * tstepB;
    if constexpr (SP2) {
        PG8_STAGE(PG8_SB(0, 0), cB, voffB); PG8_STAGE(PG8_SB(0, 1), cB + hstepB, voffB); PG8_STAGE(PG8_SA(0, 0), cA, voffA); PG8_STAGE(PG8_SA(0, 1), cA + hstepA, voffA);
        if (wr == 1) PG8_BAR;
        PG8_WAIT_V(2); PG8_BAR;
        PG8_STAGE(PG8_SB(1, 0), cB + kstep, voffB); PG8_STAGE(PG8_SA(1, 0), cA + kstep, voffA); PG8_STAGE(PG8_SB(1, 1), cB + hstepB + kstep, voffB);
        PG8_WAIT_V(6); PG8_BAR;
    } else {
        PG8_STAGE(PG8_SB(0, 0), cB, voffB); PG8_STAGE(PG8_SA(0, 0), cA, voffA); PG8_STAGE(PG8_SB(0, 1), cB + hstepB, voffB); PG8_STAGE(PG8_SA(0, 1), cA + hstepA, voffA);
        if (wr == 1) PG8_BAR;
        PG8_WAIT_V(4); PG8_BAR;
        PG8_STAGE(PG8_SB(1, 0), cB + kstep, voffB); PG8_STAGE(PG8_SA(1, 0), cA + kstep, voffA); PG8_STAGE(PG8_SB(1, 1), cB + hstepB + kstep, voffB);
        PG8_WAIT_V(6); PG8_BAR;
    }
    for (;;) {
        const bool has_next = S.next(ui + 1, nxt);
        const char* nA = has_next ? (const char*)g.A + ((size_t)nxt.g * g.gsA) * 2 + (size_t)nxt.pm * tstepA : cA; const char* nB = has_next ? (const char*)g.Bt + ((size_t)nxt.g * g.gsB) * 2 + (size_t)nxt.pn * tstepB : cB;
        for (int t = 0; t < nt; t += 2) {
            const bool last = (t == nt - 2);
            const char* a1 = cA + (size_t)(t + 1) * kstep;
            const char* a2 = last ? nA : cA + (size_t)(t + 2) * kstep; const char* b2 = last ? nB : cB + (size_t)(t + 2) * kstep;
            const char* a3 = a2 + kstep; const char* b3 = b2 + kstep;
            if constexpr (SP2) {
            PG8_LDB(B0, 0, 0); PG8_LDB(B1, 0, 1); PG8_SCHED; PG8_LDA(At, 0, 0); PG8_STAGE(PG8_SA(1, 1), a1 + hstepA, voffA);
            PG8_WAIT_V(8); PG8_WAIT_L(0); PG8_BAR; PG8_MMA(0, 0, At, B0); PG8_MMA(0, 1, At, B1); PG8_BAR; PG8_SCHED;
            PG8_LDA(At, 0, 1); PG8_STAGE(PG8_SB(0, 0), b2, voffB); PG8_STAGE(PG8_SB(0, 1), b2 + hstepB, voffB); PG8_STAGE(PG8_SA(0, 0), a2, voffA);
            PG8_WAIT_V(8); PG8_WAIT_L(0); PG8_BAR; PG8_MMA(1, 0, At, B0); PG8_MMA(1, 1, At, B1); PG8_BAR; PG8_SCHED;
            PG8_LDB(B0, 1, 0); PG8_LDB(B1, 1, 1); PG8_SCHED; PG8_LDA(At, 1, 0); PG8_STAGE(PG8_SA(0, 1), a2 + hstepA, voffA);
            PG8_WAIT_V(8); PG8_WAIT_L(0); PG8_BAR; PG8_MMA(0, 0, At, B0); PG8_MMA(0, 1, At, B1); PG8_BAR; PG8_SCHED;
            PG8_LDA(At, 1, 1); PG8_STAGE(PG8_SB(1, 0), b3, voffB); PG8_STAGE(PG8_SB(1, 1), b3 + hstepB, voffB); PG8_STAGE(PG8_SA(1, 0), a3, voffA);
            PG8_WAIT_V(8); PG8_WAIT_L(0); PG8_BAR; PG8_MMA(1, 0, At, B0); PG8_MMA(1, 1, At, B1); PG8_BAR; PG8_SCHED;
            } else {
            PG8_LDB(B0, 0, 0); PG8_SCHED; PG8_LDA(At, 0, 0); PG8_STAGE(PG8_SA(1, 1), a1 + hstepA, voffA);
            PG8_WAIT_L(8); PG8_BAR; PG8_WAIT_L(0); PG8_MMA(0, 0, At, B0); PG8_BAR; PG8_SCHED;
            PG8_LDB(B1, 0, 1); PG8_STAGE(PG8_SB(0, 0), b2, voffB);
            PG8_BAR; PG8_WAIT_L(0); PG8_MMA(0, 1, At, B1); PG8_BAR;
            PG8_LDA(At, 0, 1); PG8_STAGE(PG8_SA(0, 0), a2, voffA);
            PG8_BAR; PG8_WAIT_L(0); PG8_MMA(1, 0, At, B0); PG8_BAR; PG8_SCHED;
            PG8_STAGE(PG8_SB(0, 1), b2 + hstepB, voffB);
            PG8_WAIT_V(6); PG8_BAR; PG8_MMA(1, 1, At, B1); PG8_BAR;
            PG8_LDB(B0, 1, 0); PG8_SCHED; PG8_LDA(At, 1, 0); PG8_STAGE(PG8_SA(0, 1), a2 + hstepA, voffA);
            PG8_WAIT_L(8); PG8_BAR; PG8_WAIT_L(0); PG8_MMA(0, 0, At, B0); PG8_BAR; PG8_SCHED;
            PG8_LDB(B1, 1, 1); PG8_STAGE(PG8_SB(1, 0), b3, voffB);
            PG8_BAR; PG8_WAIT_L(0); PG8_MMA(0, 1, At, B1); PG8_BAR;
            PG8_LDA(At, 1, 1); PG8_STAGE(PG8_SA(1, 0), a3, voffA);
            PG8_BAR; PG8_WAIT_L(0); PG8_MMA(1, 0, At, B0); PG8_BAR; PG8_SCHED;
            PG8_STAGE(PG8_SB(1, 1), b3 + hstepB, voffB);
            PG8_WAIT_V(6); PG8_BAR; PG8_MMA(1, 1, At, B1); PG8_BAR;
            }
        }
        if constexpr (ALIGN_EPI) { if (wr == 0) PG8_BAR; }
        E(acc, cur, wr, wc, fr, fq);
        if (!has_next) break;
#pragma unroll
        for (int a = 0; a < 2; ++a)
#pragma unroll
            for (int b = 0; b < 2; ++b)
#pragma unroll
                for (int m = 0; m < 4; ++m)
#pragma unroll
                    for (int n = 0; n < 2; ++n) acc[a][b][m][n] = (f32x4){0.f, 0.f, 0.f, 0.f};
        cur = nxt; cA = nA; cB = nB; ++ui;
        if constexpr (ALIGN_EPI) { if (wr == 1) PG8_BAR; }
    }
    PG8_WAIT_V(0);
    if constexpr (!ALIGN_EPI) { if (wr == 0) PG8_BAR; }
    PG8_BAR;
#undef PG8_SA
#undef PG8_SB
#undef PG8_STAGE
#undef PG8_LDA
#undef PG8_LDB
#undef PG8_MMA
#undef PG8_WAIT_V
#undef PG8_WAIT_L
#undef PG8_BAR
#undef PG8_SCHED
}
}

constexpr int NWAVES = 8, NTHR = NWAVES * 64;
constexpr int DM = 2048, NBATCH = 2, SEQ = 4096, CTX = 256, MT = NBATCH * SEQ, MC = NBATCH * CTX, DFF = 5632, DFF2 = 2 * DFF, NMODC = 6 * DM, NG = 128;
constexpr float RMS_EPS = 1e-6f;
constexpr int NPHASE = 17;

constexpr size_t MiB = 1u << 20;
constexpr size_t WS_CTL = 0, CTL_ZERO_BYTES = 1 * MiB;
constexpr size_t WS_MODP = 1 * MiB;
constexpr size_t WS_A16 = 4 * MiB;
constexpr size_t WS_WGLU = 5 * MiB;
constexpr size_t WS_WUP = 21 * MiB;
constexpr size_t WS_WDN = 109 * MiB;
constexpr size_t WS_WPOOL = 153 * MiB;
constexpr size_t WS_UZ = 155 * MiB;
constexpr size_t WS_YF = 187 * MiB;
constexpr size_t WS_ACT = 219 * MiB;
constexpr size_t WS_H = 307 * MiB;
constexpr size_t WS_WIN = 307 * MiB;
constexpr size_t WS_W2 = 323 * MiB;
constexpr size_t WS_A2 = 355 * MiB;
constexpr size_t WS_UCG = 419 * MiB;
constexpr size_t WS_SLOC = 421 * MiB;
constexpr size_t WS_SCLOC = 485 * MiB;
constexpr size_t WS_END = 489 * MiB;
static_assert(WS_H + (size_t)MT * DFF2 * 2 <= WS_END && WS_SCLOC + (size_t)NG * 32 * 256 * 4 <= WS_END, "d_ws map");
constexpr int CW_BAR = 4096;

constexpr int RING_OFF = 0, RING_BYTES = 131072;
constexpr int LDSCTL_OFF = RING_BYTES, MISC_OFF = LDSCTL_OFF + 320, PTR_OFF = LDSCTL_OFF + 1024;
constexpr int LDS_BYTES = 147456;

#define GAS __attribute__((address_space(1)))
#define LAS __attribute__((address_space(3)))
typedef unsigned short bf16;
typedef unsigned v4u __attribute__((ext_vector_type(4)));
typedef unsigned v2u __attribute__((ext_vector_type(2)));
typedef float f32x4 __attribute__((ext_vector_type(4)));
typedef short bf16x8 __attribute__((ext_vector_type(8)));
typedef float f32x16 __attribute__((ext_vector_type(16)));
#define LDS_WAIT() asm volatile("s_waitcnt lgkmcnt(0)" ::: "memory")
#define VM_WAIT() asm volatile("s_waitcnt vmcnt(0)" ::: "memory")
__device__ __forceinline__ unsigned f2bf(float f) { unsigned u = __builtin_bit_cast(unsigned, f); return (u + 0x7fffu + ((u >> 16) & 1u)) >> 16; }
__device__ __forceinline__ unsigned pk2(float lo, float hi) { return f2bf(lo) | (f2bf(hi) << 16); }
__device__ __forceinline__ float bf_lo(unsigned w) { return __builtin_bit_cast(float, w << 16); }
__device__ __forceinline__ float bf_hi(unsigned w) { return __builtin_bit_cast(float, w & 0xffff0000u); }
__device__ __forceinline__ float sigm(float x) { return __builtin_amdgcn_rcpf(1.0f + __builtin_amdgcn_exp2f(-1.44269504089f * x)); }

#define XB_TMO      128
#define XB_XCNT(j)  (256  + 64 * (j))
#define XB_XSUB(j)  (1280 + 64 * (j))
#define XB_XGEN(j)  (2304 + 64 * (j))
#define XB_TOP      3328
#define XB_TOPGEN   3392
#define XCD_BAR_WORDS 3456
#define XB_SPIN_CAP (1u << 20)
__device__ __forceinline__ unsigned xb_ld(unsigned* p)              { return __hip_atomic_load(p, __ATOMIC_RELAXED, __HIP_MEMORY_SCOPE_AGENT); }
__device__ __forceinline__ unsigned xb_add(unsigned* p, unsigned v) { return __hip_atomic_fetch_add(p, v, __ATOMIC_RELAXED, __HIP_MEMORY_SCOPE_AGENT); }
__device__ __forceinline__ unsigned xb_xcc_id() { return (unsigned)__builtin_amdgcn_s_getreg((3 << 11) | 20) & 0xFu; }
#define XB_SPIN(cond, bar) do { unsigned _sp = 0; while (cond) { __builtin_amdgcn_s_sleep(1); \
    if ((++_sp & 255u) == 0u) { if (xb_ld(&(bar)[XB_TMO])) break; if (_sp > XB_SPIN_CAP) { atomicAdd(&(bar)[XB_TMO], 1u); break; } } } } while (0)
struct XcdBarrier { unsigned* bar; unsigned x; volatile LAS unsigned* st; };
__device__ __forceinline__ XcdBarrier xcd_barrier_post(unsigned* bar, volatile LAS unsigned* st) {
    XcdBarrier b; b.bar = bar; b.x = xb_xcc_id(); b.st = st;
    if (threadIdx.x == 0) (void)xb_add(&bar[XB_XCNT(b.x)], 1u);
    return b;
}
__device__ __forceinline__ void xcd_barrier_complete(unsigned* bar, unsigned x, unsigned& nloc, unsigned& nx) {
    const unsigned G = gridDim.x * gridDim.y * gridDim.z;
    unsigned sum, cnt, mine, sp = 0u;
    for (;;) {
        sum = 0u; cnt = 0u; mine = 0u;
#pragma unroll
        for (unsigned j = 0; j < 16; ++j) { const unsigned c = xb_ld(&bar[XB_XCNT(j)]); sum += c; cnt += (c > 0u) ? 1u : 0u; mine = (j == x) ? c : mine; }
        if (sum == G) break;
        __builtin_amdgcn_s_sleep(1);
        if ((++sp & 255u) == 0u) { if (xb_ld(&bar[XB_TMO])) break; if (sp > XB_SPIN_CAP) { atomicAdd(&bar[XB_TMO], 1u); break; } }
    }
    nloc = mine > 0u ? mine : 1u; nx = cnt > 0u ? cnt : 1u;
}
__device__ __forceinline__ void xcd_barrier(const XcdBarrier& b) {
    asm volatile("s_waitcnt vmcnt(0)" ::: "memory");
    __syncthreads();
    if (threadIdx.x == 0) {
        unsigned* bar = b.bar;
        __builtin_amdgcn_s_waitcnt(0);
        unsigned nloc = b.st[0], nx = b.st[1];
        if (nloc == 0u) { xcd_barrier_complete(bar, b.x, nloc, nx); b.st[0] = nloc; b.st[1] = nx; }
        const unsigned old = xb_add(&bar[XB_XSUB(b.x)], 1u);
        const unsigned gen = old / nloc;
        if (old + 1u == (gen + 1u) * nloc) {
            __builtin_amdgcn_fence(__ATOMIC_RELEASE, "agent");
            asm volatile("s_waitcnt vmcnt(0)" ::: "memory");
            const unsigned og = xb_add(&bar[XB_TOP], 1u);
            const unsigned tg = og / nx;
            if (og + 1u == (tg + 1u) * nx) xb_add(&bar[XB_TOPGEN], 1u);
            else XB_SPIN(xb_ld(&bar[XB_TOPGEN]) == tg, bar);
            __builtin_amdgcn_fence(__ATOMIC_ACQUIRE, "agent");
            xb_add(&bar[XB_XGEN(b.x)], 1u);
            asm volatile("s_waitcnt vmcnt(0)" ::: "memory");
        } else {
            XB_SPIN(xb_ld(&bar[XB_XGEN(b.x)]) == gen, bar);
            __builtin_amdgcn_fence(__ATOMIC_ACQUIRE, "agent");
            asm volatile("s_waitcnt vmcnt(0)" ::: "memory");
        }
    }
    __syncthreads();
}

struct Args { const float* in[22]; float* out; unsigned char* ws; int ph_lo, ph_hi, li, pad; };
struct Frame {
    LAS unsigned char* lds;
    int tid, lane, wave, vcu, G;
    float* out; unsigned char* ws;
    __device__ __forceinline__ const float* inp(int i) const { return *(const float* LAS*)(lds + PTR_OFF + 8 * i); }
};
enum { I_X = 0, I_C, I_CTX, I_CCTX, I_ADAW, I_ADAB, I_NORMG, I_LAMRE, I_LAMIM, I_LOGSTEP, I_BRE, I_BIM, I_CRE, I_CIM, I_S5D, I_GLUW, I_POOLW, I_POOLS, I_UP, I_CONV, I_CONVB, I_DOWN };

__device__ __forceinline__ float wave_sum(float v) {
#pragma unroll
    for (int o = 1; o < 64; o <<= 1) v += __shfl_xor(v, o);
    return v;
}

__device__ __forceinline__ void sincos_d(double x, double& s, double& c) {
    const double q = __builtin_rint(x * 0.63661977236758134308);
    double r = __builtin_fma(-q, 1.57079632679489655800e+00, x); r = __builtin_fma(-q, 6.12323399573676603587e-17, r);
    const int iq = ((int)q) & 3; const double r2 = r * r;
    double sp = 1.0 / 6227020800.0; sp = sp * r2 - 1.0 / 39916800.0; sp = sp * r2 + 1.0 / 362880.0; sp = sp * r2 - 1.0 / 5040.0; sp = sp * r2 + 1.0 / 120.0; sp = sp * r2 - 1.0 / 6.0; sp = sp * r2 + 1.0; sp *= r;
    double cp = -1.0 / 87178291200.0; cp = cp * r2 + 1.0 / 479001600.0; cp = cp * r2 - 1.0 / 3628800.0; cp = cp * r2 + 1.0 / 40320.0; cp = cp * r2 - 1.0 / 720.0; cp = cp * r2 + 1.0 / 24.0; cp = cp * r2 - 0.5; cp = cp * r2 + 1.0;
    s = (iq == 0) ? sp : (iq == 1) ? cp : (iq == 2) ? -sp : -cp;
    c = (iq == 0) ? cp : (iq == 1) ? -sp : (iq == 2) ? -cp : sp;
}
__device__ __forceinline__ double exp_d(double x) {
    const double n = __builtin_rint(x * 1.44269504088896340736);
    double r = __builtin_fma(-n, 6.93147180369123816490e-01, x); r = __builtin_fma(-n, 1.90821492927058770002e-10, r);
    double p = 1.0 / 479001600.0;
    p = p * r + 1.0 / 39916800.0; p = p * r + 1.0 / 3628800.0; p = p * r + 1.0 / 362880.0; p = p * r + 1.0 / 40320.0; p = p * r + 1.0 / 5040.0; p = p * r + 1.0 / 720.0;
    p = p * r + 1.0 / 120.0; p = p * r + 1.0 / 24.0; p = p * r + 1.0 / 6.0; p = p * r + 0.5; p = p * r + 1.0; p = p * r + 1.0;
    return __builtin_ldexp(p, (int)n);
}

template <int MODE>
__device__ __forceinline__ void p0_transpose_item(const float* W, int K, int N, bf16* WT, LAS float* scr, int item, int lane) {
    const int nblk = N / 32, kb = item / nblk, nb = item % nblk, k0 = 64 * kb, n0 = 32 * nb;
#pragma unroll 8
    for (int i = 0; i < 32; ++i) { const int kk = 2 * i + (lane >> 5); scr[kk * 33 + (lane & 31)] = W[(size_t)(k0 + kk) * N + n0 + (lane & 31)]; }
    LDS_WAIT(); asm volatile("" ::: "memory");
    const int c = lane & 7;
    int r0 = n0;
    if (MODE == 1) { r0 = (n0 < 2048) ? (256 * (n0 >> 7) + (n0 & 127)) : (256 * ((n0 - 2048) >> 7) + 128 + ((n0 - 2048) & 127)); }
#pragma unroll
    for (int j = 0; j < 4; ++j) { const int n = (lane >> 3) + 8 * j; const LAS float* s = scr + (8 * c) * 33 + n;
        v4u o; o.x = pk2(s[0 * 33], s[1 * 33]); o.y = pk2(s[2 * 33], s[3 * 33]); o.z = pk2(s[4 * 33], s[5 * 33]); o.w = pk2(s[6 * 33], s[7 * 33]);
        *(GAS v4u*)(WT + (size_t)(r0 + n) * K + k0 + 8 * c) = o; }
    LDS_WAIT(); asm volatile("" ::: "memory");
}

__device__ __forceinline__ void p0_ada_item(Frame& F, int it) {
    LAS float* cond = (LAS float*)(F.lds);
    LAS float* red = (LAS float*)(F.lds + 24576);
    const int l = it / 384, r = it % 384, s = r / 48, ct = r % 48, k0 = s * 256 + F.wave * 32, n0 = ct * 256;
    const float* W = F.inp(I_ADAW) + (size_t)l * DM * NMODC + (size_t)k0 * NMODC + n0 + 4 * F.lane;
    f32x4 a0 = {0.f, 0.f, 0.f, 0.f}, a1 = a0, a2 = a0;
#pragma unroll 8
    for (int i = 0; i < 32; ++i) { const f32x4 w = *(const GAS f32x4*)(W + (size_t)i * NMODC);
        const float c0 = cond[k0 + i], c1 = cond[2048 + k0 + i], c2 = cond[4096 + k0 + i];
        a0 += w * c0; a1 += w * c1; a2 += w * c2; }
    *(LAS f32x4*)(red + (F.wave * 3 + 0) * 256 + 4 * F.lane) = a0;
    *(LAS f32x4*)(red + (F.wave * 3 + 1) * 256 + 4 * F.lane) = a1;
    *(LAS f32x4*)(red + (F.wave * 3 + 2) * 256 + 4 * F.lane) = a2;
    __syncthreads();
    float* MODP = (float*)(F.ws + WS_MODP);
    for (int o = F.tid; o < 768; o += NTHR) { const int v = o >> 8, col = o & 255; float sum = 0.f;
#pragma unroll
        for (int w = 0; w < 8; ++w) sum += red[(w * 3 + v) * 256 + col];
        MODP[((size_t)(l * 8 + s) * 3 + v) * NMODC + n0 + col] = sum; }
    __syncthreads();
}

__device__ __forceinline__ void p0_s5_item(Frame& F, int g) {
    LAS float* APR = (LAS float*)(F.lds);
    LAS float* API = APR + 2176;
    LAS float* BBR = API + 2176;
    LAS float* BBI = BBR + 2048;
    LAS float* CCR = BBI + 2048;
    LAS float* CCI = CCR + 2048;
    LAS float* KT = CCI + 2048;
    const float* lam_re = F.inp(I_LAMRE); const float* lam_im = F.inp(I_LAMIM); const float* logst = F.inp(I_LOGSTEP);
    for (int idx = F.tid; idx < 2176; idx += NTHR) { const int p = idx & 63, dk = idx >> 6, d = dk / 17, k = dk % 17;
        const double dt = exp_d((double)logst[d * NG + g]); const double lr = (double)lam_re[(d * NG + g) * 64 + p], li = (double)lam_im[(d * NG + g) * 64 + p];
        const double mag = exp_d((double)k * lr * dt); double sn, cs; sincos_d((double)k * li * dt, sn, cs);
        APR[idx] = (float)(mag * cs); API[idx] = (float)(mag * sn); }
    for (int idx = F.tid; idx < 2048; idx += NTHR) { const int c = idx & 15, dp = idx >> 4, d = dp >> 6, p = dp & 63;
        const double dt = exp_d((double)logst[d * NG + g]); const double lr = (double)lam_re[(d * NG + g) * 64 + p], li = (double)lam_im[(d * NG + g) * 64 + p];
        const double mag = exp_d(lr * dt); double sn, cs; sincos_d(li * dt, sn, cs);
        const double nr = mag * cs - 1.0, ni = mag * sn, den = lr * lr + li * li;
        const double fr = (nr * lr + ni * li) / den, fi = (ni * lr - nr * li) / den;
        const size_t bi = ((size_t)(d * NG + g) * 64 + p) * 16 + c; const double br = (double)F.inp(I_BRE)[bi], bim = (double)F.inp(I_BIM)[bi];
        BBR[idx] = (float)(fr * br - fi * bim); BBI[idx] = (float)(fr * bim + fi * br);
        const int cc = idx >> 6, pp = idx & 63;
        const int d2 = cc >> 4, c2 = cc & 15; const size_t ci = ((size_t)(d2 * NG + g) * 16 + c2) * 64 + pp;
        CCR[idx] = F.inp(I_CRE)[ci]; CCI[idx] = F.inp(I_CIM)[ci]; }
    __syncthreads();
    bf16* WIN = (bf16*)(F.ws + WS_WIN) + (size_t)g * 256 * 256;
    for (int q = F.tid; q < 8192; q += NTHR) { const int n = q >> 5, kc = q & 31, d = n >> 7, part = (n >> 6) & 1, p = n & 63, j = kc >> 1, c0 = 8 * (kc & 1);
        const int e = d == 0 ? 15 - j : j; const float ar = APR[(d * 17 + e) * 64 + p], ai = API[(d * 17 + e) * 64 + p];
        float v[8];
#pragma unroll
        for (int x = 0; x < 8; ++x) { const float br = BBR[(d * 64 + p) * 16 + c0 + x], bi = BBI[(d * 64 + p) * 16 + c0 + x]; v[x] = part == 0 ? ar * br - ai * bi : ar * bi + ai * br; }
        v4u o; o.x = pk2(v[0], v[1]); o.y = pk2(v[2], v[3]); o.z = pk2(v[4], v[5]); o.w = pk2(v[6], v[7]);
        *(GAS v4u*)(WIN + (size_t)n * 256 + 8 * kc) = o; }
    for (int idx = F.tid; idx < 8192; idx += NTHR) { const int c = idx & 15, cp = (idx >> 4) & 15, tau = (idx >> 8) & 15, d = idx >> 12; float s = 0.f;
        for (int p = 0; p < 64; ++p) { const float cr = CCR[(d * 16 + cp) * 64 + p], ci = CCI[(d * 16 + cp) * 64 + p], ar = APR[(d * 17 + tau) * 64 + p], ai = API[(d * 17 + tau) * 64 + p];
            const float mr = cr * ar - ci * ai, mi = cr * ai + ci * ar; s += mr * BBR[(d * 64 + p) * 16 + c] - mi * BBI[(d * 64 + p) * 16 + c]; }
        KT[idx] = s; }
    __syncthreads();
    bf16* W2 = (bf16*)(F.ws + WS_W2) + (size_t)g * 256 * 512;
    const float* dsk = F.inp(I_S5D) + g * 16;
    for (int q = F.tid; q < 16384; q += NTHR) { const int n = q >> 6, kc = q & 63, jp = n >> 4, cp = n & 15; float v[8];
        if (kc < 32) { const int d = kc >> 4, part = (kc >> 3) & 1, p0 = 8 * (kc & 7), e = d == 0 ? jp + 1 : 16 - jp;
#pragma unroll
            for (int x = 0; x < 8; ++x) { const int p = p0 + x; const float cr = CCR[(d * 16 + cp) * 64 + p], ci = CCI[(d * 16 + cp) * 64 + p], ar = APR[(d * 17 + e) * 64 + p], ai = API[(d * 17 + e) * 64 + p];
                v[x] = part == 0 ? cr * ar - ci * ai : -(cr * ai + ci * ar); }
        } else { const int j = (kc - 32) >> 1, c0 = 8 * ((kc - 32) & 1);
#pragma unroll
            for (int x = 0; x < 8; ++x) { const int c = c0 + x; float s = 0.f;
                if (j <= jp) s += KT[((0 * 16 + (jp - j)) * 16 + cp) * 16 + c];
                if (j >= jp) s += KT[((1 * 16 + (j - jp)) * 16 + cp) * 16 + c];
                if (j == jp && c == cp) s += dsk[c];
                v[x] = s; } }
        v4u o; o.x = pk2(v[0], v[1]); o.y = pk2(v[2], v[3]); o.z = pk2(v[4], v[5]); o.w = pk2(v[6], v[7]);
        *(GAS v4u*)(W2 + (size_t)n * 512 + 8 * kc) = o; }
    if (F.tid < 128) { const int d = F.tid >> 6, p = F.tid & 63; float* A16 = (float*)(F.ws + WS_A16) + ((size_t)(d * NG + g) * 64 + p) * 2;
        A16[0] = APR[(d * 17 + 16) * 64 + p]; A16[1] = API[(d * 17 + 16) * 64 + p]; }
    __syncthreads();
}

__device__ __forceinline__ void p0_prologue(Frame& F) {
    for (int g = F.vcu; g < NG; g += F.G) p0_s5_item(F, g);
    { LAS float* cond = (LAS float*)(F.lds);
      for (int i = F.tid; i < 3 * DM; i += NTHR) { const float x = i < 2 * DM ? F.inp(I_C)[i] : F.inp(I_CCTX)[i - 2 * DM]; cond[i] = x * sigm(x); }
      __syncthreads();
      for (int it = F.vcu; it < 768; it += F.G) p0_ada_item(F, it); }
    __syncthreads();
    LAS float* scr = (LAS float*)(F.lds + F.wave * 16384);
    const int gw = F.vcu * NWAVES + F.wave, NGW = F.G * NWAVES;
    constexpr int I_G = (DM / 64) * (2 * DM / 32), I_U = (DM / 64) * (DFF2 / 32), I_D = (DFF / 64) * (DM / 32), I_P = (512 / 64) * (512 / 32);
    constexpr int NITEMS = I_G + 2 * I_U + 2 * I_D + 4 * I_P;
    for (int it = gw; it < NITEMS; it += NGW) {
        int r = it;
        if (r < I_G) { p0_transpose_item<1>(F.inp(I_GLUW), DM, 2 * DM, (bf16*)(F.ws + WS_WGLU), scr, r, F.lane); continue; } r -= I_G;
        if (r < 2 * I_U) { const int l = r / I_U; p0_transpose_item<0>(F.inp(I_UP) + (size_t)l * DM * DFF2, DM, DFF2, (bf16*)(F.ws + WS_WUP) + (size_t)l * DFF2 * DM, scr, r % I_U, F.lane); continue; } r -= 2 * I_U;
        if (r < 2 * I_D) { const int l = r / I_D; p0_transpose_item<0>(F.inp(I_DOWN) + (size_t)l * DFF * DM, DFF, DM, (bf16*)(F.ws + WS_WDN) + (size_t)l * DM * DFF, scr, r % I_D, F.lane); continue; } r -= 2 * I_D;
        { const int gi = r / I_P; p0_transpose_item<0>(F.inp(I_POOLW) + (size_t)gi * 512 * 512, 512, 512, (bf16*)(F.ws + WS_WPOOL) + (size_t)gi * 512 * 512, scr, r % I_P, F.lane); }
    }
}

__device__ __forceinline__ void load_mod(Frame& F, int l, int v, int q, LAS float* dst) {
    const float* MODP = (const float*)(F.ws + WS_MODP); const int col = q * DM + 4 * F.tid;
    f32x4 s = *(const GAS f32x4*)(F.inp(I_ADAB) + l * NMODC + col);
#pragma unroll
    for (int sl = 0; sl < 8; ++sl) s += *(const GAS f32x4*)(MODP + ((size_t)(l * 8 + sl) * 3 + v) * NMODC + col);
    *(LAS f32x4*)(dst + 4 * F.tid) = s;
}

constexpr int STG_PITCH = 4112;
__device__ __forceinline__ void p1_rows(Frame& F) {
    LAS float* shiftL = (LAS float*)(F.lds + 98304);
    LAS float* scaleL = shiftL + 2048;
    LAS unsigned char* stg = F.lds;
    const float* g0 = F.inp(I_NORMG);
    int cur_vec = -1;
    for (int unit = F.vcu; unit < 544; unit += F.G) {
        const bool is_ctx = unit >= 512; const int b = is_ctx ? (unit - 512) >> 4 : unit >> 8, blk = is_ctx ? (unit - 512) & 15 : unit & 255;
        const int vec = is_ctx ? 2 : b;
        if (vec != cur_vec) { __syncthreads(); load_mod(F, 0, vec, 0, shiftL); load_mod(F, 0, vec, 1, scaleL); cur_vec = vec; }
        __syncthreads();
#pragma unroll 1
        for (int rr = 0; rr < 2; ++rr) { const int row = F.wave + 8 * rr, t = blk * 16 + row;
            const float* src = is_ctx ? F.inp(I_CTX) + ((size_t)(b * CTX + t)) * DM : F.inp(I_X) + ((size_t)(b * SEQ + t)) * DM;
            f32x4 v[8]; float ss = 0.f;
#pragma unroll
            for (int j = 0; j < 8; ++j) { v[j] = *(const GAS f32x4*)(src + 4 * F.lane + 256 * j); }
            if (!is_ctx) { const float prow = (float)(t >> 6), pcol = (float)(t & 63);
#pragma unroll
                for (int j = 0; j < 8; ++j) { const float pos = j < 4 ? prow : pcol; const bool is_cos = (j & 2) != 0;
#pragma unroll
                    for (int e = 0; e < 4; ++e) { const int i = (4 * F.lane + 256 * j + e) & 511;
                        const float omega = __builtin_amdgcn_exp2f(-(float)i * (13.287712379549449f / 512.0f));
                        const float rev = pos * omega * 0.15915494309189535f;
                        v[j][e] += is_cos ? __builtin_amdgcn_cosf(rev) : __builtin_amdgcn_sinf(rev); } }
                float* dst = F.out + ((size_t)(b * SEQ + t)) * DM;
#pragma unroll
                for (int j = 0; j < 8; ++j) *(GAS f32x4*)(dst + 4 * F.lane + 256 * j) = v[j]; }
#pragma unroll
            for (int j = 0; j < 8; ++j) ss += (v[j][0] * v[j][0] + v[j][1] * v[j][1]) + (v[j][2] * v[j][2] + v[j][3] * v[j][3]);
            const float rstd = 1.0f / sqrtf(wave_sum(ss) * (1.0f / DM) + RMS_EPS);
#pragma unroll
            for (int j = 0; j < 8; ++j) { const int col = 4 * F.lane + 256 * j; const f32x4 gg = *(const GAS f32x4*)(g0 + col), sc = *(LAS f32x4*)(scaleL + col), sh = *(LAS f32x4*)(shiftL + col);
                const f32x4 u = (v[j] * rstd * gg) * (sc + 1.0f) + sh;
                v2u w; w.x = pk2(u[0], u[1]); w.y = pk2(u[2], u[3]);
                *(LAS v2u*)(stg + row * STG_PITCH + col * 2) = w; } }
        __syncthreads();
        for (int q = F.tid; q < 4096; q += NTHR) { const int g = q >> 5, jh = q & 31, j = jh >> 1, h = jh & 1;
            const v4u w = *(LAS v4u*)(stg + j * STG_PITCH + g * 32 + h * 16);
            bf16* dst = is_ctx ? (bf16*)(F.ws + WS_UCG) + ((size_t)g * 32 + b * 16 + blk) * 256 + jh * 8
                               : (bf16*)(F.ws + WS_A2) + ((size_t)g * 512 + b * 256 + blk) * 512 + 256 + jh * 8;
            *(GAS v4u*)dst = w; }
    }
    __syncthreads();
}

__device__ __forceinline__ void p2_ctx_small(Frame& F, int g) {
    const bf16* A = (const bf16*)(F.ws + WS_UCG) + (size_t)g * 32 * 256; const bf16* Bt = (const bf16*)(F.ws + WS_WIN) + (size_t)g * 256 * 256;
    const int r = F.lane & 31, h = F.lane >> 5; f32x16 acc;
#pragma unroll
    for (int i = 0; i < 16; ++i) acc[i] = 0.f;
#pragma unroll 4
    for (int ks = 0; ks < 16; ++ks) { const bf16x8 a = *(const GAS bf16x8*)(A + r * 256 + ks * 16 + 8 * h), bq = *(const GAS bf16x8*)(Bt + (size_t)(32 * F.wave + r) * 256 + ks * 16 + 8 * h);
        acc = __builtin_amdgcn_mfma_f32_32x32x16_bf16(a, bq, acc, 0, 0, 0); }
    float* O = (float*)(F.ws + WS_SCLOC) + (size_t)g * 32 * 256;
#pragma unroll
    for (int i = 0; i < 16; ++i) { const int row = (i & 3) + 8 * (i >> 2) + 4 * h; O[row * 256 + 32 * F.wave + r] = acc[i]; }
}

__device__ __forceinline__ void p3_scan(Frame& F) {
    LAS float* EX = (LAS float*)(F.lds);
    for (int item = F.vcu; item < 2 * NG; item += F.G) { const int g = item >> 1, b = item & 1;
        const int p = F.lane, d = F.wave >> 2, ch = F.wave & 3;
        const float* A16 = (const float*)(F.ws + WS_A16) + ((size_t)(d * NG + g) * 64 + p) * 2; const float ar = A16[0], ai = A16[1];
        const int row0 = d == 0 ? ch * 64 : 255 - ch * 64; const long rstep = d == 0 ? 256 : -256;
        const float* SL = (const float*)(F.ws + WS_SLOC) + ((size_t)g * 512 + b * 256 + row0) * 256 + d * 128 + p;
        const float* SC = (const float*)(F.ws + WS_SCLOC) + ((size_t)g * 32 + b * 16 + (d == 0 ? 0 : 15)) * 256 + d * 128 + p;
        float cr = 0.f, ci = 0.f;
        { const float* q = SC;
#pragma unroll 8
          for (int k = 0; k < 16; ++k) { const float xr = q[0], xi = q[64]; q += rstep;
            const float nr = ar * cr - ai * ci + xr, ni = ar * ci + ai * cr + xi; cr = nr; ci = ni; } }
        float sr = 0.f, si = 0.f;
        { const float* q = SL;
#pragma unroll 8
          for (int i = 0; i < 64; ++i) { const float xr = q[0], xi = q[64]; q += rstep;
            const float nr = ar * sr - ai * si + xr, ni = ar * si + ai * sr + xi; sr = nr; si = ni; } }
        __syncthreads();
        EX[((d * 4 + ch) * 64 + p) * 2] = sr; EX[((d * 4 + ch) * 64 + p) * 2 + 1] = si;
        __syncthreads();
        float pr = ar, pi = ai;
#pragma unroll
        for (int k = 0; k < 6; ++k) { const float nr = pr * pr - pi * pi, ni = 2.f * pr * pi; pr = nr; pi = ni; }
        for (int q = 0; q < ch; ++q) { const float er = EX[((d * 4 + q) * 64 + p) * 2], ei = EX[((d * 4 + q) * 64 + p) * 2 + 1];
            const float nr = pr * cr - pi * ci + er, ni = pr * ci + pi * cr + ei; cr = nr; ci = ni; }
        bf16* OUT = (bf16*)(F.ws + WS_A2) + ((size_t)g * 512 + b * 256 + row0) * 512 + d * 128 + p;
        { const float* q = SL; const long ostep = 2 * rstep;
#pragma unroll 8
          for (int i = 0; i < 64; ++i) { const float xr = q[0], xi = q[64]; q += rstep;
            OUT[0] = (bf16)f2bf(cr); OUT[64] = (bf16)f2bf(ci); OUT += ostep;
            const float nr = ar * cr - ai * ci + xr, ni = ar * ci + ai * cr + xi; cr = nr; ci = ni; } }
    }
    __syncthreads();
}

template <bool SECOND>
__device__ __forceinline__ void row_tail(Frame& F, int row, f32x4 (&y)[8], const float* ga, const float* gb, LAS float* gateL, LAS float* shiftL, LAS float* scaleL) {
    float ss = 0.f;
#pragma unroll
    for (int j = 0; j < 8; ++j) ss += (y[j][0] * y[j][0] + y[j][1] * y[j][1]) + (y[j][2] * y[j][2] + y[j][3] * y[j][3]);
    const float ry = 1.0f / sqrtf(wave_sum(ss) * (1.0f / DM) + RMS_EPS);
    float* xrow = F.out + (size_t)row * DM; float s2 = 0.f;
#pragma unroll
    for (int j = 0; j < 8; ++j) { const int col = 4 * F.lane + 256 * j; const f32x4 x = *(const GAS f32x4*)(xrow + col), gg = *(const GAS f32x4*)(ga + col), gt = *(LAS f32x4*)(gateL + col);
        y[j] = x + gt * (y[j] * ry * gg);
        *(GAS f32x4*)(xrow + col) = y[j];
        s2 += (y[j][0] * y[j][0] + y[j][1] * y[j][1]) + (y[j][2] * y[j][2] + y[j][3] * y[j][3]); }
    if (SECOND) { const float rx = 1.0f / sqrtf(wave_sum(s2) * (1.0f / DM) + RMS_EPS); bf16* U = (bf16*)(F.ws + WS_UZ);
#pragma unroll
        for (int j = 0; j < 8; ++j) { const int col = 4 * F.lane + 256 * j; const f32x4 gg = *(const GAS f32x4*)(gb + col), sc = *(LAS f32x4*)(scaleL + col), sh = *(LAS f32x4*)(shiftL + col);
            const f32x4 u = (y[j] * rx * gg) * (sc + 1.0f) + sh; v2u w; w.x = pk2(u[0], u[1]); w.y = pk2(u[2], u[3]);
            *(GAS v2u*)(U + (size_t)row * DM + col) = w; } }
}
template <int YMODE, bool SECOND>
__device__ __forceinline__ void row_phase(Frame& F, int l_gate, int q_gate, int ga_idx, int l_mod, int q_shift, int q_scale, int gb_idx) {
    LAS float* gateL = (LAS float*)(F.lds);
    LAS float* shiftL = gateL + 2048;
    LAS float* scaleL = shiftL + 2048;
    LAS unsigned char* stg = F.lds + 32768;
    const bf16* Y = (const bf16*)(F.ws + WS_YF);
    const float* ga = F.inp(I_NORMG) + ga_idx * DM; const float* gb = F.inp(I_NORMG) + gb_idx * DM;
    int cur_b = -1;
    for (int rg = F.vcu; rg < MT / 32; rg += F.G) { const int b = rg / (SEQ / 32);
        if (b != cur_b) { __syncthreads(); load_mod(F, l_gate, b, q_gate, gateL); if (SECOND) { load_mod(F, l_mod, b, q_shift, shiftL); load_mod(F, l_mod, b, q_scale, scaleL); } cur_b = b; __syncthreads(); }
        if (YMODE == 0) {
#pragma unroll 1
            for (int rr = 0; rr < 4; ++rr) { const int row = rg * 32 + F.wave * 4 + rr;
                f32x4 y[8];
#pragma unroll
                for (int j = 0; j < 8; ++j) { const v2u w = *(const GAS v2u*)(Y + (size_t)row * DM + 4 * F.lane + 256 * j); y[j] = (f32x4){bf_lo(w.x), bf_hi(w.x), bf_lo(w.y), bf_hi(w.y)}; }
                row_tail<SECOND>(F, row, y, ga, gb, gateL, shiftL, scaleL); }
        } else {
#pragma unroll 1
            for (int half = 0; half < 2; ++half) { const int r0 = rg * 32 + half * 16, t0 = r0 & (SEQ - 1);
                __syncthreads();
                {
                    const int hw = 1 << (F.wave >> 1); const bf16* Yb = Y + (size_t)(r0 - t0) * DM + 4 * F.tid;
                    const f32x4 ps = *(const GAS f32x4*)(F.inp(I_POOLS) + 4 * F.tid);
#define LDV(trow) ({ const int _t = (trow); const bool _ok = _t >= 0 && _t < SEQ; const v2u _w = *(const GAS v2u*)(Yb + (size_t)(_ok ? _t : t0) * DM); const float _m = _ok ? 1.0f : 0.0f; \
                      (f32x4){bf_lo(_w.x) * _m, bf_hi(_w.x) * _m, bf_lo(_w.y) * _m, bf_hi(_w.y) * _m}; })
                    f32x4 s = {0.f, 0.f, 0.f, 0.f};
#pragma unroll 2
                    for (int o = -hw; o < hw; ++o) s += LDV(t0 + o);
#pragma unroll 4
                    for (int i = 0; i < 16; ++i) { const int t = t0 + i; const f32x4 self = LDV(t);
                        const int lo = t - hw < 0 ? 0 : t - hw, hi = t + hw - 1 > SEQ - 1 ? SEQ - 1 : t + hw - 1;
                        const f32x4 yv = (s * (1.0f / (float)(hi - lo + 1)) - self) * ps;
                        v2u w; w.x = pk2(yv[0], yv[1]); w.y = pk2(yv[2], yv[3]);
                        *(LAS v2u*)(stg + i * STG_PITCH + 8 * F.tid) = w;
                        s += LDV(t + hw) - LDV(t - hw); }
#undef LDV
                }
                __syncthreads();
#pragma unroll 1
                for (int rr = 0; rr < 2; ++rr) { const int lr = F.wave * 2 + rr, row = r0 + lr;
                    f32x4 y[8];
#pragma unroll
                    for (int j = 0; j < 8; ++j) { const v2u w = *(LAS v2u*)(stg + lr * STG_PITCH + 8 * F.lane + 512 * j); y[j] = (f32x4){bf_lo(w.x), bf_hi(w.x), bf_lo(w.y), bf_hi(w.y)}; }
                    row_tail<SECOND>(F, row, y, ga, gb, gateL, shiftL, scaleL); }
            }
        }
    }
    __syncthreads();
}

__device__ __forceinline__ void conv_phase(Frame& F, int l) {
    const bf16* H = (const bf16*)(F.ws + WS_H); bf16* ACT = (bf16*)(F.ws + WS_ACT);
    const float* cw = F.inp(I_CONV) + (size_t)l * 3 * DFF2; const float* cb = F.inp(I_CONVB) + (size_t)l * DFF2;
    const int gw = F.vcu * NWAVES + F.wave, NGW = F.G * NWAVES;
    for (int wi = gw; wi < (MT / 16) * 11; wi += NGW) { const int rb = wi / 11, cbk = wi % 11, f0 = (cbk * 64 + F.lane) * 8, t0 = rb * 16;
        float kv[3][8], kg[3][8], bv[8], bg[8];
#pragma unroll
        for (int tp = 0; tp < 3; ++tp) { const f32x4 a = *(const GAS f32x4*)(cw + tp * DFF2 + f0), b2 = *(const GAS f32x4*)(cw + tp * DFF2 + f0 + 4), c = *(const GAS f32x4*)(cw + tp * DFF2 + DFF + f0), d = *(const GAS f32x4*)(cw + tp * DFF2 + DFF + f0 + 4);
#pragma unroll
            for (int e = 0; e < 4; ++e) { kv[tp][e] = a[e]; kv[tp][4 + e] = b2[e]; kg[tp][e] = c[e]; kg[tp][4 + e] = d[e]; } }
        { const f32x4 a = *(const GAS f32x4*)(cb + f0), b2 = *(const GAS f32x4*)(cb + f0 + 4), c = *(const GAS f32x4*)(cb + DFF + f0), d = *(const GAS f32x4*)(cb + DFF + f0 + 4);
#pragma unroll
            for (int e = 0; e < 4; ++e) { bv[e] = a[e]; bv[4 + e] = b2[e]; bg[e] = c[e]; bg[4 + e] = d[e]; } }
        float pv[8], pg[8], cv[8], cg[8], nv[8], ng[8];
        const bool has_prev = (t0 & (SEQ - 1)) != 0, has_next = ((t0 + 16) & (SEQ - 1)) != 0;
#define LD8(dstv, dstg, trow) do { const v4u _a = *(const GAS v4u*)(H + (size_t)(trow) * DFF2 + f0), _b = *(const GAS v4u*)(H + (size_t)(trow) * DFF2 + DFF + f0); \
            dstv[0] = bf_lo(_a.x); dstv[1] = bf_hi(_a.x); dstv[2] = bf_lo(_a.y); dstv[3] = bf_hi(_a.y); dstv[4] = bf_lo(_a.z); dstv[5] = bf_hi(_a.z); dstv[6] = bf_lo(_a.w); dstv[7] = bf_hi(_a.w); \
            dstg[0] = bf_lo(_b.x); dstg[1] = bf_hi(_b.x); dstg[2] = bf_lo(_b.y); dstg[3] = bf_hi(_b.y); dstg[4] = bf_lo(_b.z); dstg[5] = bf_hi(_b.z); dstg[6] = bf_lo(_b.w); dstg[7] = bf_hi(_b.w); } while (0)
        if (has_prev) LD8(pv, pg, t0 - 1); else {
#pragma unroll
            for (int e = 0; e < 8; ++e) { pv[e] = 0.f; pg[e] = 0.f; } }
        LD8(cv, cg, t0);
#pragma unroll
        for (int i = 0; i < 16; ++i) {
            if (i < 15 || has_next) LD8(nv, ng, t0 + i + 1); else {
#pragma unroll
                for (int e = 0; e < 8; ++e) { nv[e] = 0.f; ng[e] = 0.f; } }
            float o[8];
#pragma unroll
            for (int e = 0; e < 8; ++e) { const float vv = kv[0][e] * pv[e] + kv[1][e] * cv[e] + kv[2][e] * nv[e] + bv[e], gg = kg[0][e] * pg[e] + kg[1][e] * cg[e] + kg[2][e] * ng[e] + bg[e];
                o[e] = gg * sigm(gg) * vv; }
            v4u w; w.x = pk2(o[0], o[1]); w.y = pk2(o[2], o[3]); w.z = pk2(o[4], o[5]); w.w = pk2(o[6], o[7]);
            *(GAS v4u*)(ACT + (size_t)(t0 + i) * DFF + f0) = w;
#pragma unroll
            for (int e = 0; e < 8; ++e) { pv[e] = cv[e]; pg[e] = cg[e]; cv[e] = nv[e]; cg[e] = ng[e]; }
        }
#undef LD8
    }
}

__global__ void __launch_bounds__(NTHR, 2) fwd_kernel(Args args) {
    extern __shared__ __attribute__((aligned(16))) unsigned char lds[];
    Frame F;
    F.lds = (LAS unsigned char*)lds;
    F.tid = threadIdx.x; F.lane = F.tid & 63; F.wave = __builtin_amdgcn_readfirstlane(F.tid >> 6);
    F.G = gridDim.x; { const int bx = blockIdx.x; F.vcu = (F.G % 8 == 0) ? (bx % 8) * (F.G / 8) + bx / 8 : bx; }
    F.out = args.out; F.ws = args.ws;
    volatile LAS unsigned* MISC = (volatile LAS unsigned*)(F.lds + MISC_OFF);
    for (int u = F.tid; u < (LDS_BYTES - LDSCTL_OFF) / 4; u += NTHR) ((LAS unsigned*)(F.lds + LDSCTL_OFF))[u] = 0u;
    __syncthreads();
    if (F.tid < 22) *(const float* LAS*)(F.lds + PTR_OFF + 8 * F.tid) = args.in[F.tid];
    __syncthreads();
    const bool one_launch = (args.ph_hi - args.ph_lo) > 1;
    XcdBarrier bar; bar.bar = (unsigned*)(F.ws + WS_CTL) + CW_BAR; bar.x = 0; bar.st = nullptr;
    if (one_launch) bar = xcd_barrier_post((unsigned*)(F.ws + WS_CTL) + CW_BAR, MISC + 8);
    const int lo = args.ph_lo, hi = args.ph_hi;
#ifndef PH_MASK
#define PH_MASK 0x1ffff
#endif
#define IN(k) ((((PH_MASK) >> (k)) & 1) && lo <= (k) && (k) < hi)
#define FENCE() do { asm volatile("" : "+v"(F.tid)); F.lane = F.tid & 63; { int _w = F.tid >> 6; asm volatile("" : "+v"(_w)); F.wave = __builtin_amdgcn_readfirstlane(_w); } \
        asm volatile("" : "+s"(F.vcu), "+s"(F.G), "+s"(F.ws), "+s"(F.out), "+s"(F.lds)); ring = F.lds + RING_OFF; } while (0)
#define SEAM(k) do { if (IN(k) && IN((k) + 1)) xcd_barrier(bar); FENCE(); } while (0)
    LAS unsigned char* ring = F.lds + RING_OFF;
    FENCE();

    if (IN(0)) { p0_prologue(F); } SEAM(0);
    if (IN(1)) { p1_rows(F); } SEAM(1);
    if (IN(2)) {
        for (int g = F.vcu; g < NG; g += F.G) p2_ctx_small(F, g);
        VM_WAIT(); __syncthreads();
        pg8::Gemm g{(const pg8::bf16_t*)(F.ws + WS_A2) + 256, (const pg8::bf16_t*)(F.ws + WS_WIN), 512, 256, 256, (size_t)512 * 512, (size_t)256 * 256};
        pg8::GroupedOrder S; S.init(NG, 2, 1, F.G, F.vcu);
        pg8::EpiF32G E{(float*)(F.ws + WS_SLOC), 256, (size_t)512 * 256};
        pg8::gemm_phase<pg8::EpiF32G, pg8::GroupedOrder, true, true>(ring, g, S, E, F.tid);
    } SEAM(2);
    if (IN(3)) { p3_scan(F); } SEAM(3);
    if (IN(4)) {
        pg8::Gemm g{(const pg8::bf16_t*)(F.ws + WS_A2), (const pg8::bf16_t*)(F.ws + WS_W2), 512, 512, 512, (size_t)512 * 512, (size_t)256 * 512};
        pg8::GroupedOrder S; S.init(NG, 2, 1, F.G, F.vcu);
        pg8::EpiGeluZ E{(pg8::bf16_t*)(F.ws + WS_UZ)};
        pg8::gemm_phase<pg8::EpiGeluZ, pg8::GroupedOrder, true, true>(ring, g, S, E, F.tid);
    } SEAM(4);
    if (IN(5)) {
        pg8::Gemm g{(const pg8::bf16_t*)(F.ws + WS_UZ), (const pg8::bf16_t*)(F.ws + WS_WGLU), DM, DM, DM, 0, 0};
        pg8::StaticOrder S; S.init(MT, 2 * DM, F.G, (int)blockIdx.x);
        pg8::EpiGlu E{(pg8::bf16_t*)(F.ws + WS_YF), DM};
        pg8::gemm_phase<pg8::EpiGlu, pg8::StaticOrder, true, true>(ring, g, S, E, F.tid);
    } SEAM(5);
    if (IN(6)) { row_phase<0, true>(F, 0, 2, 1, 0, 3, 4, 2); } SEAM(6);
    for (int l = 0; l < 2; ++l) {
        const int pb = l == 0 ? 7 : 13;
        if (IN(pb)) {
            pg8::Gemm g{(const pg8::bf16_t*)(F.ws + WS_UZ), (const pg8::bf16_t*)(F.ws + WS_WUP) + (size_t)l * DFF2 * DM, DM, DM, DM, 0, 0};
            pg8::StaticOrder S; S.init(MT, DFF2, F.G, (int)blockIdx.x);
            pg8::EpiBf16G E{(pg8::bf16_t*)(F.ws + WS_H), DFF2, 0};
            pg8::gemm_phase<pg8::EpiBf16G, pg8::StaticOrder, true, true>(ring, g, S, E, F.tid);
        } SEAM(pb);
        if (IN(pb + 1)) { conv_phase(F, l); } SEAM(pb + 1);
        if (IN(pb + 2)) {
            pg8::Gemm g{(const pg8::bf16_t*)(F.ws + WS_ACT), (const pg8::bf16_t*)(F.ws + WS_WDN) + (size_t)l * DM * DFF, DFF, DFF, DFF, 0, 0};
            pg8::StaticOrder S; S.init(MT, DM, F.G, (int)blockIdx.x);
            pg8::EpiBf16G E{(pg8::bf16_t*)(F.ws + WS_YF), DM, 0};
            pg8::gemm_phase<pg8::EpiBf16G, pg8::StaticOrder, true, true>(ring, g, S, E, F.tid);
        } SEAM(pb + 2);
        if (l == 0) {
            if (IN(10)) { row_phase<0, true>(F, 0, 5, 3, 1, 0, 1, 4); } SEAM(10);
            if (IN(11)) {
                pg8::Gemm g{(const pg8::bf16_t*)(F.ws + WS_UZ), (const pg8::bf16_t*)(F.ws + WS_WPOOL), DM, 512, 512, (size_t)512, (size_t)512 * 512};
                pg8::GroupedOrder S; S.init(4, MT / 256, 2, F.G, F.vcu);
                pg8::EpiBf16G E{(pg8::bf16_t*)(F.ws + WS_YF), DM, (size_t)512};
                pg8::gemm_phase<pg8::EpiBf16G, pg8::GroupedOrder, true, true>(ring, g, S, E, F.tid);
            } SEAM(11);
            if (IN(12)) { row_phase<1, true>(F, 1, 2, 5, 1, 3, 4, 6); } SEAM(12);
        } else {
            if (IN(16)) { row_phase<0, false>(F, 1, 5, 7, 0, 0, 0, 0); }
        }
    }
#undef IN
#undef SEAM
}

extern "C" void kernel_launch(void* const* d_in, const int* in_sizes, int n_in, void* d_out, int out_size, void* d_ws, size_t ws_size, hipStream_t stream) {
    static int grid = 0;
    if (grid == 0) {
        if (n_in != 22 || out_size != MT * DM || ws_size < WS_END) { fprintf(stderr, "kernel_launch: unexpected problem (n_in %d, out %d, ws %zu); nothing launched\n", n_in, out_size, ws_size); grid = -1; return; }
        int dev = 0, cus = 0, per_cu = 0;
        if (hipGetDevice(&dev) != hipSuccess || hipDeviceGetAttribute(&cus, hipDeviceAttributeMultiprocessorCount, dev) != hipSuccess) { grid = -1; return; }
        if (hipFuncSetAttribute((const void*)fwd_kernel, hipFuncAttributeMaxDynamicSharedMemorySize, LDS_BYTES) != hipSuccess) { fprintf(stderr, "kernel_launch: hipFuncSetAttribute failed\n"); grid = -1; return; }
        if (hipOccupancyMaxActiveBlocksPerMultiprocessor(&per_cu, (const void*)fwd_kernel, NTHR, LDS_BYTES) != hipSuccess || per_cu < 1) { fprintf(stderr, "kernel_launch: occupancy query reports %d blocks per CU\n", per_cu); per_cu = 1; }
        (void)hipGetLastError();
        grid = cus;
    }
    if (grid < 0) return;
    if (hipMemsetAsync((char*)d_ws + WS_CTL, 0, CTL_ZERO_BYTES, stream) != hipSuccess) { fprintf(stderr, "kernel_launch: hipMemsetAsync failed\n"); return; }
    Args a{};
    for (int i = 0; i < 22; ++i) a.in[i] = (const float*)d_in[i];
    a.out = (float*)d_out; a.ws = (unsigned char*)d_ws;
#if MK_N_LAUNCHES == 1
    a.ph_lo = 0; a.ph_hi = NPHASE; a.li = 0;
    hipLaunchKernelGGL(fwd_kernel, dim3(grid), dim3(NTHR), LDS_BYTES, stream, a);
#else
    for (int p = 0; p < NPHASE; ++p) { a.ph_lo = p; a.ph_hi = p + 1; a.li = p; hipLaunchKernelGGL(fwd_kernel, dim3(grid), dim3(NTHR), LDS_BYTES, stream, a); }
#endif
    const hipError_t le = hipPeekAtLastError();
    if (le != hipSuccess) fprintf(stderr, "kernel_launch: launch failed: %s\n", hipGetErrorName(le));
}
```

```cpp
#include <hip/hip_runtime.h>
#include <cstdio>
#include <cstdint>

#ifndef MK_N_LAUNCHES
#define MK_N_LAUNCHES 1
#endif

namespace pg8 {
#define PG8_LAS __attribute__((address_space(3)))
typedef unsigned short bf16_t;
typedef short bf16x8 __attribute__((ext_vector_type(8)));
typedef float f32x4 __attribute__((ext_vector_type(4)));
typedef float f32x16 __attribute__((ext_vector_type(16)));
typedef unsigned u32x4 __attribute__((ext_vector_type(4)));
typedef unsigned u32x2 __attribute__((ext_vector_type(2)));
constexpr int BM = 256, BK = 64, HALF = 128, HTB = HALF * BK * 2  , STAGE_BYTES = 8 * HTB, NXCD = 8, WGM = 8;

__host__ __device__ __forceinline__ int lds_byte(int r, int c) { const int st = (r >> 4) * 2 + (c >> 5), rr = r & 15, cc = c & 31, ob = rr * 64 + cc * 2; return st * 1024 + (ob ^ (((ob >> 9) & 1) << 5)); }
__host__ __device__ __forceinline__ void stage_rc(int b, int& R, int& C) { const int st = b / 1024, sb = b % 1024, swz = sb ^ (((sb >> 9) & 1) << 5); R = (st >> 1) * 16 + swz / 64; C = (st & 1) * 32 + (swz % 64) / 2; }
__host__ __device__ __forceinline__ int perm32(int rho) { const int n = rho >> 4, i = rho & 15; return 8 * (i >> 2) + 4 * n + (i & 3); }

struct Unit { int pm, pn, g; };
struct Gemm { const bf16_t* A; const bf16_t* Bt; int lda, ldb, K; size_t gsA, gsB; };

struct StaticOrder {
    int nM, nN, nwg, G, c;
    __device__ void init(int M, int N, int G_, int c_) { nM = M / BM; nN = N / BM; nwg = nM * nN; G = G_; c = c_; }
    __device__ bool next(int i, Unit& u) const {
        const long L = (long)i * G + c; if (L >= nwg) return false;
        int wgid = (int)L; { const int q = nwg / NXCD, r = nwg % NXCD, xcd = wgid % NXCD, off = wgid / NXCD; wgid = (xcd < r ? xcd * (q + 1) : r * (q + 1) + (xcd - r) * q) + off; }
        const int nig = WGM * nN, gid = wgid / nig, fm = gid * WGM, gsz = (nM - fm) < WGM ? (nM - fm) : WGM;
        u.pm = fm + ((wgid % nig) % gsz); u.pn = (wgid % nig) / gsz; u.g = 0; return true;
    }
};
struct GroupedOrder {
    int nG, nM, nN, G, c;
    __device__ void init(int nG_, int nM_, int nN_, int G_, int c_) { nG = nG_; nM = nM_; nN = nN_; G = G_; c = c_; }
    __device__ bool next(int i, Unit& u) const {
        const long L = (long)i * G + c; if (L >= (long)nG * nM * nN) return false;
        const int per = nM * nN, r = (int)(L % per); u.g = (int)(L / per); u.pn = r / nM; u.pm = r % nM; return true;
    }
};

__device__ __forceinline__ unsigned cvt_pk_bf16(float lo, float hi) { unsigned r; asm volatile("v_cvt_pk_bf16_f32 %0, %1, %2" : "=v"(r) : "v"(lo), "v"(hi)); return r; }
__device__ __forceinline__ float sigmoidf_fast(float x) { return __builtin_amdgcn_rcpf(1.0f + __builtin_amdgcn_exp2f(-1.44269504089f * x)); }
__device__ __forceinline__ float gelu_tanh(float y) { const float z = 0.7978845608f * (y + 0.044715f * y * y * y); return y * sigmoidf_fast(2.0f * z); }

struct EpiF32G {
    static constexpr bool PERM = false;
    float* C; int ldc; size_t gsC;
    __device__ __forceinline__ void operator()(const f32x4 (&acc)[2][2][4][2], const Unit& u, int wr, int wc, int fr, int fq) const {
        const int row0 = u.pm * BM + wr * 64 + fr, col0 = u.pn * BM + wc * 32 + 4 * fq; float* rowp = C + (size_t)u.g * gsC + (size_t)row0 * ldc + col0;
#pragma unroll
        for (int ai = 0; ai < 2; ++ai) {
#pragma unroll
            for (int m = 0; m < 4; ++m) {
#pragma unroll
                for (int bj = 0; bj < 2; ++bj)
#pragma unroll
                    for (int n = 0; n < 2; ++n) *(f32x4*)(rowp + bj * HALF + n * 16) = acc[ai][bj][m][n];
                asm volatile("" : "+v"(rowp)); rowp += (size_t)16 * ldc; }
            rowp += (size_t)64 * ldc; }
    }
};
struct EpiBf16G {
    static constexpr bool PERM = true;
    bf16_t* O; int ldc; size_t gsO;
    __device__ __forceinline__ void operator()(const f32x4 (&acc)[2][2][4][2], const Unit& u, int wr, int wc, int fr, int fq) const {
        const int row0 = u.pm * BM + wr * 64 + fr, col0 = u.pn * BM + wc * 32 + 8 * fq; bf16_t* rowp = O + (size_t)u.g * gsO + (size_t)row0 * ldc + col0;
#pragma unroll
        for (int ai = 0; ai < 2; ++ai) {
#pragma unroll
            for (int m = 0; m < 4; ++m) {
#pragma unroll
                for (int bj = 0; bj < 2; ++bj) { const f32x4 v0 = acc[ai][bj][m][0], v1 = acc[ai][bj][m][1];
                    u32x4 w; w.x = cvt_pk_bf16(v0[0], v0[1]); w.y = cvt_pk_bf16(v0[2], v0[3]); w.z = cvt_pk_bf16(v1[0], v1[1]); w.w = cvt_pk_bf16(v1[2], v1[3]);
                    *(u32x4*)(rowp + bj * HALF) = w; }
                asm volatile("" : "+v"(rowp)); rowp += (size_t)16 * ldc; }
            rowp += (size_t)64 * ldc; }
    }
};
struct EpiGeluZ {
    static constexpr bool PERM = true;
    bf16_t* Z;
    __device__ __forceinline__ void operator()(const f32x4 (&acc)[2][2][4][2], const Unit& u, int wr, int wc, int fr, int fq) const {
        bf16_t* rowp = Z + ((size_t)(u.pm * 4096 + (wr * 64 + fr) * 16 + 2 * wc + (fq >> 1))) * 2048 + u.g * 16 + 8 * (fq & 1);
#pragma unroll
        for (int ai = 0; ai < 2; ++ai) {
#pragma unroll
            for (int m = 0; m < 4; ++m) {
#pragma unroll
                for (int bj = 0; bj < 2; ++bj) {
                    const f32x4 v0 = acc[ai][bj][m][0], v1 = acc[ai][bj][m][1];
                    u32x4 w; w.x = cvt_pk_bf16(gelu_tanh(v0[0]), gelu_tanh(v0[1])); w.y = cvt_pk_bf16(gelu_tanh(v0[2]), gelu_tanh(v0[3]));
                    w.z = cvt_pk_bf16(gelu_tanh(v1[0]), gelu_tanh(v1[1])); w.w = cvt_pk_bf16(gelu_tanh(v1[2]), gelu_tanh(v1[3]));
                    *(u32x4*)(rowp + (size_t)bj * 8 * 2048) = w; }
                asm volatile("" : "+v"(rowp)); rowp += (size_t)16 * 16 * 2048; }
            rowp += (size_t)64 * 16 * 2048; }
    }
};
struct EpiGlu {
    static constexpr bool PERM = true;
    bf16_t* O; int ldc;
    __device__ __forceinline__ void operator()(const f32x4 (&acc)[2][2][4][2], const Unit& u, int wr, int wc, int fr, int fq) const {
        const int row0 = u.pm * BM + wr * 64 + fr, col0 = u.pn * HALF + wc * 32 + 8 * fq; bf16_t* rowp = O + (size_t)row0 * ldc + col0;
#pragma unroll
        for (int ai = 0; ai < 2; ++ai) {
#pragma unroll
            for (int m = 0; m < 4; ++m) {
                const f32x4 v0 = acc[ai][0][m][0], v1 = acc[ai][0][m][1], g0 = acc[ai][1][m][0], g1 = acc[ai][1][m][1];
                u32x4 w; w.x = cvt_pk_bf16(v0[0] * sigmoidf_fast(g0[0]), v0[1] * sigmoidf_fast(g0[1])); w.y = cvt_pk_bf16(v0[2] * sigmoidf_fast(g0[2]), v0[3] * sigmoidf_fast(g0[3]));
                w.z = cvt_pk_bf16(v1[0] * sigmoidf_fast(g1[0]), v1[1] * sigmoidf_fast(g1[1])); w.w = cvt_pk_bf16(v1[2] * sigmoidf_fast(g1[2]), v1[3] * sigmoidf_fast(g1[3]));
                *(u32x4*)rowp = w;
                asm volatile("" : "+v"(rowp)); rowp += (size_t)16 * ldc; }
            rowp += (size_t)64 * ldc; }
    }
};

template <class Epi, class Sched, bool ALIGN_EPI = false, bool SP2 = false>
__device__ __forceinline__ void gemm_phase(PG8_LAS unsigned char* lds, const Gemm g, const Sched& S, const Epi& E, const int tid) {
    const int wid = __builtin_amdgcn_readfirstlane(tid >> 6), lane = tid & 63, wr = wid >> 2, wc = wid & 3, fr = lane & 15, fq = lane >> 4;
    const int K = g.K, nt = K / BK;
    unsigned voffA[2], voffB[2];
#pragma unroll
    for (int i = 0; i < 2; ++i) { int R, C; stage_rc(tid * 16 + i * 8192, R, C); const int Rb = Epi::PERM ? ((R & ~31) + perm32(R & 31)) : R;
        voffA[i] = (unsigned)(R * g.lda + C) * 2u; voffB[i] = (unsigned)(Rb * g.ldb + C) * 2u; }
    const size_t kstep = (size_t)(BK * 2);
    const size_t hstepA = (size_t)HALF * g.lda * 2, hstepB = (size_t)HALF * g.ldb * 2;
    const size_t tstepA = 2 * hstepA, tstepB = 2 * hstepB;
    const unsigned ldsw = (unsigned)wid * 1024u;
    const int aoff = lds_byte(wr * 64 + fr, fq * 8), boff = lds_byte(wc * 32 + fr, fq * 8);
#define PG8_SA(b, h) (((b) * 2 + (h)) * HTB)
#define PG8_SB(b, h) ((4 + (b) * 2 + (h)) * HTB)
#define PG8_STAGE(bufoff, gbase, voff) do { _Pragma("unroll") for (int _i = 0; _i < 2; ++_i) \
        __builtin_amdgcn_global_load_lds((const unsigned*)((const char*)(gbase) + (voff)[_i]), (PG8_LAS unsigned*)(lds + (bufoff) + ldsw + _i * 8192), 16, 0, 0); } while (0)
#define PG8_LDA(dst, b, h) do { _Pragma("unroll") for (int m = 0; m < 4; ++m) _Pragma("unroll") for (int k = 0; k < 2; ++k) dst[m][k] = *(const PG8_LAS bf16x8*)(lds + PG8_SA(b, h) + aoff + m * 2048 + k * 1024); } while (0)
#define PG8_LDB(dst, b, h) do { _Pragma("unroll") for (int n = 0; n < 2; ++n) _Pragma("unroll") for (int k = 0; k < 2; ++k) dst[n][k] = *(const PG8_LAS bf16x8*)(lds + PG8_SB(b, h) + boff + n * 2048 + k * 1024); } while (0)
#define PG8_MMA(ai, bj, At, Bt) do { __builtin_amdgcn_s_setprio(1); _Pragma("unroll") for (int m = 0; m < 4; ++m) _Pragma("unroll") for (int n = 0; n < 2; ++n) _Pragma("unroll") for (int k = 0; k < 2; ++k) \
        acc[ai][bj][m][n] = __builtin_amdgcn_mfma_f32_16x16x32_bf16(Bt[n][k], At[m][k], acc[ai][bj][m][n], 0, 0, 0); __builtin_amdgcn_s_setprio(0); } while (0)
#define PG8_WAIT_V(n) asm volatile("s_waitcnt vmcnt(" #n ")" ::: "memory")
#define PG8_WAIT_L(n) asm volatile("s_waitcnt lgkmcnt(" #n ")" ::: "memory")
#define PG8_BAR __builtin_amdgcn_s_barrier()
#define PG8_SCHED __builtin_amdgcn_sched_barrier(0)
    Unit cur, nxt; int ui = 0;
    if (!S.next(0, cur)) return;
    f32x4 acc[2][2][4][2];
#pragma unroll
    for (int a = 0; a < 2; ++a)
#pragma unroll
        for (int b = 0; b < 2; ++b)
#pragma unroll
            for (int m = 0; m < 4; ++m)
#pragma unroll
                for (int n = 0; n < 2; ++n) acc[a][b][m][n] = (f32x4){0.f, 0.f, 0.f, 0.f};
    bf16x8 At[4][2], B0[2][2], B1[2][2];
    const char* cA = (const char*)g.A + ((size_t)cur.g * g.gsA) * 2 + (size_t)cur.pm * tstepA; const char* cB = (const char*)g.Bt + ((size_t)cur.g * g.gsB) * 2 + (size_t)cur.pn * tstepB;
    if constexpr (SP2) {
        PG8_STAGE(PG8_SB(0, 0), cB, voffB); PG8_STAGE(PG8_SB(0, 1), cB + hstepB, voffB); PG8_STAGE(PG8_SA(0, 0), cA, voffA); PG8_STAGE(PG8_SA(0, 1), cA + hstepA, voffA);
        if (wr == 1) PG8_BAR;
        PG8_WAIT_V(2); PG8_BAR;
        PG8_STAGE(PG8_SB(1, 0), cB + kstep, voffB); PG8_STAGE(PG8_SA(1, 0), cA + kstep, voffA); PG8_STAGE(PG8_SB(1, 1), cB + hstepB + kstep, voffB);
        PG8_WAIT_V(6); PG8_BAR;
    } else {
        PG8_STAGE(PG8_SB(0, 0), cB, voffB); PG8_STAGE(PG8_SA(0, 0), cA, voffA); PG8_STAGE(PG8_SB(0, 1), cB + hstepB, voffB); PG8_STAGE(PG8_SA(0, 1), cA + hstepA, voffA);
        if (wr == 1) PG8_BAR;
        PG8_WAIT_V(4); PG8_BAR;
        PG8_STAGE(PG8_SB(1, 0), cB + kstep, voffB); PG8_STAGE(PG8_SA(1, 0), cA + kstep, voffA); PG8_STAGE(PG8_SB(1, 1), cB + hstepB + kstep, voffB);
        PG8_WAIT_V(6); PG8_BAR;
    }
    for (;;) {
        const bool has_next = S.next(ui + 1, nxt);
        const char* nA = has_next ? (const char*)g.A + ((size_t)nxt.g * g.gsA) * 2 + (size_t)nxt.pm * tstepA : cA; const char* nB = has_next ? (const char*)g.Bt + ((size_t)nxt.g * g.gsB) * 2 + (size_t)nxt.pn * tstepB : cB;
        for (int t = 0; t < nt; t += 2) {
            const bool last = (t == nt - 2);
            const char* a1 = cA + (size_t)(t + 1) * kstep;
            const char* a2 = last ? nA : cA + (size_t)(t + 2) * kstep; const char* b2 = last ? nB : cB + (size_t)(t + 2) * kstep;
            const char* a3 = a2 + kstep; const char* b3 = b2 + kstep;
            if constexpr (SP2) {
            PG8_LDB(B0, 0, 0); PG8_LDB(B1, 0, 1); PG8_SCHED; PG8_LDA(At, 0, 0); PG8_STAGE(PG8_SA(1, 1), a1 + hstepA, voffA);
            PG8_WAIT_V(8); PG8_WAIT_L(0); PG8_BAR; PG8_MMA(0, 0, At, B0); PG8_MMA(0, 1, At, B1); PG8_BAR; PG8_SCHED;
            PG8_LDA(At, 0, 1); PG8_STAGE(PG8_SB(0, 0), b2, voffB); PG8_STAGE(PG8_SB(0, 1), b2 + hstepB, voffB); PG8_STAGE(PG8_SA(0, 0), a2, voffA);
            PG8_WAIT_V(8); PG8_WAIT_L(0); PG8_BAR; PG8_MMA(1, 0, At, B0); PG8_MMA(1, 1, At, B1); PG8_BAR; PG8_SCHED;
            PG8_LDB(B0, 1, 0); PG8_LDB(B1, 1, 1); PG8_SCHED; PG8_LDA(At, 1, 0); PG8_STAGE(PG8_SA(0, 1), a2 + hstepA, voffA);
            PG8_WAIT_V(8); PG8_WAIT_L(0); PG8_BAR; PG8_MMA(0, 0, At, B0); PG8_MMA(0, 1, At, B1); PG8_BAR; PG8_SCHED;
            PG8_LDA(At, 1, 1); PG8_STAGE(PG8_SB(1, 0), b3, voffB); PG8_STAGE(PG8_SB(1, 1), b3 + hstepB, voffB); PG8_STAGE(PG8_SA(1, 0), a3, voffA);
            PG8_WAIT_V(8); PG8_WAIT_L(0); PG8_BAR; PG8_MMA(1, 0, At, B0); PG8_MMA(1, 1, At, B1); PG8_BAR; PG8_SCHED;
            } else {
            PG8_LDB(B0, 0, 0); PG8_SCHED; PG8_LDA(At, 0, 0); PG8_STAGE(PG8_SA(1, 1), a1 + hstepA, voffA);
            PG8_WAIT_L(8); PG8_BAR; PG8_WAIT_L(0); PG8_MMA(0, 0, At, B0); PG8_BAR; PG8_SCHED;
            PG8_LDB(B1, 0, 1); PG8_STAGE(PG8_SB(0, 0), b2, voffB);
            PG8_BAR; PG8_WAIT_L(0); PG8_MMA(0, 1, At, B1); PG8_BAR;
            PG8_LDA(At, 0, 1); PG8_STAGE(PG8_SA(0, 0), a2, voffA);
            PG8_BAR; PG8_WAIT_L(0); PG8_MMA(1, 0, At, B0); PG8_BAR; PG8_SCHED;
            PG8_STAGE(PG8_SB(0, 1), b2 + hstepB, voffB);
            PG8_WAIT_V(6); PG8_BAR; PG8_MMA(1, 1, At, B1); PG8_BAR;
            PG8_LDB(B0, 1, 0); PG8_SCHED; PG8_LDA(At, 1, 0); PG8_STAGE(PG8_SA(0, 1), a2 + hstepA, voffA);
            PG8_WAIT_L(8); PG8_BAR; PG8_WAIT_L(0); PG8_MMA(0, 0, At, B0); PG8_BAR; PG8_SCHED;
            PG8_LDB(B1, 1, 1); PG8_STAGE(PG8_SB(1, 0), b3, voffB);
            PG8_BAR; PG8_WAIT_L(0); PG8_MMA(0, 1, At, B1); PG8_BAR;
            PG8_LDA(At, 1, 1); PG8_STAGE(PG8_SA(1, 0), a3, voffA);
            PG8_BAR; PG8_WAIT_L(0); PG8_MMA(1, 0, At, B0); PG8_BAR; PG8_SCHED;
            PG8_STAGE(PG8_SB(1, 1), b3 + hstepB, voffB);
            PG8_WAIT_V(6); PG8_BAR; PG8_MMA(1, 1, At, B1); PG8_BAR;
            }
        }
        if constexpr (ALIGN_EPI) { if (wr == 0) PG8_BAR; }
        E(acc, cur, wr, wc, fr, fq);
        if (!has_next) break;
#pragma unroll
        for (int a = 0; a < 2; ++a)
#pragma unroll
            for (int b = 0; b < 2; ++b)
#pragma unroll
                for (int m = 0; m < 4; ++m)
#pragma unroll
                    for (int n = 0; n < 2; ++n) acc[a][b][m][n] = (f32x4){0.f, 0.f, 0.f, 0.f};
        cur = nxt; cA = nA; cB = nB; ++ui;
        if constexpr (ALIGN_EPI) { if (wr == 1) PG8_BAR; }
    }
    PG8_WAIT_V(0);
    if constexpr (!ALIGN_EPI) { if (wr == 0) PG8_BAR; }
    PG8_BAR;
#undef PG8_SA
#undef PG8_SB
#undef PG8_STAGE
#undef PG8_LDA
#undef PG8_LDB
#undef PG8_MMA
#undef PG8_WAIT_V
#undef PG8_WAIT_L
#undef PG8_BAR
#undef PG8_SCHED
}
}

constexpr int NWAVES = 8, NTHR = NWAVES * 64;
constexpr int DM = 2048, NBATCH = 2, SEQ = 4096, CTX = 256, MT = NBATCH * SEQ, MC = NBATCH * CTX, DFF = 5632, DFF2 = 2 * DFF, NMODC = 6 * DM, NG = 128;
constexpr float RMS_EPS = 1e-6f;
constexpr int NPHASE = 17;

constexpr size_t MiB = 1u << 20;
constexpr size_t WS_CTL = 0, CTL_ZERO_BYTES = 1 * MiB;
constexpr size_t WS_MODP = 1 * MiB;
constexpr size_t WS_A16 = 4 * MiB;
constexpr size_t WS_WGLU = 5 * MiB;
constexpr size_t WS_WUP = 21 * MiB;
constexpr size_t WS_WDN = 109 * MiB;
constexpr size_t WS_WPOOL = 153 * MiB;
constexpr size_t WS_UZ = 155 * MiB;
constexpr size_t WS_YF = 187 * MiB;
constexpr size_t WS_ACT = 219 * MiB;
constexpr size_t WS_H = 307 * MiB;
constexpr size_t WS_WIN = 307 * MiB;
constexpr size_t WS_W2 = 323 * MiB;
constexpr size_t WS_A2 = 355 * MiB;
constexpr size_t WS_UCG = 419 * MiB;
constexpr size_t WS_SLOC = 421 * MiB;
constexpr size_t WS_SCLOC = 485 * MiB;
constexpr size_t WS_END = 489 * MiB;
static_assert(WS_H + (size_t)MT * DFF2 * 2 <= WS_END && WS_SCLOC + (size_t)NG * 32 * 256 * 4 <= WS_END, "d_ws map");
constexpr int CW_BAR = 4096;

constexpr int RING_OFF = 0, RING_BYTES = 131072;
constexpr int LDSCTL_OFF = RING_BYTES, MISC_OFF = LDSCTL_OFF + 320, PTR_OFF = LDSCTL_OFF + 1024;
constexpr int LDS_BYTES = 147456;

#define GAS __attribute__((address_space(1)))
#define LAS __attribute__((address_space(3)))
typedef unsigned short bf16;
typedef unsigned v4u __attribute__((ext_vector_type(4)));
typedef unsigned v2u __attribute__((ext_vector_type(2)));
typedef float f32x4 __attribute__((ext_vector_type(4)));
typedef short bf16x8 __attribute__((ext_vector_type(8)));
typedef float f32x16 __attribute__((ext_vector_type(16)));
#define LDS_WAIT() asm volatile("s_waitcnt lgkmcnt(0)" ::: "memory")
#define VM_WAIT() asm volatile("s_waitcnt vmcnt(0)" ::: "memory")
__device__ __forceinline__ unsigned f2bf(float f) { unsigned u = __builtin_bit_cast(unsigned, f); return (u + 0x7fffu + ((u >> 16) & 1u)) >> 16; }
__device__ __forceinline__ unsigned pk2(float lo, float hi) { return f2bf(lo) | (f2bf(hi) << 16); }
__device__ __forceinline__ float bf_lo(unsigned w) { return __builtin_bit_cast(float, w << 16); }
__device__ __forceinline__ float bf_hi(unsigned w) { return __builtin_bit_cast(float, w & 0xffff0000u); }
__device__ __forceinline__ float sigm(float x) { return __builtin_amdgcn_rcpf(1.0f + __builtin_amdgcn_exp2f(-1.44269504089f * x)); }

#define XB_TMO      128
#define XB_XCNT(j)  (256  + 64 * (j))
#define XB_XSUB(j)  (1280 + 64 * (j))
#define XB_XGEN(j)  (2304 + 64 * (j))
#define XB_TOP      3328
#define XB_TOPGEN   3392
#define XCD_BAR_WORDS 3456
#define XB_SPIN_CAP (1u << 20)
__device__ __forceinline__ unsigned xb_ld(unsigned* p)              { return __hip_atomic_load(p, __ATOMIC_RELAXED, __HIP_MEMORY_SCOPE_AGENT); }
__device__ __forceinline__ unsigned xb_add(unsigned* p, unsigned v) { return __hip_atomic_fetch_add(p, v, __ATOMIC_RELAXED, __HIP_MEMORY_SCOPE_AGENT); }
__device__ __forceinline__ unsigned xb_xcc_id() { return (unsigned)__builtin_amdgcn_s_getreg((3 << 11) | 20) & 0xFu; }
#define XB_SPIN(cond, bar) do { unsigned _sp = 0; while (cond) { __builtin_amdgcn_s_sleep(1); \
    if ((++_sp & 255u) == 0u) { if (xb_ld(&(bar)[XB_TMO])) break; if (_sp > XB_SPIN_CAP) { atomicAdd(&(bar)[XB_TMO], 1u); break; } } } } while (0)
struct XcdBarrier { unsigned* bar; unsigned x; volatile LAS unsigned* st; };
__device__ __forceinline__ XcdBarrier xcd_barrier_post(unsigned* bar, volatile LAS unsigned* st) {
    XcdBarrier b; b.bar = bar; b.x = xb_xcc_id(); b.st = st;
    if (threadIdx.x == 0) (void)xb_add(&bar[XB_XCNT(b.x)], 1u);
    return b;
}
__device__ __forceinline__ void xcd_barrier_complete(unsigned* bar, unsigned x, unsigned& nloc, unsigned& nx) {
    const unsigned G = gridDim.x * gridDim.y * gridDim.z;
    unsigned sum, cnt, mine, sp = 0u;
    for (;;) {
        sum = 0u; cnt = 0u; mine = 0u;
#pragma unroll
        for (unsigned j = 0; j < 16; ++j) { const unsigned c = xb_ld(&bar[XB_XCNT(j)]); sum += c; cnt += (c > 0u) ? 1u : 0u; mine = (j == x) ? c : mine; }
        if (sum == G) break;
        __builtin_amdgcn_s_sleep(1);
        if ((++sp & 255u) == 0u) { if (xb_ld(&bar[XB_TMO])) break; if (sp > XB_SPIN_CAP) { atomicAdd(&bar[XB_TMO], 1u); break; } }
    }
    nloc = mine > 0u ? mine : 1u; nx = cnt > 0u ? cnt : 1u;
}
__device__ __forceinline__ void xcd_barrier(const XcdBarrier& b) {
    asm volatile("s_waitcnt vmcnt(0)" ::: "memory");
    __syncthreads();
    if (threadIdx.x == 0) {
        unsigned* bar = b.bar;
        __builtin_amdgcn_s_waitcnt(0);
        unsigned nloc = b.st[0], nx = b.st[1];
        if (nloc == 0u) { xcd_barrier_complete(bar, b.x, nloc, nx); b.st[0] = nloc; b.st[1] = nx; }
        const unsigned old = xb_add(&bar[XB_XSUB(b.x)], 1u);
        const unsigned gen = old / nloc;
        if (old + 1u == (gen + 1u) * nloc) {
            __builtin_amdgcn_fence(__ATOMIC_RELEASE, "agent");
            asm volatile("s_waitcnt vmcnt(0)" ::: "memory");
            const unsigned og = xb_add(&bar[XB_TOP], 1u);
            const unsigned tg = og / nx;
            if (og + 1u == (tg + 1u) * nx) xb_add(&bar[XB_TOPGEN], 1u);
            else XB_SPIN(xb_ld(&bar[XB_TOPGEN]) == tg, bar);
            __builtin_amdgcn_fence(__ATOMIC_ACQUIRE, "agent");
            xb_add(&bar[XB_XGEN(b.x)], 1u);
            asm volatile("s_waitcnt vmcnt(0)" ::: "memory");
        } else {
            XB_SPIN(xb_ld(&bar[XB_XGEN(b.x)]) == gen, bar);
            __builtin_amdgcn_fence(__ATOMIC_ACQUIRE, "agent");
            asm volatile("s_waitcnt vmcnt(0)" ::: "memory");
        }
    }
    __syncthreads();
}

struct Args { const float* in[22]; float* out; unsigned char* ws; int ph_lo, ph_hi, li, pad; };
struct Frame {
    LAS unsigned char* lds;
    int tid, lane, wave, vcu, G;
    float* out; unsigned char* ws;
    __device__ __forceinline__ const float* inp(int i) const { return *(const float* LAS*)(lds + PTR_OFF + 8 * i); }
};
enum { I_X = 0, I_C, I_CTX, I_CCTX, I_ADAW, I_ADAB, I_NORMG, I_LAMRE, I_LAMIM, I_LOGSTEP, I_BRE, I_BIM, I_CRE, I_CIM, I_S5D, I_GLUW, I_POOLW, I_POOLS, I_UP, I_CONV, I_CONVB, I_DOWN };

__device__ __forceinline__ float wave_sum(float v) {
#pragma unroll
    for (int o = 1; o < 64; o <<= 1) v += __shfl_xor(v, o);
    return v;
}

__device__ __forceinline__ void sincos_d(double x, double& s, double& c) {
    const double q = __builtin_rint(x * 0.63661977236758134308);
    double r = __builtin_fma(-q, 1.57079632679489655800e+00, x); r = __builtin_fma(-q, 6.12323399573676603587e-17, r);
    const int iq = ((int)q) & 3; const double r2 = r * r;
    double sp = 1.0 / 6227020800.0; sp = sp * r2 - 1.0 / 39916800.0; sp = sp * r2 + 1.0 / 362880.0; sp = sp * r2 - 1.0 / 5040.0; sp = sp * r2 + 1.0 / 120.0; sp = sp * r2 - 1.0 / 6.0; sp = sp * r2 + 1.0; sp *= r;
    double cp = -1.0 / 87178291200.0; cp = cp * r2 + 1.0 / 479001600.0; cp = cp * r2 - 1.0 / 3628800.0; cp = cp * r2 + 1.0 / 40320.0; cp = cp * r2 - 1.0 / 720.0; cp = cp * r2 + 1.0 / 24.0; cp = cp * r2 - 0.5; cp = cp * r2 + 1.0;
    s = (iq == 0) ? sp : (iq == 1) ? cp : (iq == 2) ? -sp : -cp;
    c = (iq == 0) ? cp : (iq == 1) ? -sp : (iq == 2) ? -cp : sp;
}
__device__ __forceinline__ double exp_d(double x) {
    const double n = __builtin_rint(x * 1.44269504088896340736);
    double r = __builtin_fma(-n, 6.93147180369123816490e-01, x); r = __builtin_fma(-n, 1.90821492927058770002e-10, r);
    double p = 1.0 / 479001600.0;
    p = p * r + 1.0 / 39916800.0; p = p * r + 1.0 / 3628800.0; p = p * r + 1.0 / 362880.0; p = p * r + 1.0 / 40320.0; p = p * r + 1.0 / 5040.0; p = p * r + 1.0 / 720.0;
    p = p * r + 1.0 / 120.0; p = p * r + 1.0 / 24.0; p = p * r + 1.0 / 6.0; p = p * r + 0.5; p = p * r + 1.0; p = p * r + 1.0;
    return __builtin_ldexp(p, (int)n);
}

template <int MODE>
__device__ __forceinline__ void p0_transpose_item(const float* W, int K, int N, bf16* WT, LAS float* scr, int item, int lane) {
    const int nblk = N / 32, kb = item / nblk, nb = item % nblk, k0 = 64 * kb, n0 = 32 * nb;
#pragma unroll 8
    for (int i = 0; i < 32; ++i) { const int kk = 2 * i + (lane >> 5); scr[kk * 33 + (lane & 31)] = W[(size_t)(k0 + kk) * N + n0 + (lane & 31)]; }
    LDS_WAIT(); asm volatile("" ::: "memory");
    const int c = lane & 7;
    int r0 = n0;
    if (MODE == 1) { r0 = (n0 < 2048) ? (256 * (n0 >> 7) + (n0 & 127)) : (256 * ((n0 - 2048) >> 7) + 128 + ((n0 - 2048) & 127)); }
#pragma unroll
    for (int j = 0; j < 4; ++j) { const int n = (lane >> 3) + 8 * j; const LAS float* s = scr + (8 * c) * 33 + n;
        v4u o; o.x = pk2(s[0 * 33], s[1 * 33]); o.y = pk2(s[2 * 33], s[3 * 33]); o.z = pk2(s[4 * 33], s[5 * 33]); o.w = pk2(s[6 * 33], s[7 * 33]);
        *(GAS v4u*)(WT + (size_t)(r0 + n) * K + k0 + 8 * c) = o; }
    LDS_WAIT(); asm volatile("" ::: "memory");
}

__device__ __forceinline__ void p0_ada_item(Frame& F, int it) {
    LAS float* cond = (LAS float*)(F.lds);
    LAS float* red = (LAS float*)(F.lds + 24576);
    const int l = it / 384, r = it % 384, s = r / 48, ct = r % 48, k0 = s * 256 + F.wave * 32, n0 = ct * 256;
    const float* W = F.inp(I_ADAW) + (size_t)l * DM * NMODC + (size_t)k0 * NMODC + n0 + 4 * F.lane;
    f32x4 a0 = {0.f, 0.f, 0.f, 0.f}, a1 = a0, a2 = a0;
#pragma unroll 8
    for (int i = 0; i < 32; ++i) { const f32x4 w = *(const GAS f32x4*)(W + (size_t)i * NMODC);
        const float c0 = cond[k0 + i], c1 = cond[2048 + k0 + i], c2 = cond[4096 + k0 + i];
        a0 += w * c0; a1 += w * c1; a2 += w * c2; }
    *(LAS f32x4*)(red + (F.wave * 3 + 0) * 256 + 4 * F.lane) = a0;
    *(LAS f32x4*)(red + (F.wave * 3 + 1) * 256 + 4 * F.lane) = a1;
    *(LAS f32x4*)(red + (F.wave * 3 + 2) * 256 + 4 * F.lane) = a2;
    __syncthreads();
    float* MODP = (float*)(F.ws + WS_MODP);
    for (int o = F.tid; o < 768; o += NTHR) { const int v = o >> 8, col = o & 255; float sum = 0.f;
#pragma unroll
        for (int w = 0; w < 8; ++w) sum += red[(w * 3 + v) * 256 + col];
        MODP[((size_t)(l * 8 + s) * 3 + v) * NMODC + n0 + col] = sum; }
    __syncthreads();
}

__device__ __forceinline__ void p0_s5_item(Frame& F, int g) {
    LAS float* APR = (LAS float*)(F.lds);
    LAS float* API = APR + 2176;
    LAS float* BBR = API + 2176;
    LAS float* BBI = BBR + 2048;
    LAS float* CCR = BBI + 2048;
    LAS float* CCI = CCR + 2048;
    LAS float* KT = CCI + 2048;
    const float* lam_re = F.inp(I_LAMRE); const float* lam_im = F.inp(I_LAMIM); const float* logst = F.inp(I_LOGSTEP);
    for (int idx = F.tid; idx < 2176; idx += NTHR) { const int p = idx & 63, dk = idx >> 6, d = dk / 17, k = dk % 17;
        const double dt = exp_d((double)logst[d * NG + g]); const double lr = (double)lam_re[(d * NG + g) * 64 + p], li = (double)lam_im[(d * NG + g) * 64 + p];
        const double mag = exp_d((double)k * lr * dt); double sn, cs; sincos_d((double)k * li * dt, sn, cs);
        APR[idx] = (float)(mag * cs); API[idx] = (float)(mag * sn); }
    for (int idx = F.tid; idx < 2048; idx += NTHR) { const int c = idx & 15, dp = idx >> 4, d = dp >> 6, p = dp & 63;
        const double dt = exp_d((double)logst[d * NG + g]); const double lr = (double)lam_re[(d * NG + g) * 64 + p], li = (double)lam_im[(d * NG + g) * 64 + p];
        const double mag = exp_d(lr * dt); double sn, cs; sincos_d(li * dt, sn, cs);
        const double nr = mag * cs - 1.0, ni = mag * sn, den = lr * lr + li * li;
        const double fr = (nr * lr + ni * li) / den, fi = (ni * lr - nr * li) / den;
        const size_t bi = ((size_t)(d * NG + g) * 64 + p) * 16 + c; const double br = (double)F.inp(I_BRE)[bi], bim = (double)F.inp(I_BIM)[bi];
        BBR[idx] = (float)(fr * br - fi * bim); BBI[idx] = (float)(fr * bim + fi * br);
        const int cc = idx >> 6, pp = idx & 63;
        const int d2 = cc >> 4, c2 = cc & 15; const size_t ci = ((size_t)(d2 * NG + g) * 16 + c2) * 64 + pp;
        CCR[idx] = F.inp(I_CRE)[ci]; CCI[idx] = F.inp(I_CIM)[ci]; }
    __syncthreads();
    bf16* WIN = (bf16*)(F.ws + WS_WIN) + (size_t)g * 256 * 256;
    for (int q = F.tid; q < 8192; q += NTHR) { const int n = q >> 5, kc = q & 31, d = n >> 7, part = (n >> 6) & 1, p = n & 63, j = kc >> 1, c0 = 8 * (kc & 1);
        const int e = d == 0 ? 15 - j : j; const float ar = APR[(d * 17 + e) * 64 + p], ai = API[(d * 17 + e) * 64 + p];
        float v[8];
#pragma unroll
        for (int x = 0; x < 8; ++x) { const float br = BBR[(d * 64 + p) * 16 + c0 + x], bi = BBI[(d * 64 + p) * 16 + c0 + x]; v[x] = part == 0 ? ar * br - ai * bi : ar * bi + ai * br; }
        v4u o; o.x = pk2(v[0], v[1]); o.y = pk2(v[2], v[3]); o.z = pk2(v[4], v[5]); o.w = pk2(v[6], v[7]);
        *(GAS v4u*)(WIN + (size_t)n * 256 + 8 * kc) = o; }
    for (int idx = F.tid; idx < 8192; idx += NTHR) { const int c = idx & 15, cp = (idx >> 4) & 15, tau = (idx >> 8) & 15, d = idx >> 12; float s = 0.f;
        for (int p = 0; p < 64; ++p) { const float cr = CCR[(d * 16 + cp) * 64 + p], ci = CCI[(d * 16 + cp) * 64 + p], ar = APR[(d * 17 + tau) * 64 + p], ai = API[(d * 17 + tau) * 64 + p];
            const float mr = cr * ar - ci * ai, mi = cr * ai + ci * ar; s += mr * BBR[(d * 64 + p) * 16 + c] - mi * BBI[(d * 64 + p) * 16 + c]; }
        KT[idx] = s; }
    __syncthreads();
    bf16* W2 = (bf16*)(F.ws + WS_W2) + (size_t)g * 256 * 512;
    const float* dsk = F.inp(I_S5D) + g * 16;
    for (int q = F.tid; q < 16384; q += NTHR) { const int n = q >> 6, kc = q & 63, jp = n >> 4, cp = n & 15; float v[8];
        if (kc < 32) { const int d = kc >> 4, part = (kc >> 3) & 1, p0 = 8 * (kc & 7), e = d == 0 ? jp + 1 : 16 - jp;
#pragma unroll
            for (int x = 0; x < 8; ++x) { const int p = p0 + x; const float cr = CCR[(d * 16 + cp) * 64 + p], ci = CCI[(d * 16 + cp) * 64 + p], ar = APR[(d * 17 + e) * 64 + p], ai = API[(d * 17 + e) * 64 + p];
                v[x] = part == 0 ? cr * ar - ci * ai : -(cr * ai + ci * ar); }
        } else { const int j = (kc - 32) >> 1, c0 = 8 * ((kc - 32) & 1);
#pragma unroll
            for (int x = 0; x < 8; ++x) { const int c = c0 + x; float s = 0.f;
                if (j <= jp) s += KT[((0 * 16 + (jp - j)) * 16 + cp) * 16 + c];
                if (j >= jp) s += KT[((1 * 16 + (j - jp)) * 16 + cp) * 16 + c];
                if (j == jp && c == cp) s += dsk[c];
                v[x] = s; } }
        v4u o; o.x = pk2(v[0], v[1]); o.y = pk2(v[2], v[3]); o.z = pk2(v[4], v[5]); o.w = pk2(v[6], v[7]);
        *(GAS v4u*)(W2 + (size_t)n * 512 + 8 * kc) = o; }
    if (F.tid < 128) { const int d = F.tid >> 6, p = F.tid & 63; float* A16 = (float*)(F.ws + WS_A16) + ((size_t)(d * NG + g) * 64 + p) * 2;
        A16[0] = APR[(d * 17 + 16) * 64 + p]; A16[1] = API[(d * 17 + 16) * 64 + p]; }
    __syncthreads();
}

__device__ __forceinline__ void p0_prologue(Frame& F) {
    for (int g = F.vcu; g < NG; g += F.G) p0_s5_item(F, g);
    { LAS float* cond = (LAS float*)(F.lds);
      for (int i = F.tid; i < 3 * DM; i += NTHR) { const float x = i < 2 * DM ? F.inp(I_C)[i] : F.inp(I_CCTX)[i - 2 * DM]; cond[i] = x * sigm(x); }
      __syncthreads();
      for (int it = F.vcu; it < 768; it += F.G) p0_ada_item(F, it); }
    __syncthreads();
    LAS float* scr = (LAS float*)(F.lds + F.wave * 16384);
    const int gw = F.vcu * NWAVES + F.wave, NGW = F.G * NWAVES;
    constexpr int I_G = (DM / 64) * (2 * DM / 32), I_U = (DM / 64) * (DFF2 / 32), I_D = (DFF / 64) * (DM / 32), I_P = (512 / 64) * (512 / 32);
    constexpr int NITEMS = I_G + 2 * I_U + 2 * I_D + 4 * I_P;
    for (int it = gw; it < NITEMS; it += NGW) {
        int r = it;
        if (r < I_G) { p0_transpose_item<1>(F.inp(I_GLUW), DM, 2 * DM, (bf16*)(F.ws + WS_WGLU), scr, r, F.lane); continue; } r -= I_G;
        if (r < 2 * I_U) { const int l = r / I_U; p0_transpose_item<0>(F.inp(I_UP) + (size_t)l * DM * DFF2, DM, DFF2, (bf16*)(F.ws + WS_WUP) + (size_t)l * DFF2 * DM, scr, r % I_U, F.lane); continue; } r -= 2 * I_U;
        if (r < 2 * I_D) { const int l = r / I_D; p0_transpose_item<0>(F.inp(I_DOWN) + (size_t)l * DFF * DM, DFF, DM, (bf16*)(F.ws + WS_WDN) + (size_t)l * DM * DFF, scr, r % I_D, F.lane); continue; } r -= 2 * I_D;
        { const int gi = r / I_P; p0_transpose_item<0>(F.inp(I_POOLW) + (size_t)gi * 512 * 512, 512, 512, (bf16*)(F.ws + WS_WPOOL) + (size_t)gi * 512 * 512, scr, r % I_P, F.lane); }
    }
}

__device__ __forceinline__ void load_mod(Frame& F, int l, int v, int q, LAS float* dst) {
    const float* MODP = (const float*)(F.ws + WS_MODP); const int col = q * DM + 4 * F.tid;
    f32x4 s = *(const GAS f32x4*)(F.inp(I_ADAB) + l * NMODC + col);
#pragma unroll
    for (int sl = 0; sl < 8; ++sl) s += *(const GAS f32x4*)(MODP + ((size_t)(l * 8 + sl) * 3 + v) * NMODC + col);
    *(LAS f32x4*)(dst + 4 * F.tid) = s;
}

constexpr int STG_PITCH = 4112;
__device__ __forceinline__ void p1_rows(Frame& F) {
    LAS float* shiftL = (LAS float*)(F.lds + 98304);
    LAS float* scaleL = shiftL + 2048;
    LAS unsigned char* stg = F.lds;
    const float* g0 = F.inp(I_NORMG);
    int cur_vec = -1;
    for (int unit = F.vcu; unit < 544; unit += F.G) {
        const bool is_ctx = unit >= 512; const int b = is_ctx ? (unit - 512) >> 4 : unit >> 8, blk = is_ctx ? (unit - 512) & 15 : unit & 255;
        const int vec = is_ctx ? 2 : b;
        if (vec != cur_vec) { __syncthreads(); load_mod(F, 0, vec, 0, shiftL); load_mod(F, 0, vec, 1, scaleL); cur_vec = vec; }
        __syncthreads();
#pragma unroll 1
        for (int rr = 0; rr < 2; ++rr) { const int row = F.wave + 8 * rr, t = blk * 16 + row;
            const float* src = is_ctx ? F.inp(I_CTX) + ((size_t)(b * CTX + t)) * DM : F.inp(I_X) + ((size_t)(b * SEQ + t)) * DM;
            f32x4 v[8]; float ss = 0.f;
#pragma unroll
            for (int j = 0; j < 8; ++j) { v[j] = *(const GAS f32x4*)(src + 4 * F.lane + 256 * j); }
            if (!is_ctx) { const float prow = (float)(t >> 6), pcol = (float)(t & 63);
#pragma unroll
                for (int j = 0; j < 8; ++j) { const float pos = j < 4 ? prow : pcol; const bool is_cos = (j & 2) != 0;
#pragma unroll
                    for (int e = 0; e < 4; ++e) { const int i = (4 * F.lane + 256 * j + e) & 511;
                        const float omega = __builtin_amdgcn_exp2f(-(float)i * (13.287712379549449f / 512.0f));
                        const float rev = pos * omega * 0.15915494309189535f;
                        v[j][e] += is_cos ? __builtin_amdgcn_cosf(rev) : __builtin_amdgcn_sinf(rev); } }
                float* dst = F.out + ((size_t)(b * SEQ + t)) * DM;
#pragma unroll
                for (int j = 0; j < 8; ++j) *(GAS f32x4*)(dst + 4 * F.lane + 256 * j) = v[j]; }
#pragma unroll
            for (int j = 0; j < 8; ++j) ss += (v[j][0] * v[j][0] + v[j][1] * v[j][1]) + (v[j][2] * v[j][2] + v[j][3] * v[j][3]);
            const float rstd = 1.0f / sqrtf(wave_sum(ss) * (1.0f / DM) + RMS_EPS);
#pragma unroll
            for (int j = 0; j < 8; ++j) { const int col = 4 * F.lane + 256 * j; const f32x4 gg = *(const GAS f32x4*)(g0 + col), sc = *(LAS f32x4*)(scaleL + col), sh = *(LAS f32x4*)(shiftL + col);
                const f32x4 u = (v[j] * rstd * gg) * (sc + 1.0f) + sh;
                v2u w; w.x = pk2(u[0], u[1]); w.y = pk2(u[2], u[3]);
                *(LAS v2u*)(stg + row * STG_PITCH + col * 2) = w; } }
        __syncthreads();
        for (int q = F.tid; q < 4096; q += NTHR) { const int g = q >> 5, jh = q & 31, j = jh >> 1, h = jh & 1;
            const v4u w = *(LAS v4u*)(stg + j * STG_PITCH + g * 32 + h * 16);
            bf16* dst = is_ctx ? (bf16*)(F.ws + WS_UCG) + ((size_t)g * 32 + b * 16 + blk) * 256 + jh * 8
                               : (bf16*)(F.ws + WS_A2) + ((size_t)g * 512 + b * 256 + blk) * 512 + 256 + jh * 8;
            *(GAS v4u*)dst = w; }
    }
    __syncthreads();
}

__device__ __forceinline__ void p2_ctx_small(Frame& F, int g) {
    const bf16* A = (const bf16*)(F.ws + WS_UCG) + (size_t)g * 32 * 256; const bf16* Bt = (const bf16*)(F.ws + WS_WIN) + (size_t)g * 256 * 256;
    const int r = F.lane & 31, h = F.lane >> 5; f32x16 acc;
#pragma unroll
    for (int i = 0; i < 16; ++i) acc[i] = 0.f;
#pragma unroll 4
    for (int ks = 0; ks < 16; ++ks) { const bf16x8 a = *(const GAS bf16x8*)(A + r * 256 + ks * 16 + 8 * h), bq = *(const GAS bf16x8*)(Bt + (size_t)(32 * F.wave + r) * 256 + ks * 16 + 8 * h);
        acc = __builtin_amdgcn_mfma_f32_32x32x16_bf16(a, bq, acc, 0, 0, 0); }
    float* O = (float*)(F.ws + WS_SCLOC) + (size_t)g * 32 * 256;
#pragma unroll
    for (int i = 0; i < 16; ++i) { const int row = (i & 3) + 8 * (i >> 2) + 4 * h; O[row * 256 + 32 * F.wave + r] = acc[i]; }
}

__device__ __forceinline__ void p3_scan(Frame& F) {
    LAS float* EX = (LAS float*)(F.lds);
    for (int item = F.vcu; item < 2 * NG; item += F.G) { const int g = item >> 1, b = item & 1;
        const int p = F.lane, d = F.wave >> 2, ch = F.wave & 3;
        const float* A16 = (const float*)(F.ws + WS_A16) + ((size_t)(d * NG + g) * 64 + p) * 2; const float ar = A16[0], ai = A16[1];
        const int row0 = d == 0 ? ch * 64 : 255 - ch * 64; const long rstep = d == 0 ? 256 : -256;
        const float* SL = (const float*)(F.ws + WS_SLOC) + ((size_t)g * 512 + b * 256 + row0) * 256 + d * 128 + p;
        const float* SC = (const float*)(F.ws + WS_SCLOC) + ((size_t)g * 32 + b * 16 + (d == 0 ? 0 : 15)) * 256 + d * 128 + p;
        float cr = 0.f, ci = 0.f;
        { const float* q = SC;
#pragma unroll 8
          for (int k = 0; k < 16; ++k) { const float xr = q[0], xi = q[64]; q += rstep;
            const float nr = ar * cr - ai * ci + xr, ni = ar * ci + ai * cr + xi; cr = nr; ci = ni; } }
        float sr = 0.f, si = 0.f;
        { const float* q = SL;
#pragma unroll 8
          for (int i = 0; i < 64; ++i) { const float xr = q[0], xi = q[64]; q += rstep;
            const float nr = ar * sr - ai * si + xr, ni = ar * si + ai * sr + xi; sr = nr; si = ni; } }
        __syncthreads();
        EX[((d * 4 + ch) * 64 + p) * 2] = sr; EX[((d * 4 + ch) * 64 + p) * 2 + 1] = si;
        __syncthreads();
        float pr = ar, pi = ai;
#pragma unroll
        for (int k = 0; k < 6; ++k) { const float nr = pr * pr - pi * pi, ni = 2.f * pr * pi; pr = nr; pi = ni; }
        for (int q = 0; q < ch; ++q) { const float er = EX[((d * 4 + q) * 64 + p) * 2], ei = EX[((d * 4 + q) * 64 + p) * 2 + 1];
            const float nr = pr * cr - pi * ci + er, ni = pr * ci + pi * cr + ei; cr = nr; ci = ni; }
        bf16* OUT = (bf16*)(F.ws + WS_A2) + ((size_t)g * 512 + b * 256 + row0) * 512 + d * 128 + p;
        { const float* q = SL; const long ostep = 2 * rstep;
#pragma unroll 8
          for (int i = 0; i < 64; ++i) { const float xr = q[0], xi = q[64]; q += rstep;
            OUT[0] = (bf16)f2bf(cr); OUT[64] = (bf16)f2bf(ci); OUT += ostep;
            const float nr = ar * cr - ai * ci + xr, ni = ar * ci + ai * cr + xi; cr = nr; ci = ni; } }
    }
    __syncthreads();
}

template <bool SECOND>
__device__ __forceinline__ void row_tail(Frame& F, int row, f32x4 (&y)[8], const float* ga, const float* gb, LAS float* gateL, LAS float* shiftL, LAS float* scaleL) {
    float ss = 0.f;
#pragma unroll
    for (int j = 0; j < 8; ++j) ss += (y[j][0] * y[j][0] + y[j][1] * y[j][1]) + (y[j][2] * y[j][2] + y[j][3] * y[j][3]);
    const float ry = 1.0f / sqrtf(wave_sum(ss) * (1.0f / DM) + RMS_EPS);
    float* xrow = F.out + (size_t)row * DM; float s2 = 0.f;
#pragma unroll
    for (int j = 0; j < 8; ++j) { const int col = 4 * F.lane + 256 * j; const f32x4 x = *(const GAS f32x4*)(xrow + col), gg = *(const GAS f32x4*)(ga + col), gt = *(LAS f32x4*)(gateL + col);
        y[j] = x + gt * (y[j] * ry * gg);
        *(GAS f32x4*)(xrow + col) = y[j];
        s2 += (y[j][0] * y[j][0] + y[j][1] * y[j][1]) + (y[j][2] * y[j][2] + y[j][3] * y[j][3]); }
    if (SECOND) { const float rx = 1.0f / sqrtf(wave_sum(s2) * (1.0f / DM) + RMS_EPS); bf16* U = (bf16*)(F.ws + WS_UZ);
#pragma unroll
        for (int j = 0; j < 8; ++j) { const int col = 4 * F.lane + 256 * j; const f32x4 gg = *(const GAS f32x4*)(gb + col), sc = *(LAS f32x4*)(scaleL + col), sh = *(LAS f32x4*)(shiftL + col);
            const f32x4 u = (y[j] * rx * gg) * (sc + 1.0f) + sh; v2u w; w.x = pk2(u[0], u[1]); w.y = pk2(u[2], u[3]);
            *(GAS v2u*)(U + (size_t)row * DM + col) = w; } }
}
template <int YMODE, bool SECOND>
__device__ __forceinline__ void row_phase(Frame& F, int l_gate, int q_gate, int ga_idx, int l_mod, int q_shift, int q_scale, int gb_idx) {
    LAS float* gateL = (LAS float*)(F.lds);
    LAS float* shiftL = gateL + 2048;
    LAS float* scaleL = shiftL + 2048;
    LAS unsigned char* stg = F.lds + 32768;
    const bf16* Y = (const bf16*)(F.ws + WS_YF);
    const float* ga = F.inp(I_NORMG) + ga_idx * DM; const float* gb = F.inp(I_NORMG) + gb_idx * DM;
    int cur_b = -1;
    for (int rg = F.vcu; rg < MT / 32; rg += F.G) { const int b = rg / (SEQ / 32);
        if (b != cur_b) { __syncthreads(); load_mod(F, l_gate, b, q_gate, gateL); if (SECOND) { load_mod(F, l_mod, b, q_shift, shiftL); load_mod(F, l_mod, b, q_scale, scaleL); } cur_b = b; __syncthreads(); }
        if (YMODE == 0) {
#pragma unroll 1
            for (int rr = 0; rr < 4; ++rr) { const int row = rg * 32 + F.wave * 4 + rr;
                f32x4 y[8];
#pragma unroll
                for (int j = 0; j < 8; ++j) { const v2u w = *(const GAS v2u*)(Y + (size_t)row * DM + 4 * F.lane + 256 * j); y[j] = (f32x4){bf_lo(w.x), bf_hi(w.x), bf_lo(w.y), bf_hi(w.y)}; }
                row_tail<SECOND>(F, row, y, ga, gb, gateL, shiftL, scaleL); }
        } else {
#pragma unroll 1
            for (int half = 0; half < 2; ++half) { const int r0 = rg * 32 + half * 16, t0 = r0 & (SEQ - 1);
                __syncthreads();
                {
                    const int hw = 1 << (F.wave >> 1); const bf16* Yb = Y + (size_t)(r0 - t0) * DM + 4 * F.tid;
                    const f32x4 ps = *(const GAS f32x4*)(F.inp(I_POOLS) + 4 * F.tid);
#define LDV(trow) ({ const int _t = (trow); const bool _ok = _t >= 0 && _t < SEQ; const v2u _w = *(const GAS v2u*)(Yb + (size_t)(_ok ? _t : t0) * DM); const float _m = _ok ? 1.0f : 0.0f; \
                      (f32x4){bf_lo(_w.x) * _m, bf_hi(_w.x) * _m, bf_lo(_w.y) * _m, bf_hi(_w.y) * _m}; })
                    f32x4 s = {0.f, 0.f, 0.f, 0.f};
#pragma unroll 2
                    for (int o = -hw; o < hw; ++o) s += LDV(t0 + o);
#pragma unroll 4
                    for (int i = 0; i < 16; ++i) { const int t = t0 + i; const f32x4 self = LDV(t);
                        const int lo = t - hw < 0 ? 0 : t - hw, hi = t + hw - 1 > SEQ - 1 ? SEQ - 1 : t + hw - 1;
                        const f32x4 yv = (s * (1.0f / (float)(hi - lo + 1)) - self) * ps;
                        v2u w; w.x = pk2(yv[0], yv[1]); w.y = pk2(yv[2], yv[3]);
                        *(LAS v2u*)(stg + i * STG_PITCH + 8 * F.tid) = w;
                        s += LDV(t + hw) - LDV(t - hw); }
#undef LDV
                }
                __syncthreads();
#pragma unroll 1
                for (int rr = 0; rr < 2; ++rr) { const int lr = F.wave * 2 + rr, row = r0 + lr;
                    f32x4 y[8];
#pragma unroll
                    for (int j = 0; j < 8; ++j) { const v2u w = *(LAS v2u*)(stg + lr * STG_PITCH + 8 * F.lane + 512 * j); y[j] = (f32x4){bf_lo(w.x), bf_hi(w.x), bf_lo(w.y), bf_hi(w.y)}; }
                    row_tail<SECOND>(F, row, y, ga, gb, gateL, shiftL, scaleL); }
            }
        }
    }
    __syncthreads();
}

__device__ __forceinline__ void conv_phase(Frame& F, int l) {
    const bf16* H = (const bf16*)(F.ws + WS_H); bf16* ACT = (bf16*)(F.ws + WS_ACT);
    const float* cw = F.inp(I_CONV) + (size_t)l * 3 * DFF2; const float* cb = F.inp(I_CONVB) + (size_t)l * DFF2;
    const int gw = F.vcu * NWAVES + F.wave, NGW = F.G * NWAVES;
    for (int wi = gw; wi < (MT / 16) * 11; wi += NGW) { const int rb = wi / 11, cbk = wi % 11, f0 = (cbk * 64 + F.lane) * 8, t0 = rb * 16;
        float kv[3][8], kg[3][8], bv[8], bg[8];
#pragma unroll
        for (int tp = 0; tp < 3; ++tp) { const f32x4 a = *(const GAS f32x4*)(cw + tp * DFF2 + f0), b2 = *(const GAS f32x4*)(cw + tp * DFF2 + f0 + 4), c = *(const GAS f32x4*)(cw + tp * DFF2 + DFF + f0), d = *(const GAS f32x4*)(cw + tp * DFF2 + DFF + f0 + 4);
#pragma unroll
            for (int e = 0; e < 4; ++e) { kv[tp][e] = a[e]; kv[tp][4 + e] = b2[e]; kg[tp][e] = c[e]; kg[tp][4 + e] = d[e]; } }
        { const f32x4 a = *(const GAS f32x4*)(cb + f0), b2 = *(const GAS f32x4*)(cb + f0 + 4), c = *(const GAS f32x4*)(cb + DFF + f0), d = *(const GAS f32x4*)(cb + DFF + f0 + 4);
#pragma unroll
            for (int e = 0; e < 4; ++e) { bv[e] = a[e]; bv[4 + e] = b2[e]; bg[e] = c[e]; bg[4 + e] = d[e]; } }
        float pv[8], pg[8], cv[8], cg[8], nv[8], ng[8];
        const bool has_prev = (t0 & (SEQ - 1)) != 0, has_next = ((t0 + 16) & (SEQ - 1)) != 0;
#define LD8(dstv, dstg, trow) do { const v4u _a = *(const GAS v4u*)(H + (size_t)(trow) * DFF2 + f0), _b = *(const GAS v4u*)(H + (size_t)(trow) * DFF2 + DFF + f0); \
            dstv[0] = bf_lo(_a.x); dstv[1] = bf_hi(_a.x); dstv[2] = bf_lo(_a.y); dstv[3] = bf_hi(_a.y); dstv[4] = bf_lo(_a.z); dstv[5] = bf_hi(_a.z); dstv[6] = bf_lo(_a.w); dstv[7] = bf_hi(_a.w); \
            dstg[0] = bf_lo(_b.x); dstg[1] = bf_hi(_b.x); dstg[2] = bf_lo(_b.y); dstg[3] = bf_hi(_b.y); dstg[4] = bf_lo(_b.z); dstg[5] = bf_hi(_b.z); dstg[6] = bf_lo(_b.w); dstg[7] = bf_hi(_b.w); } while (0)
        if (has_prev) LD8(pv, pg, t0 - 1); else {
#pragma unroll
            for (int e = 0; e < 8; ++e) { pv[e] = 0.f; pg[e] = 0.f; } }
        LD8(cv, cg, t0);
#pragma unroll
        for (int i = 0; i < 16; ++i) {
            if (i < 15 || has_next) LD8(nv, ng, t0 + i + 1); else {
#pragma unroll
                for (int e = 0; e < 8; ++e) { nv[e] = 0.f; ng[e] = 0.f; } }
            float o[8];
#pragma unroll
            for (int e = 0; e < 8; ++e) { const float vv = kv[0][e] * pv[e] + kv[1][e] * cv[e] + kv[2][e] * nv[e] + bv[e], gg = kg[0][e] * pg[e] + kg[1][e] * cg[e] + kg[2][e] * ng[e] + bg[e];
                o[e] = gg * sigm(gg) * vv; }
            v4u w; w.x = pk2(o[0], o[1]); w.y = pk2(o[2], o[3]); w.z = pk2(o[4], o[5]); w.w = pk2(o[6], o[7]);
            *(GAS v4u*)(ACT + (size_t)(t0 + i) * DFF + f0) = w;
#pragma unroll
            for (int e = 0; e < 8; ++e) { pv[e] = cv[e]; pg[e] = cg[e]; cv[e] = nv[e]; cg[e] = ng[e]; }
        }
#undef LD8
    }
}

__global__ void __launch_bounds__(NTHR, 2) fwd_kernel(Args args) {
    extern __shared__ __attribute__((aligned(16))) unsigned char lds[];
    Frame F;
    F.lds = (LAS unsigned char*)lds;
    F.tid = threadIdx.x; F.lane = F.tid & 63; F.wave = __builtin_amdgcn_readfirstlane(F.tid >> 6);
    F.G = gridDim.x; { const int bx = blockIdx.x; F.vcu = (F.G % 8 == 0) ? (bx % 8) * (F.G / 8) + bx / 8 : bx; }
    F.out = args.out; F.ws = args.ws;
    volatile LAS unsigned* MISC = (volatile LAS unsigned*)(F.lds + MISC_OFF);
    for (int u = F.tid; u < (LDS_BYTES - LDSCTL_OFF) / 4; u += NTHR) ((LAS unsigned*)(F.lds + LDSCTL_OFF))[u] = 0u;
    __syncthreads();
    if (F.tid < 22) *(const float* LAS*)(F.lds + PTR_OFF + 8 * F.tid) = args.in[F.tid];
    __syncthreads();
    const bool one_launch = (args.ph_hi - args.ph_lo) > 1;
    XcdBarrier bar; bar.bar = (unsigned*)(F.ws + WS_CTL) + CW_BAR; bar.x = 0; bar.st = nullptr;
    if (one_launch) bar = xcd_barrier_post((unsigned*)(F.ws + WS_CTL) + CW_BAR, MISC + 8);
    const int lo = args.ph_lo, hi = args.ph_hi;
#ifndef PH_MASK
#define PH_MASK 0x1ffff
#endif
#define IN(k) ((((PH_MASK) >> (k)) & 1) && lo <= (k) && (k) < hi)
#define FENCE() do { asm volatile("" : "+v"(F.tid)); F.lane = F.tid & 63; { int _w = F.tid >> 6; asm volatile("" : "+v"(_w)); F.wave = __builtin_amdgcn_readfirstlane(_w); } \
        asm volatile("" : "+s"(F.vcu), "+s"(F.G), "+s"(F.ws), "+s"(F.out), "+s"(F.lds)); ring = F.lds + RING_OFF; } while (0)
#define SEAM(k) do { if (IN(k) && IN((k) + 1)) xcd_barrier(bar); FENCE(); } while (0)
    LAS unsigned char* ring = F.lds + RING_OFF;
    FENCE();

    if (IN(0)) { p0_prologue(F); } SEAM(0);
    if (IN(1)) { p1_rows(F); } SEAM(1);
    if (IN(2)) {
        for (int g = F.vcu; g < NG; g += F.G) p2_ctx_small(F, g);
        VM_WAIT(); __syncthreads();
        pg8::Gemm g{(const pg8::bf16_t*)(F.ws + WS_A2) + 256, (const pg8::bf16_t*)(F.ws + WS_WIN), 512, 256, 256, (size_t)512 * 512, (size_t)256 * 256};
        pg8::GroupedOrder S; S.init(NG, 2, 1, F.G, F.vcu);
        pg8::EpiF32G E{(float*)(F.ws + WS_SLOC), 256, (size_t)512 * 256};
        pg8::gemm_phase<pg8::EpiF32G, pg8::GroupedOrder, true, true>(ring, g, S, E, F.tid);
    } SEAM(2);
    if (IN(3)) { p3_scan(F); } SEAM(3);
    if (IN(4)) {
        pg8::Gemm g{(const pg8::bf16_t*)(F.ws + WS_A2), (const pg8::bf16_t*)(F.ws + WS_W2), 512, 512, 512, (size_t)512 * 512, (size_t)256 * 512};
        pg8::GroupedOrder S; S.init(NG, 2, 1, F.G, F.vcu);
        pg8::EpiGeluZ E{(pg8::bf16_t*)(F.ws + WS_UZ)};
        pg8::gemm_phase<pg8::EpiGeluZ, pg8::GroupedOrder, true, true>(ring, g, S, E, F.tid);
    } SEAM(4);
    if (IN(5)) {
        pg8::Gemm g{(const pg8::bf16_t*)(F.ws + WS_UZ), (const pg8::bf16_t*)(F.ws + WS_WGLU), DM, DM, DM, 0, 0};
        pg8::StaticOrder S; S.init(MT, 2 * DM, F.G, (int)blockIdx.x);
        pg8::EpiGlu E{(pg8::bf16_t*)(F.ws + WS_YF), DM};
        pg8::gemm_phase<pg8::EpiGlu, pg8::StaticOrder, true, true>(ring, g, S, E, F.tid);
    } SEAM(5);
    if (IN(6)) { row_phase<0, true>(F, 0, 2, 1, 0, 3, 4, 2); } SEAM(6);
    for (int l = 0; l < 2; ++l) {
        const int pb = l == 0 ? 7 : 13;
        if (IN(pb)) {
            pg8::Gemm g{(const pg8::bf16_t*)(F.ws + WS_UZ), (const pg8::bf16_t*)(F.ws + WS_WUP) + (size_t)l * DFF2 * DM, DM, DM, DM, 0, 0};
            pg8::StaticOrder S; S.init(MT, DFF2, F.G, (int)blockIdx.x);
            pg8::EpiBf16G E{(pg8::bf16_t*)(F.ws + WS_H), DFF2, 0};
            pg8::gemm_phase<pg8::EpiBf16G, pg8::StaticOrder, true, true>(ring, g, S, E, F.tid);
        } SEAM(pb);
        if (IN(pb + 1)) { conv_phase(F, l); } SEAM(pb + 1);
        if (IN(pb + 2)) {
            pg8::Gemm g{(const pg8::bf16_t*)(F.ws + WS_ACT), (const pg8::bf16_t*)(F.ws + WS_WDN) + (size_t)l * DM * DFF, DFF, DFF, DFF, 0, 0};
            pg8::StaticOrder S; S.init(MT, DM, F.G, (int)blockIdx.x);
            pg8::EpiBf16G E{(pg8::bf16_t*)(F.ws + WS_YF), DM, 0};
            pg8::gemm_phase<pg8::EpiBf16G, pg8::StaticOrder, true, true>(ring, g, S, E, F.tid);
        } SEAM(pb + 2);
        if (l == 0) {
            if (IN(10)) { row_phase<0, true>(F, 0, 5, 3, 1, 0, 1, 4); } SEAM(10);
            if (IN(11)) {
                pg8::Gemm g{(const pg8::bf16_t*)(F.ws + WS_UZ), (const pg8::bf16_t*)(F.ws + WS_WPOOL), DM, 512, 512, (size_t)512, (size_t)512 * 512};
                pg8::GroupedOrder S; S.init(4, MT / 256, 2, F.G, F.vcu);
                pg8::EpiBf16G E{(pg8::bf16_t*)(F.ws + WS_YF), DM, (size_t)512};
                pg8::gemm_phase<pg8::EpiBf16G, pg8::GroupedOrder, true, true>(ring, g, S, E, F.tid);
            } SEAM(11);
            if (IN(12)) { row_phase<1, true>(F, 1, 2, 5, 1, 3, 4, 6); } SEAM(12);
        } else {
            if (IN(16)) { row_phase<0, false>(F, 1, 5, 7, 0, 0, 0, 0); }
        }
    }
#undef IN
#undef SEAM
}

extern "C" void kernel_launch(void* const* d_in, const int* in_sizes, int n_in, void* d_out, int out_size, void* d_ws, size_t ws_size, hipStream_t stream) {
    static int grid = 0;
    if (grid == 0) {
        if (n_in != 22 || out_size != MT * DM || ws_size < WS_END) { fprintf(stderr, "kernel_launch: unexpected problem (n_in %d, out %d, ws %zu); nothing launched\n", n_in, out_size, ws_size); grid = -1; return; }
        int dev = 0, cus = 0, per_cu = 0;
        if (hipGetDevice(&dev) != hipSuccess || hipDeviceGetAttribute(&cus, hipDeviceAttributeMultiprocessorCount, dev) != hipSuccess) { grid = -1; return; }
        if (hipFuncSetAttribute((const void*)fwd_kernel, hipFuncAttributeMaxDynamicSharedMemorySize, LDS_BYTES) != hipSuccess) { fprintf(stderr, "kernel_launch: hipFuncSetAttribute failed\n"); grid = -1; return; }
        if (hipOccupancyMaxActiveBlocksPerMultiprocessor(&per_cu, (const void*)fwd_kernel, NTHR, LDS_BYTES) != hipSuccess || per_cu < 1) { fprintf(stderr, "kernel_launch: occupancy query reports %d blocks per CU\n", per_cu); per_cu = 1; }
        (void)hipGetLastError();
        grid = cus;
    }
    if (grid < 0) return;
    if (hipMemsetAsync((char*)d_ws + WS_CTL, 0, CTL_ZERO_BYTES, stream) != hipSuccess) { fprintf(stderr, "kernel_launch: hipMemsetAsync failed\n"); return; }
    Args a{};
    for (int i = 0; i < 22; ++i) a.in[i] = (const float*)d_in[i];
    a.out = (float*)d_out; a.ws = (unsigned char*)d_ws;
#if MK_N_LAUNCHES == 1
    a.ph_lo = 0; a.ph_hi = NPHASE; a.li = 0;
    hipLaunchKernelGGL(fwd_kernel, dim3(grid), dim3(NTHR), LDS_BYTES, stream, a);
#else
    for (int p = 0; p < NPHASE; ++p) { a.ph_lo = p; a.ph_hi = p + 1; a.li = p; hipLaunchKernelGGL(fwd_kernel, dim3(grid), dim3(NTHR), LDS_BYTES, stream, a); }
#endif
    const hipError_t le = hipPeekAtLastError();
    if (le != hipSuccess) fprintf(stderr, "kernel_launch: launch failed: %s\n", hipGetErrorName(le));
}
```

```cpp
#include <hip/hip_runtime.h>
#include <cstdio>
#include <cstdint>

#ifndef MK_N_LAUNCHES
#define MK_N_LAUNCHES 1
#endif

namespace pg8 {
#define PG8_LAS __attribute__((address_space(3)))
typedef unsigned short bf16_t;
typedef short bf16x8 __attribute__((ext_vector_type(8)));
typedef float f32x4 __attribute__((ext_vector_type(4)));
typedef float f32x16 __attribute__((ext_vector_type(16)));
typedef unsigned u32x4 __attribute__((ext_vector_type(4)));
typedef unsigned u32x2 __attribute__((ext_vector_type(2)));
constexpr int BM = 256, BK = 64, HALF = 128, HTB = HALF * BK * 2  , STAGE_BYTES = 8 * HTB, NXCD = 8, WGM = 8;

__host__ __device__ __forceinline__ int lds_byte(int r, int c) { const int st = (r >> 4) * 2 + (c >> 5), rr = r & 15, cc = c & 31, ob = rr * 64 + cc * 2; return st * 1024 + (ob ^ (((ob >> 9) & 1) << 5)); }
__host__ __device__ __forceinline__ void stage_rc(int b, int& R, int& C) { const int st = b / 1024, sb = b % 1024, swz = sb ^ (((sb >> 9) & 1) << 5); R = (st >> 1) * 16 + swz / 64; C = (st & 1) * 32 + (swz % 64) / 2; }
__host__ __device__ __forceinline__ int perm32(int rho) { const int n = rho >> 4, i = rho & 15; return 8 * (i >> 2) + 4 * n + (i & 3); }

struct Unit { int pm, pn, g; };
struct Gemm { const bf16_t* A; const bf16_t* Bt; int lda, ldb, K; size_t gsA, gsB; };

struct StaticOrder {
    int nM, nN, nwg, G, c, rep;
    __device__ void init(int M, int N, int G_, int c_, int rep_ = 1) { nM = M / BM; nN = N / BM; nwg = nM * nN; G = G_; c = c_; rep = rep_; }
    __device__ bool next(int i, Unit& u) const {
        const long L = (long)i * G + c; if (L >= (long)nwg * rep) return false;
        int wgid = (int)(L % nwg); { const int q = nwg / NXCD, r = nwg % NXCD, xcd = wgid % NXCD, off = wgid / NXCD; wgid = (xcd < r ? xcd * (q + 1) : r * (q + 1) + (xcd - r) * q) + off; }
        const int nig = WGM * nN, gid = wgid / nig, fm = gid * WGM, gsz = (nM - fm) < WGM ? (nM - fm) : WGM;
        u.pm = fm + ((wgid % nig) % gsz); u.pn = (wgid % nig) / gsz; u.g = 0; return true;
    }
};
struct GroupedOrder {
    int nG, nM, nN, G, c, rep;
    __device__ void init(int nG_, int nM_, int nN_, int G_, int c_, int rep_ = 1) { nG = nG_; nM = nM_; nN = nN_; G = G_; c = c_; rep = rep_; }
    __device__ bool next(int i, Unit& u) const {
        long L = (long)i * G + c; if (L >= (long)nG * nM * nN * rep) return false; L %= (long)nG * nM * nN;
        const int per = nM * nN, r = (int)(L % per); u.g = (int)(L / per); u.pn = r / nM; u.pm = r % nM; return true;
    }
};

__device__ __forceinline__ unsigned cvt_pk_bf16(float lo, float hi) { unsigned r; asm volatile("v_cvt_pk_bf16_f32 %0, %1, %2" : "=v"(r) : "v"(lo), "v"(hi)); return r; }
__device__ __forceinline__ float sigmoidf_fast(float x) { return __builtin_amdgcn_rcpf(1.0f + __builtin_amdgcn_exp2f(-1.44269504089f * x)); }
__device__ __forceinline__ float gelu_tanh(float y) { const float z = 0.7978845608f * (y + 0.044715f * y * y * y); return y * sigmoidf_fast(2.0f * z); }

struct EpiF32G {
    static constexpr bool PERM = false;
    float* C; int ldc; size_t gsC;
    __device__ __forceinline__ void operator()(const f32x4 (&acc)[2][2][4][2], const Unit& u, int wr, int wc, int fr, int fq) const {
        const int row0 = u.pm * BM + wr * 64 + fr, col0 = u.pn * BM + wc * 32 + 4 * fq; float* rowp = C + (size_t)u.g * gsC + (size_t)row0 * ldc + col0;
#pragma unroll
        for (int ai = 0; ai < 2; ++ai) {
#pragma unroll
            for (int m = 0; m < 4; ++m) {
#pragma unroll
                for (int bj = 0; bj < 2; ++bj)
#pragma unroll
                    for (int n = 0; n < 2; ++n) *(f32x4*)(rowp + bj * HALF + n * 16) = acc[ai][bj][m][n];
                asm volatile("" : "+v"(rowp)); rowp += (size_t)16 * ldc; }
            rowp += (size_t)64 * ldc; }
    }
};
struct EpiBf16G {
    static constexpr bool PERM = true;
    bf16_t* O; int ldc; size_t gsO;
    __device__ __forceinline__ void operator()(const f32x4 (&acc)[2][2][4][2], const Unit& u, int wr, int wc, int fr, int fq) const {
        const int row0 = u.pm * BM + wr * 64 + fr, col0 = u.pn * BM + wc * 32 + 8 * fq; bf16_t* rowp = O + (size_t)u.g * gsO + (size_t)row0 * ldc + col0;
#pragma unroll
        for (int ai = 0; ai < 2; ++ai) {
#pragma unroll
            for (int m = 0; m < 4; ++m) {
#pragma unroll
                for (int bj = 0; bj < 2; ++bj) { const f32x4 v0 = acc[ai][bj][m][0], v1 = acc[ai][bj][m][1];
                    u32x4 w; w.x = cvt_pk_bf16(v0[0], v0[1]); w.y = cvt_pk_bf16(v0[2], v0[3]); w.z = cvt_pk_bf16(v1[0], v1[1]); w.w = cvt_pk_bf16(v1[2], v1[3]);
                    *(u32x4*)(rowp + bj * HALF) = w; }
                asm volatile("" : "+v"(rowp)); rowp += (size_t)16 * ldc; }
            rowp += (size_t)64 * ldc; }
    }
};
struct EpiGeluZ {
    static constexpr bool PERM = true;
    bf16_t* Z;
    __device__ __forceinline__ void operator()(const f32x4 (&acc)[2][2][4][2], const Unit& u, int wr, int wc, int fr, int fq) const {
        bf16_t* rowp = Z + ((size_t)(u.pm * 4096 + (wr * 64 + fr) * 16 + 2 * wc + (fq >> 1))) * 2048 + u.g * 16 + 8 * (fq & 1);
#pragma unroll
        for (int ai = 0; ai < 2; ++ai) {
#pragma unroll
            for (int m = 0; m < 4; ++m) {
#pragma unroll
                for (int bj = 0; bj < 2; ++bj) {
                    const f32x4 v0 = acc[ai][bj][m][0], v1 = acc[ai][bj][m][1];
                    u32x4 w; w.x = cvt_pk_bf16(gelu_tanh(v0[0]), gelu_tanh(v0[1])); w.y = cvt_pk_bf16(gelu_tanh(v0[2]), gelu_tanh(v0[3]));
                    w.z = cvt_pk_bf16(gelu_tanh(v1[0]), gelu_tanh(v1[1])); w.w = cvt_pk_bf16(gelu_tanh(v1[2]), gelu_tanh(v1[3]));
                    *(u32x4*)(rowp + (size_t)bj * 8 * 2048) = w; }
                asm volatile("" : "+v"(rowp)); rowp += (size_t)16 * 16 * 2048; }
            rowp += (size_t)64 * 16 * 2048; }
    }
};
struct EpiGlu {
    static constexpr bool PERM = true;
    bf16_t* O; int ldc;
    __device__ __forceinline__ void operator()(const f32x4 (&acc)[2][2][4][2], const Unit& u, int wr, int wc, int fr, int fq) const {
        const int row0 = u.pm * BM + wr * 64 + fr, col0 = u.pn * HALF + wc * 32 + 8 * fq; bf16_t* rowp = O + (size_t)row0 * ldc + col0;
#pragma unroll
        for (int ai = 0; ai < 2; ++ai) {
#pragma unroll
            for (int m = 0; m < 4; ++m) {
                const f32x4 v0 = acc[ai][0][m][0], v1 = acc[ai][0][m][1], g0 = acc[ai][1][m][0], g1 = acc[ai][1][m][1];
                u32x4 w; w.x = cvt_pk_bf16(v0[0] * sigmoidf_fast(g0[0]), v0[1] * sigmoidf_fast(g0[1])); w.y = cvt_pk_bf16(v0[2] * sigmoidf_fast(g0[2]), v0[3] * sigmoidf_fast(g0[3]));
                w.z = cvt_pk_bf16(v1[0] * sigmoidf_fast(g1[0]), v1[1] * sigmoidf_fast(g1[1])); w.w = cvt_pk_bf16(v1[2] * sigmoidf_fast(g1[2]), v1[3] * sigmoidf_fast(g1[3]));
                *(u32x4*)rowp = w;
                asm volatile("" : "+v"(rowp)); rowp += (size_t)16 * ldc; }
            rowp += (size_t)64 * ldc; }
    }
};

template <class Epi, class Sched, bool ALIGN_EPI = false, bool SP2 = false>
__device__ __forceinline__ void gemm_phase(PG8_LAS unsigned char* lds, const Gemm g, const Sched& S, const Epi& E, const int tid) {
    const int wid = __builtin_amdgcn_readfirstlane(tid >> 6), lane = tid & 63, wr = wid >> 2, wc = wid & 3, fr = lane & 15, fq = lane >> 4;
    const int K = g.K, nt = K / BK;
    unsigned voffA[2], voffB[2];
#pragma unroll
    for (int i = 0; i < 2; ++i) { int R, C; stage_rc(tid * 16 + i * 8192, R, C); const int Rb = Epi::PERM ? ((R & ~31) + perm32(R & 31)) : R;
        voffA[i] = (unsigned)(R * g.lda + C) * 2u; voffB[i] = (unsigned)(Rb * g.ldb + C) * 2u; }
    const size_t kstep = (size_t)(BK * 2);
    const size_t hstepA = (size_t)HALF * g.lda * 2, hstepB = (size_t)HALF * g.ldb * 2;
    const size_t tstepA = 2 * hstepA, tstepB = 2 * hstepB;
    const unsigned ldsw = (unsigned)wid * 1024u;
    const int aoff = lds_byte(wr * 64 + fr, fq * 8), boff = lds_byte(wc * 32 + fr, fq * 8);
#define PG8_SA(b, h) (((b) * 2 + (h)) * HTB)
#define PG8_SB(b, h) ((4 + (b) * 2 + (h)) * HTB)
#define PG8_STAGE(bufoff, gbase, voff) do { _Pragma("unroll") for (int _i = 0; _i < 2; ++_i) \
        __builtin_amdgcn_global_load_lds((const unsigned*)((const char*)(gbase) + (voff)[_i]), (PG8_LAS unsigned*)(lds + (bufoff) + ldsw + _i * 8192), 16, 0, 0); } while (0)
#define PG8_LDA(dst, b, h) do { _Pragma("unroll") for (int m = 0; m < 4; ++m) _Pragma("unroll") for (int k = 0; k < 2; ++k) dst[m][k] = *(const PG8_LAS bf16x8*)(lds + PG8_SA(b, h) + aoff + m * 2048 + k * 1024); } while (0)
#define PG8_LDB(dst, b, h) do { _Pragma("unroll") for (int n = 0; n < 2; ++n) _Pragma("unroll") for (int k = 0; k < 2; ++k) dst[n][k] = *(const PG8_LAS bf16x8*)(lds + PG8_SB(b, h) + boff + n * 2048 + k * 1024); } while (0)
#define PG8_MMA(ai, bj, At, Bt) do { __builtin_amdgcn_s_setprio(1); _Pragma("unroll") for (int m = 0; m < 4; ++m) _Pragma("unroll") for (int n = 0; n < 2; ++n) _Pragma("unroll") for (int k = 0; k < 2; ++k) \
        acc[ai][bj][m][n] = __builtin_amdgcn_mfma_f32_16x16x32_bf16(Bt[n][k], At[m][k], acc[ai][bj][m][n], 0, 0, 0); __builtin_amdgcn_s_setprio(0); } while (0)
#define PG8_WAIT_V(n) asm volatile("s_waitcnt vmcnt(" #n ")" ::: "memory")
#define PG8_WAIT_L(n) asm volatile("s_waitcnt lgkmcnt(" #n ")" ::: "memory")
#define PG8_BAR __builtin_amdgcn_s_barrier()
#define PG8_SCHED __builtin_amdgcn_sched_barrier(0)
    Unit cur, nxt; int ui = 0;
    if (!S.next(0, cur)) return;
    f32x4 acc[2][2][4][2];
#pragma unroll
    for (int a = 0; a < 2; ++a)
#pragma unroll
        for (int b = 0; b < 2; ++b)
#pragma unroll
            for (int m = 0; m < 4; ++m)
#pragma unroll
                for (int n = 0; n < 2; ++n) acc[a][b][m][n] = (f32x4){0.f, 0.f, 0.f, 0.f};
    bf16x8 At[4][2], B0[2][2], B1[2][2];
    const char* cA = (const char*)g.A + ((size_t)cur.g * g.gsA) * 2 + (size_t)cur.pm * tstepA; const char* cB = (const char*)g.Bt + ((size_t)cur.g * g.gsB) * 2 + (size_t)cur.pn * tstepB;
    if constexpr (SP2) {
        PG8_STAGE(PG8_SB(0, 0), cB, voffB); PG8_STAGE(PG8_SB(0, 1), cB + hstepB, voffB); PG8_STAGE(PG8_SA(0, 0), cA, voffA); PG8_STAGE(PG8_SA(0, 1), cA + hstepA, voffA);
        if (wr == 1) PG8_BAR;
        PG8_WAIT_V(2); PG8_BAR;
        PG8_STAGE(PG8_SB(1, 0), cB + kstep, voffB); PG8_STAGE(PG8_SA(1, 0), cA + kstep, voffA); PG8_STAGE(PG8_SB(1, 1), cB + hstepB + kstep, voffB);
        PG8_WAIT_V(6); PG8_BAR;
    } else {
        PG8_STAGE(PG8_SB(0, 0), cB, voffB); PG8_STAGE(PG8_SA(0, 0), cA, voffA); PG8_STAGE(PG8_SB(0, 1), cB + hstepB, voffB); PG8_STAGE(PG8_SA(0, 1), cA + hstepA, voffA);
        if (wr == 1) PG8_BAR;
        PG8_WAIT_V(4); PG8_BAR;
        PG8_STAGE(PG8_SB(1, 0), cB + kstep, voffB); PG8_STAGE(PG8_SA(1, 0), cA + kstep, voffA); PG8_STAGE(PG8_SB(1, 1), cB + hstepB + kstep, voffB);
        PG8_WAIT_V(6); PG8_BAR;
    }
    for (;;) {
        const bool has_next = S.next(ui + 1, nxt);
        const char* nA = has_next ? (const char*)g.A + ((size_t)nxt.g * g.gsA) * 2 + (size_t)nxt.pm * tstepA : cA; const char* nB = has_next ? (const char*)g.Bt + ((size_t)nxt.g * g.gsB) * 2 + (size_t)nxt.pn * tstepB : cB;
        for (int t = 0; t < nt; t += 2) {
            const bool last = (t == nt - 2);
            const char* a1 = cA + (size_t)(t + 1) * kstep;
            const char* a2 = last ? nA : cA + (size_t)(t + 2) * kstep; const char* b2 = last ? nB : cB + (size_t)(t + 2) * kstep;
            const char* a3 = a2 + kstep; const char* b3 = b2 + kstep;
            if constexpr (SP2) {
            PG8_LDB(B0, 0, 0); PG8_LDB(B1, 0, 1); PG8_SCHED; PG8_LDA(At, 0, 0); PG8_STAGE(PG8_SA(1, 1), a1 + hstepA, voffA);
            PG8_WAIT_V(8); PG8_WAIT_L(0); PG8_BAR; PG8_MMA(0, 0, At, B0); PG8_MMA(0, 1, At, B1); PG8_BAR; PG8_SCHED;
            PG8_LDA(At, 0, 1); PG8_STAGE(PG8_SB(0, 0), b2, voffB); PG8_STAGE(PG8_SB(0, 1), b2 + hstepB, voffB); PG8_STAGE(PG8_SA(0, 0), a2, voffA);
            PG8_WAIT_V(8); PG8_WAIT_L(0); PG8_BAR; PG8_MMA(1, 0, At, B0); PG8_MMA(1, 1, At, B1); PG8_BAR; PG8_SCHED;
            PG8_LDB(B0, 1, 0); PG8_LDB(B1, 1, 1); PG8_SCHED; PG8_LDA(At, 1, 0); PG8_STAGE(PG8_SA(0, 1), a2 + hstepA, voffA);
            PG8_WAIT_V(8); PG8_WAIT_L(0); PG8_BAR; PG8_MMA(0, 0, At, B0); PG8_MMA(0, 1, At, B1); PG8_BAR; PG8_SCHED;
            PG8_LDA(At, 1, 1); PG8_STAGE(PG8_SB(1, 0), b3, voffB); PG8_STAGE(PG8_SB(1, 1), b3 + hstepB, voffB); PG8_STAGE(PG8_SA(1, 0), a3, voffA);
            PG8_WAIT_V(8); PG8_WAIT_L(0); PG8_BAR; PG8_MMA(1, 0, At, B0); PG8_MMA(1, 1, At, B1); PG8_BAR; PG8_SCHED;
            } else {
            PG8_LDB(B0, 0, 0); PG8_SCHED; PG8_LDA(At, 0, 0); PG8_STAGE(PG8_SA(1, 1), a1 + hstepA, voffA);
            PG8_WAIT_L(8); PG8_BAR; PG8_WAIT_L(0); PG8_MMA(0, 0, At, B0); PG8_BAR; PG8_SCHED;
            PG8_LDB(B1, 0, 1); PG8_STAGE(PG8_SB(0, 0), b2, voffB);
            PG8_BAR; PG8_WAIT_L(0); PG8_MMA(0, 1, At, B1); PG8_BAR;
            PG8_LDA(At, 0, 1); PG8_STAGE(PG8_SA(0, 0), a2, voffA);
            PG8_BAR; PG8_WAIT_L(0); PG8_MMA(1, 0, At, B0); PG8_BAR; PG8_SCHED;
            PG8_STAGE(PG8_SB(0, 1), b2 + hstepB, voffB);
            PG8_WAIT_V(6); PG8_BAR; PG8_MMA(1, 1, At, B1); PG8_BAR;
            PG8_LDB(B0, 1, 0); PG8_SCHED; PG8_LDA(At, 1, 0); PG8_STAGE(PG8_SA(0, 1), a2 + hstepA, voffA);
            PG8_WAIT_L(8); PG8_BAR; PG8_WAIT_L(0); PG8_MMA(0, 0, At, B0); PG8_BAR; PG8_SCHED;
            PG8_LDB(B1, 1, 1); PG8_STAGE(PG8_SB(1, 0), b3, voffB);
            PG8_BAR; PG8_WAIT_L(0); PG8_MMA(0, 1, At, B1); PG8_BAR;
            PG8_LDA(At, 1, 1); PG8_STAGE(PG8_SA(1, 0), a3, voffA);
            PG8_BAR; PG8_WAIT_L(0); PG8_MMA(1, 0, At, B0); PG8_BAR; PG8_SCHED;
            PG8_STAGE(PG8_SB(1, 1), b3 + hstepB, voffB);
            PG8_WAIT_V(6); PG8_BAR; PG8_MMA(1, 1, At, B1); PG8_BAR;
            }
        }
        if constexpr (ALIGN_EPI) { if (wr == 0) PG8_BAR; }
        E(acc, cur, wr, wc, fr, fq);
        if (!has_next) break;
#pragma unroll
        for (int a = 0; a < 2; ++a)
#pragma unroll
            for (int b = 0; b < 2; ++b)
#pragma unroll
                for (int m = 0; m < 4; ++m)
#pragma unroll
                    for (int n = 0; n < 2; ++n) acc[a][b][m][n] = (f32x4){0.f, 0.f, 0.f, 0.f};
        cur = nxt; cA = nA; cB = nB; ++ui;
        if constexpr (ALIGN_EPI) { if (wr == 1) PG8_BAR; }
    }
    PG8_WAIT_V(0);
    if constexpr (!ALIGN_EPI) { if (wr == 0) PG8_BAR; }
    PG8_BAR;
#undef PG8_SA
#undef PG8_SB
#undef PG8_STAGE
#undef PG8_LDA
#undef PG8_LDB
#undef PG8_MMA
#undef PG8_WAIT_V
#undef PG8_WAIT_L
#undef PG8_BAR
#undef PG8_SCHED
}
}

constexpr int NWAVES = 8, NTHR = NWAVES * 64;
constexpr int DM = 2048, NBATCH = 2, SEQ = 4096, CTX = 256, MT = NBATCH * SEQ, MC = NBATCH * CTX, DFF = 5632, DFF2 = 2 * DFF, NMODC = 6 * DM, NG = 128;
constexpr float RMS_EPS = 1e-6f;
constexpr int NPHASE = 17;

constexpr size_t MiB = 1u << 20;
constexpr size_t WS_CTL = 0, CTL_ZERO_BYTES = 1 * MiB;
constexpr size_t WS_MODP = 1 * MiB;
constexpr size_t WS_A16 = 4 * MiB;
constexpr size_t WS_WGLU = 5 * MiB;
constexpr size_t WS_WUP = 21 * MiB;
constexpr size_t WS_WDN = 109 * MiB;
constexpr size_t WS_WPOOL = 153 * MiB;
constexpr size_t WS_UZ = 155 * MiB;
constexpr size_t WS_YF = 187 * MiB;
constexpr size_t WS_ACT = 219 * MiB;
constexpr size_t WS_H = 307 * MiB;
constexpr size_t WS_WIN = 307 * MiB;
constexpr size_t WS_W2 = 323 * MiB;
constexpr size_t WS_A2 = 355 * MiB;
constexpr size_t WS_UCG = 419 * MiB;
constexpr size_t WS_SLOC = 421 * MiB;
constexpr size_t WS_SCLOC = 485 * MiB;
constexpr size_t WS_END = 489 * MiB;
static_assert(WS_H + (size_t)MT * DFF2 * 2 <= WS_END && WS_SCLOC + (size_t)NG * 32 * 256 * 4 <= WS_END, "d_ws map");
constexpr int CW_BAR = 4096;

constexpr int RING_OFF = 0, RING_BYTES = 131072;
constexpr int LDSCTL_OFF = RING_BYTES, MISC_OFF = LDSCTL_OFF + 320, PTR_OFF = LDSCTL_OFF + 1024;
constexpr int LDS_BYTES = 147456;

#define GAS __attribute__((address_space(1)))
#define LAS __attribute__((address_space(3)))
typedef unsigned short bf16;
typedef unsigned v4u __attribute__((ext_vector_type(4)));
typedef unsigned v2u __attribute__((ext_vector_type(2)));
typedef float f32x4 __attribute__((ext_vector_type(4)));
typedef short bf16x8 __attribute__((ext_vector_type(8)));
typedef float f32x16 __attribute__((ext_vector_type(16)));
#define LDS_WAIT() asm volatile("s_waitcnt lgkmcnt(0)" ::: "memory")
#define VM_WAIT() asm volatile("s_waitcnt vmcnt(0)" ::: "memory")
__device__ __forceinline__ unsigned f2bf(float f) { unsigned u = __builtin_bit_cast(unsigned, f); return (u + 0x7fffu + ((u >> 16) & 1u)) >> 16; }
__device__ __forceinline__ unsigned pk2(float lo, float hi) { return f2bf(lo) | (f2bf(hi) << 16); }
__device__ __forceinline__ float bf_lo(unsigned w) { return __builtin_bit_cast(float, w << 16); }
__device__ __forceinline__ float bf_hi(unsigned w) { return __builtin_bit_cast(float, w & 0xffff0000u); }
__device__ __forceinline__ float sigm(float x) { return __builtin_amdgcn_rcpf(1.0f + __builtin_amdgcn_exp2f(-1.44269504089f * x)); }

#define XB_TMO      128
#define XB_XCNT(j)  (256  + 64 * (j))
#define XB_XSUB(j)  (1280 + 64 * (j))
#define XB_XGEN(j)  (2304 + 64 * (j))
#define XB_TOP      3328
#define XB_TOPGEN   3392
#define XCD_BAR_WORDS 3456
#define XB_SPIN_CAP (1u << 20)
__device__ __forceinline__ unsigned xb_ld(unsigned* p)              { return __hip_atomic_load(p, __ATOMIC_RELAXED, __HIP_MEMORY_SCOPE_AGENT); }
__device__ __forceinline__ unsigned xb_add(unsigned* p, unsigned v) { return __hip_atomic_fetch_add(p, v, __ATOMIC_RELAXED, __HIP_MEMORY_SCOPE_AGENT); }
__device__ __forceinline__ unsigned xb_xcc_id() { return (unsigned)__builtin_amdgcn_s_getreg((3 << 11) | 20) & 0xFu; }
#define XB_SPIN(cond, bar) do { unsigned _sp = 0; while (cond) { __builtin_amdgcn_s_sleep(1); \
    if ((++_sp & 255u) == 0u) { if (xb_ld(&(bar)[XB_TMO])) break; if (_sp > XB_SPIN_CAP) { atomicAdd(&(bar)[XB_TMO], 1u); break; } } } } while (0)
struct XcdBarrier { unsigned* bar; unsigned x; volatile LAS unsigned* st; };
__device__ __forceinline__ XcdBarrier xcd_barrier_post(unsigned* bar, volatile LAS unsigned* st) {
    XcdBarrier b; b.bar = bar; b.x = xb_xcc_id(); b.st = st;
    if (threadIdx.x == 0) (void)xb_add(&bar[XB_XCNT(b.x)], 1u);
    return b;
}
__device__ __forceinline__ void xcd_barrier_complete(unsigned* bar, unsigned x, unsigned& nloc, unsigned& nx) {
    const unsigned G = gridDim.x * gridDim.y * gridDim.z;
    unsigned sum, cnt, mine, sp = 0u;
    for (;;) {
        sum = 0u; cnt = 0u; mine = 0u;
#pragma unroll
        for (unsigned j = 0; j < 16; ++j) { const unsigned c = xb_ld(&bar[XB_XCNT(j)]); sum += c; cnt += (c > 0u) ? 1u : 0u; mine = (j == x) ? c : mine; }
        if (sum == G) break;
        __builtin_amdgcn_s_sleep(1);
        if ((++sp & 255u) == 0u) { if (xb_ld(&bar[XB_TMO])) break; if (sp > XB_SPIN_CAP) { atomicAdd(&bar[XB_TMO], 1u); break; } }
    }
    nloc = mine > 0u ? mine : 1u; nx = cnt > 0u ? cnt : 1u;
}
__device__ __forceinline__ void xcd_barrier(const XcdBarrier& b) {
    asm volatile("s_waitcnt vmcnt(0)" ::: "memory");
    __syncthreads();
    if (threadIdx.x == 0) {
        unsigned* bar = b.bar;
        __builtin_amdgcn_s_waitcnt(0);
        unsigned nloc = b.st[0], nx = b.st[1];
        if (nloc == 0u) { xcd_barrier_complete(bar, b.x, nloc, nx); b.st[0] = nloc; b.st[1] = nx; }
        const unsigned old = xb_add(&bar[XB_XSUB(b.x)], 1u);
        const unsigned gen = old / nloc;
        if (old + 1u == (gen + 1u) * nloc) {
            __builtin_amdgcn_fence(__ATOMIC_RELEASE, "agent");
            asm volatile("s_waitcnt vmcnt(0)" ::: "memory");
            const unsigned og = xb_add(&bar[XB_TOP], 1u);
            const unsigned tg = og / nx;
            if (og + 1u == (tg + 1u) * nx) xb_add(&bar[XB_TOPGEN], 1u);
            else XB_SPIN(xb_ld(&bar[XB_TOPGEN]) == tg, bar);
            __builtin_amdgcn_fence(__ATOMIC_ACQUIRE, "agent");
            xb_add(&bar[XB_XGEN(b.x)], 1u);
            asm volatile("s_waitcnt vmcnt(0)" ::: "memory");
        } else {
            XB_SPIN(xb_ld(&bar[XB_XGEN(b.x)]) == gen, bar);
            __builtin_amdgcn_fence(__ATOMIC_ACQUIRE, "agent");
            asm volatile("s_waitcnt vmcnt(0)" ::: "memory");
        }
    }
    __syncthreads();
}

struct Args { const float* in[22]; float* out; unsigned char* ws; int ph_lo, ph_hi, li, pad; };
struct Frame {
    LAS unsigned char* lds;
    int tid, lane, wave, vcu, G;
    float* out; unsigned char* ws;
    __device__ __forceinline__ const float* inp(int i) const { return *(const float* LAS*)(lds + PTR_OFF + 8 * i); }
};
enum { I_X = 0, I_C, I_CTX, I_CCTX, I_ADAW, I_ADAB, I_NORMG, I_LAMRE, I_LAMIM, I_LOGSTEP, I_BRE, I_BIM, I_CRE, I_CIM, I_S5D, I_GLUW, I_POOLW, I_POOLS, I_UP, I_CONV, I_CONVB, I_DOWN };

__device__ __forceinline__ float wave_sum(float v) {
#pragma unroll
    for (int o = 1; o < 64; o <<= 1) v += __shfl_xor(v, o);
    return v;
}

__device__ __forceinline__ void sincos_d(double x, double& s, double& c) {
    const double q = __builtin_rint(x * 0.63661977236758134308);
    double r = __builtin_fma(-q, 1.57079632679489655800e+00, x); r = __builtin_fma(-q, 6.12323399573676603587e-17, r);
    const int iq = ((int)q) & 3; const double r2 = r * r;
    double sp = 1.0 / 6227020800.0; sp = sp * r2 - 1.0 / 39916800.0; sp = sp * r2 + 1.0 / 362880.0; sp = sp * r2 - 1.0 / 5040.0; sp = sp * r2 + 1.0 / 120.0; sp = sp * r2 - 1.0 / 6.0; sp = sp * r2 + 1.0; sp *= r;
    double cp = -1.0 / 87178291200.0; cp = cp * r2 + 1.0 / 479001600.0; cp = cp * r2 - 1.0 / 3628800.0; cp = cp * r2 + 1.0 / 40320.0; cp = cp * r2 - 1.0 / 720.0; cp = cp * r2 + 1.0 / 24.0; cp = cp * r2 - 0.5; cp = cp * r2 + 1.0;
    s = (iq == 0) ? sp : (iq == 1) ? cp : (iq == 2) ? -sp : -cp;
    c = (iq == 0) ? cp : (iq == 1) ? -sp : (iq == 2) ? -cp : sp;
}
__device__ __forceinline__ double exp_d(double x) {
    const double n = __builtin_rint(x * 1.44269504088896340736);
    double r = __builtin_fma(-n, 6.93147180369123816490e-01, x); r = __builtin_fma(-n, 1.90821492927058770002e-10, r);
    double p = 1.0 / 479001600.0;
    p = p * r + 1.0 / 39916800.0; p = p * r + 1.0 / 3628800.0; p = p * r + 1.0 / 362880.0; p = p * r + 1.0 / 40320.0; p = p * r + 1.0 / 5040.0; p = p * r + 1.0 / 720.0;
    p = p * r + 1.0 / 120.0; p = p * r + 1.0 / 24.0; p = p * r + 1.0 / 6.0; p = p * r + 0.5; p = p * r + 1.0; p = p * r + 1.0;
    return __builtin_ldexp(p, (int)n);
}

template <int MODE>
__device__ __forceinline__ void p0_transpose_item(const float* W, int K, int N, bf16* WT, LAS unsigned* scr, int item, int lane) {
    const int nblk = N / 64, kb = item / nblk, nb = item % nblk, k0 = 64 * kb, n0 = 64 * nb;
    const float* src = W + (size_t)k0 * N + n0 + lane;
    float v[64];
#pragma unroll
    for (int i = 0; i < 64; ++i) v[i] = *(const GAS float*)(src + (size_t)i * N);
#pragma unroll
    for (int i = 0; i < 32; ++i) scr[i * 65 + lane] = pk2(v[2 * i], v[2 * i + 1]);
    LDS_WAIT(); asm volatile("" ::: "memory");
    const int c = lane & 7;
    int r0 = n0;
    if (MODE == 1) { r0 = (n0 < 2048) ? (256 * (n0 >> 7) + (n0 & 127)) : (256 * ((n0 - 2048) >> 7) + 128 + ((n0 - 2048) & 127)); }
#pragma unroll
    for (int j = 0; j < 8; ++j) { const int n = (lane >> 3) + 8 * j; const LAS unsigned* q = scr + (4 * c) * 65 + n;
        v4u o; o.x = q[0]; o.y = q[65]; o.z = q[130]; o.w = q[195];
        *(GAS v4u*)(WT + (size_t)(r0 + n) * K + k0 + 8 * c) = o; }
    LDS_WAIT(); asm volatile("" ::: "memory");
}

__device__ __forceinline__ void p0_ada_item(Frame& F, int it) {
    LAS float* cond = (LAS float*)(F.lds);
    LAS float* red = (LAS float*)(F.lds + 24576);
    const int l = it / 384, r = it % 384, s = r / 48, ct = r % 48, k0 = s * 256 + F.wave * 32, n0 = ct * 256;
    const float* W = F.inp(I_ADAW) + (size_t)l * DM * NMODC + (size_t)k0 * NMODC + n0 + 4 * F.lane;
    f32x4 a0 = {0.f, 0.f, 0.f, 0.f}, a1 = a0, a2 = a0;
#pragma unroll 8
    for (int i = 0; i < 32; ++i) { const f32x4 w = *(const GAS f32x4*)(W + (size_t)i * NMODC);
        const float c0 = cond[k0 + i], c1 = cond[2048 + k0 + i], c2 = cond[4096 + k0 + i];
        a0 += w * c0; a1 += w * c1; a2 += w * c2; }
    *(LAS f32x4*)(red + (F.wave * 3 + 0) * 256 + 4 * F.lane) = a0;
    *(LAS f32x4*)(red + (F.wave * 3 + 1) * 256 + 4 * F.lane) = a1;
    *(LAS f32x4*)(red + (F.wave * 3 + 2) * 256 + 4 * F.lane) = a2;
    __syncthreads();
    float* MODP = (float*)(F.ws + WS_MODP);
    for (int o = F.tid; o < 768; o += NTHR) { const int v = o >> 8, col = o & 255; float sum = 0.f;
#pragma unroll
        for (int w = 0; w < 8; ++w) sum += red[(w * 3 + v) * 256 + col];
        MODP[((size_t)(l * 8 + s) * 3 + v) * NMODC + n0 + col] = sum; }
    __syncthreads();
}

__device__ __forceinline__ void p0_s5_item(Frame& F, int g) {
    LAS float* APR = (LAS float*)(F.lds);
    LAS float* API = APR + 2176;
    LAS float* BBR = API + 2176;
    LAS float* BBI = BBR + 2048;
    LAS float* CCR = BBI + 2048;
    LAS float* CCI = CCR + 2048;
    LAS float* KT = CCI + 2048;
    const float* lam_re = F.inp(I_LAMRE); const float* lam_im = F.inp(I_LAMIM); const float* logst = F.inp(I_LOGSTEP);
    for (int idx = F.tid; idx < 2176; idx += NTHR) { const int p = idx & 63, dk = idx >> 6, d = dk / 17, k = dk % 17;
        const double dt = exp_d((double)logst[d * NG + g]); const double lr = (double)lam_re[(d * NG + g) * 64 + p], li = (double)lam_im[(d * NG + g) * 64 + p];
        const double mag = exp_d((double)k * lr * dt); double sn, cs; sincos_d((double)k * li * dt, sn, cs);
        APR[idx] = (float)(mag * cs); API[idx] = (float)(mag * sn); }
    for (int idx = F.tid; idx < 2048; idx += NTHR) { const int c = idx & 15, dp = idx >> 4, d = dp >> 6, p = dp & 63;
        const double dt = exp_d((double)logst[d * NG + g]); const double lr = (double)lam_re[(d * NG + g) * 64 + p], li = (double)lam_im[(d * NG + g) * 64 + p];
        const double mag = exp_d(lr * dt); double sn, cs; sincos_d(li * dt, sn, cs);
        const double nr = mag * cs - 1.0, ni = mag * sn, den = lr * lr + li * li;
        const double fr = (nr * lr + ni * li) / den, fi = (ni * lr - nr * li) / den;
        const size_t bi = ((size_t)(d * NG + g) * 64 + p) * 16 + c; const double br = (double)F.inp(I_BRE)[bi], bim = (double)F.inp(I_BIM)[bi];
        BBR[idx] = (float)(fr * br - fi * bim); BBI[idx] = (float)(fr * bim + fi * br);
        const int cc = idx >> 6, pp = idx & 63;
        const int d2 = cc >> 4, c2 = cc & 15; const size_t ci = ((size_t)(d2 * NG + g) * 16 + c2) * 64 + pp;
        CCR[idx] = F.inp(I_CRE)[ci]; CCI[idx] = F.inp(I_CIM)[ci]; }
    __syncthreads();
    bf16* WIN = (bf16*)(F.ws + WS_WIN) + (size_t)g * 256 * 256;
    for (int q = F.tid; q < 8192; q += NTHR) { const int n = q >> 5, kc = q & 31, d = n >> 7, part = (n >> 6) & 1, p = n & 63, j = kc >> 1, c0 = 8 * (kc & 1);
        const int e = d == 0 ? 15 - j : j; const float ar = APR[(d * 17 + e) * 64 + p], ai = API[(d * 17 + e) * 64 + p];
        float v[8];
#pragma unroll
        for (int x = 0; x < 8; ++x) { const float br = BBR[(d * 64 + p) * 16 + c0 + x], bi = BBI[(d * 64 + p) * 16 + c0 + x]; v[x] = part == 0 ? ar * br - ai * bi : ar * bi + ai * br; }
        v4u o; o.x = pk2(v[0], v[1]); o.y = pk2(v[2], v[3]); o.z = pk2(v[4], v[5]); o.w = pk2(v[6], v[7]);
        *(GAS v4u*)(WIN + (size_t)n * 256 + 8 * kc) = o; }
    { const int cp = F.tid & 15, tau = (F.tid >> 4) & 15, d = F.tid >> 8; f32x4 s0 = {0.f, 0.f, 0.f, 0.f}, s1 = s0, s2 = s0, s3 = s0;
#pragma unroll 4
      for (int p = 0; p < 64; ++p) { const float cr = CCR[(d * 16 + cp) * 64 + p], ci = CCI[(d * 16 + cp) * 64 + p], ar = APR[(d * 17 + tau) * 64 + p], ai = API[(d * 17 + tau) * 64 + p];
          const float mr = cr * ar - ci * ai, mi = cr * ai + ci * ar; const LAS f32x4* br = (const LAS f32x4*)(BBR + (d * 64 + p) * 16); const LAS f32x4* bi = (const LAS f32x4*)(BBI + (d * 64 + p) * 16);
          s0 += br[0] * mr - bi[0] * mi; s1 += br[1] * mr - bi[1] * mi; s2 += br[2] * mr - bi[2] * mi; s3 += br[3] * mr - bi[3] * mi; }
      LAS f32x4* o = (LAS f32x4*)(KT + ((d * 16 + tau) * 16 + cp) * 16); o[0] = s0; o[1] = s1; o[2] = s2; o[3] = s3; }
    __syncthreads();
    bf16* W2 = (bf16*)(F.ws + WS_W2) + (size_t)g * 256 * 512;
    const float* dsk = F.inp(I_S5D) + g * 16;
    for (int q = F.tid; q < 16384; q += NTHR) { const int n = q >> 6, kc = q & 63, jp = n >> 4, cp = n & 15; float v[8];
        if (kc < 32) { const int d = kc >> 4, part = (kc >> 3) & 1, p0 = 8 * (kc & 7), e = d == 0 ? jp + 1 : 16 - jp;
#pragma unroll
            for (int x = 0; x < 8; ++x) { const int p = p0 + x; const float cr = CCR[(d * 16 + cp) * 64 + p], ci = CCI[(d * 16 + cp) * 64 + p], ar = APR[(d * 17 + e) * 64 + p], ai = API[(d * 17 + e) * 64 + p];
                v[x] = part == 0 ? cr * ar - ci * ai : -(cr * ai + ci * ar); }
        } else { const int j = (kc - 32) >> 1, c0 = 8 * ((kc - 32) & 1);
#pragma unroll
            for (int x = 0; x < 8; ++x) { const int c = c0 + x; float s = 0.f;
                if (j <= jp) s += KT[((0 * 16 + (jp - j)) * 16 + cp) * 16 + c];
                if (j >= jp) s += KT[((1 * 16 + (j - jp)) * 16 + cp) * 16 + c];
                if (j == jp && c == cp) s += dsk[c];
                v[x] = s; } }
        v4u o; o.x = pk2(v[0], v[1]); o.y = pk2(v[2], v[3]); o.z = pk2(v[4], v[5]); o.w = pk2(v[6], v[7]);
        *(GAS v4u*)(W2 + (size_t)n * 512 + 8 * kc) = o; }
    if (F.tid < 128) { const int d = F.tid >> 6, p = F.tid & 63; float* A16 = (float*)(F.ws + WS_A16) + ((size_t)(d * NG + g) * 64 + p) * 2;
        A16[0] = APR[(d * 17 + 16) * 64 + p]; A16[1] = API[(d * 17 + 16) * 64 + p]; }
    __syncthreads();
}

__device__ __forceinline__ void p0_prologue(Frame& F) {
    for (int g = F.vcu; g < NG; g += F.G) p0_s5_item(F, g);
    { LAS float* cond = (LAS float*)(F.lds);
      for (int i = F.tid; i < 3 * DM; i += NTHR) { const float x = i < 2 * DM ? F.inp(I_C)[i] : F.inp(I_CCTX)[i - 2 * DM]; cond[i] = x * sigm(x); }
      __syncthreads();
      for (int it = F.vcu; it < 768; it += F.G) p0_ada_item(F, it); }
    __syncthreads();
    LAS unsigned* scr = (LAS unsigned*)(F.lds + F.wave * 16384);
    const int gw = F.vcu * NWAVES + F.wave, NGW = F.G * NWAVES;
    constexpr int I_G = (DM / 64) * (2 * DM / 64), I_U = (DM / 64) * (DFF2 / 64), I_D = (DFF / 64) * (DM / 64), I_P = (512 / 64) * (512 / 64);
    constexpr int NITEMS = I_G + 2 * I_U + 2 * I_D + 4 * I_P;
    for (int it = gw; it < NITEMS; it += NGW) {
        int r = it;
        if (r < I_G) { p0_transpose_item<1>(F.inp(I_GLUW), DM, 2 * DM, (bf16*)(F.ws + WS_WGLU), scr, r, F.lane); continue; } r -= I_G;
        if (r < 2 * I_U) { const int l = r / I_U; p0_transpose_item<0>(F.inp(I_UP) + (size_t)l * DM * DFF2, DM, DFF2, (bf16*)(F.ws + WS_WUP) + (size_t)l * DFF2 * DM, scr, r % I_U, F.lane); continue; } r -= 2 * I_U;
        if (r < 2 * I_D) { const int l = r / I_D; p0_transpose_item<0>(F.inp(I_DOWN) + (size_t)l * DFF * DM, DFF, DM, (bf16*)(F.ws + WS_WDN) + (size_t)l * DM * DFF, scr, r % I_D, F.lane); continue; } r -= 2 * I_D;
        { const int gi = r / I_P; p0_transpose_item<0>(F.inp(I_POOLW) + (size_t)gi * 512 * 512, 512, 512, (bf16*)(F.ws + WS_WPOOL) + (size_t)gi * 512 * 512, scr, r % I_P, F.lane); }
    }
}

__device__ __forceinline__ void load_mod(Frame& F, int l, int v, int q, LAS float* dst) {
    const float* MODP = (const float*)(F.ws + WS_MODP); const int col = q * DM + 4 * F.tid;
    f32x4 s = *(const GAS f32x4*)(F.inp(I_ADAB) + l * NMODC + col);
#pragma unroll
    for (int sl = 0; sl < 8; ++sl) s += *(const GAS f32x4*)(MODP + ((size_t)(l * 8 + sl) * 3 + v) * NMODC + col);
    *(LAS f32x4*)(dst + 4 * F.tid) = s;
}

constexpr int STG_PITCH = 4112;
__device__ __forceinline__ void p1_rows(Frame& F) {
    LAS float* shiftL = (LAS float*)(F.lds + 98304);
    LAS float* scaleL = shiftL + 2048;
    LAS unsigned char* stg = F.lds;
    const float* g0 = F.inp(I_NORMG);
    int cur_vec = -1;
    for (int unit = F.vcu; unit < 544; unit += F.G) {
        const bool is_ctx = unit >= 512; const int b = is_ctx ? (unit - 512) >> 4 : unit >> 8, blk = is_ctx ? (unit - 512) & 15 : unit & 255;
        const int vec = is_ctx ? 2 : b;
        if (vec != cur_vec) { __syncthreads(); load_mod(F, 0, vec, 0, shiftL); load_mod(F, 0, vec, 1, scaleL); cur_vec = vec; }
        __syncthreads();
#pragma unroll 1
        for (int rr = 0; rr < 2; ++rr) { const int row = F.wave + 8 * rr, t = blk * 16 + row;
            const float* src = is_ctx ? F.inp(I_CTX) + ((size_t)(b * CTX + t)) * DM : F.inp(I_X) + ((size_t)(b * SEQ + t)) * DM;
            f32x4 v[8]; float ss = 0.f;
#pragma unroll
            for (int j = 0; j < 8; ++j) { v[j] = *(const GAS f32x4*)(src + 4 * F.lane + 256 * j); }
            if (!is_ctx) { const float prow = (float)(t >> 6), pcol = (float)(t & 63);
#pragma unroll
                for (int j = 0; j < 8; ++j) { const float pos = j < 4 ? prow : pcol; const bool is_cos = (j & 2) != 0;
#pragma unroll
                    for (int e = 0; e < 4; ++e) { const int i = (4 * F.lane + 256 * j + e) & 511;
                        const float omega = __builtin_amdgcn_exp2f(-(float)i * (13.287712379549449f / 512.0f));
                        const float rev = pos * omega * 0.15915494309189535f;
                        v[j][e] += is_cos ? __builtin_amdgcn_cosf(rev) : __builtin_amdgcn_sinf(rev); } }
                float* dst = F.out + ((size_t)(b * SEQ + t)) * DM;
#pragma unroll
                for (int j = 0; j < 8; ++j) *(GAS f32x4*)(dst + 4 * F.lane + 256 * j) = v[j]; }
#pragma unroll
            for (int j = 0; j < 8; ++j) ss += (v[j][0] * v[j][0] + v[j][1] * v[j][1]) + (v[j][2] * v[j][2] + v[j][3] * v[j][3]);
            const float rstd = 1.0f / sqrtf(wave_sum(ss) * (1.0f / DM) + RMS_EPS);
#pragma unroll
            for (int j = 0; j < 8; ++j) { const int col = 4 * F.lane + 256 * j; const f32x4 gg = *(const GAS f32x4*)(g0 + col), sc = *(LAS f32x4*)(scaleL + col), sh = *(LAS f32x4*)(shiftL + col);
                const f32x4 u = (v[j] * rstd * gg) * (sc + 1.0f) + sh;
                v2u w; w.x = pk2(u[0], u[1]); w.y = pk2(u[2], u[3]);
                *(LAS v2u*)(stg + row * STG_PITCH + col * 2) = w; } }
        __syncthreads();
        for (int q = F.tid; q < 4096; q += NTHR) { const int g = q >> 5, jh = q & 31, j = jh >> 1, h = jh & 1;
            const v4u w = *(LAS v4u*)(stg + j * STG_PITCH + g * 32 + h * 16);
            bf16* dst = is_ctx ? (bf16*)(F.ws + WS_UCG) + ((size_t)g * 32 + b * 16 + blk) * 256 + jh * 8
                               : (bf16*)(F.ws + WS_A2) + ((size_t)g * 512 + b * 256 + blk) * 512 + 256 + jh * 8;
            *(GAS v4u*)dst = w; }
    }
    __syncthreads();
}

__device__ __forceinline__ void p2_ctx_small(Frame& F, int g) {
    const bf16* A = (const bf16*)(F.ws + WS_UCG) + (size_t)g * 32 * 256; const bf16* Bt = (const bf16*)(F.ws + WS_WIN) + (size_t)g * 256 * 256;
    const int r = F.lane & 31, h = F.lane >> 5; f32x16 acc;
#pragma unroll
    for (int i = 0; i < 16; ++i) acc[i] = 0.f;
#pragma unroll 4
    for (int ks = 0; ks < 16; ++ks) { const bf16x8 a = *(const GAS bf16x8*)(A + r * 256 + ks * 16 + 8 * h), bq = *(const GAS bf16x8*)(Bt + (size_t)(32 * F.wave + r) * 256 + ks * 16 + 8 * h);
        acc = __builtin_amdgcn_mfma_f32_32x32x16_bf16(a, bq, acc, 0, 0, 0); }
    float* O = (float*)(F.ws + WS_SCLOC) + (size_t)g * 32 * 256;
#pragma unroll
    for (int i = 0; i < 16; ++i) { const int row = (i & 3) + 8 * (i >> 2) + 4 * h; O[row * 256 + 32 * F.wave + r] = acc[i]; }
}

__device__ __forceinline__ void p3_scan(Frame& F) {
    LAS float* EX = (LAS float*)(F.lds);
    for (int item = F.vcu; item < 2 * NG; item += F.G) { const int g = item >> 1, b = item & 1;
        const int p = F.lane, d = F.wave >> 2, ch = F.wave & 3;
        const float* A16 = (const float*)(F.ws + WS_A16) + ((size_t)(d * NG + g) * 64 + p) * 2; const float ar = A16[0], ai = A16[1];
        const int row0 = d == 0 ? ch * 64 : 255 - ch * 64; const long rstep = d == 0 ? 256 : -256;
        const float* SL = (const float*)(F.ws + WS_SLOC) + ((size_t)g * 512 + b * 256 + row0) * 256 + d * 128 + p;
        const float* SC = (const float*)(F.ws + WS_SCLOC) + ((size_t)g * 32 + b * 16 + (d == 0 ? 0 : 15)) * 256 + d * 128 + p;
        float cr = 0.f, ci = 0.f;
        { const float* q = SC;
#pragma unroll 8
          for (int k = 0; k < 16; ++k) { const float xr = q[0], xi = q[64]; q += rstep;
            const float nr = ar * cr - ai * ci + xr, ni = ar * ci + ai * cr + xi; cr = nr; ci = ni; } }
        float sr = 0.f, si = 0.f;
        { const float* q = SL;
#pragma unroll 8
          for (int i = 0; i < 64; ++i) { const float xr = q[0], xi = q[64]; q += rstep;
            const float nr = ar * sr - ai * si + xr, ni = ar * si + ai * sr + xi; sr = nr; si = ni; } }
        __syncthreads();
        EX[((d * 4 + ch) * 64 + p) * 2] = sr; EX[((d * 4 + ch) * 64 + p) * 2 + 1] = si;
        __syncthreads();
        float pr = ar, pi = ai;
#pragma unroll
        for (int k = 0; k < 6; ++k) { const float nr = pr * pr - pi * pi, ni = 2.f * pr * pi; pr = nr; pi = ni; }
        for (int q = 0; q < ch; ++q) { const float er = EX[((d * 4 + q) * 64 + p) * 2], ei = EX[((d * 4 + q) * 64 + p) * 2 + 1];
            const float nr = pr * cr - pi * ci + er, ni = pr * ci + pi * cr + ei; cr = nr; ci = ni; }
        bf16* OUT = (bf16*)(F.ws + WS_A2) + ((size_t)g * 512 + b * 256 + row0) * 512 + d * 128 + p;
        { const float* q = SL; const long ostep = 2 * rstep;
#pragma unroll 8
          for (int i = 0; i < 64; ++i) { const float xr = q[0], xi = q[64]; q += rstep;
            OUT[0] = (bf16)f2bf(cr); OUT[64] = (bf16)f2bf(ci); OUT += ostep;
            const float nr = ar * cr - ai * ci + xr, ni = ar * ci + ai * cr + xi; cr = nr; ci = ni; } }
    }
    __syncthreads();
}

template <bool SECOND>
__device__ __forceinline__ void row_tail(Frame& F, int row, f32x4 (&y)[8], const float* ga, const float* gb, LAS float* gateL, LAS float* shiftL, LAS float* scaleL) {
    float ss = 0.f;
#pragma unroll
    for (int j = 0; j < 8; ++j) ss += (y[j][0] * y[j][0] + y[j][1] * y[j][1]) + (y[j][2] * y[j][2] + y[j][3] * y[j][3]);
    const float ry = 1.0f / sqrtf(wave_sum(ss) * (1.0f / DM) + RMS_EPS);
    float* xrow = F.out + (size_t)row * DM; float s2 = 0.f;
#pragma unroll
    for (int j = 0; j < 8; ++j) { const int col = 4 * F.lane + 256 * j; const f32x4 x = *(const GAS f32x4*)(xrow + col), gg = *(const GAS f32x4*)(ga + col), gt = *(LAS f32x4*)(gateL + col);
        y[j] = x + gt * (y[j] * ry * gg);
        *(GAS f32x4*)(xrow + col) = y[j];
        s2 += (y[j][0] * y[j][0] + y[j][1] * y[j][1]) + (y[j][2] * y[j][2] + y[j][3] * y[j][3]); }
    if (SECOND) { const float rx = 1.0f / sqrtf(wave_sum(s2) * (1.0f / DM) + RMS_EPS); bf16* U = (bf16*)(F.ws + WS_UZ);
#pragma unroll
        for (int j = 0; j < 8; ++j) { const int col = 4 * F.lane + 256 * j; const f32x4 gg = *(const GAS f32x4*)(gb + col), sc = *(LAS f32x4*)(scaleL + col), sh = *(LAS f32x4*)(shiftL + col);
            const f32x4 u = (y[j] * rx * gg) * (sc + 1.0f) + sh; v2u w; w.x = pk2(u[0], u[1]); w.y = pk2(u[2], u[3]);
            *(GAS v2u*)(U + (size_t)row * DM + col) = w; } }
}
template <int YMODE, bool SECOND>
__device__ __forceinline__ void row_phase(Frame& F, int l_gate, int q_gate, int ga_idx, int l_mod, int q_shift, int q_scale, int gb_idx) {
    LAS float* gateL = (LAS float*)(F.lds);
    LAS float* shiftL = gateL + 2048;
    LAS float* scaleL = shiftL + 2048;
    LAS unsigned char* stg = F.lds + 32768;
    const bf16* Y = (const bf16*)(F.ws + WS_YF);
    const float* ga = F.inp(I_NORMG) + ga_idx * DM; const float* gb = F.inp(I_NORMG) + gb_idx * DM;
    int cur_b = -1;
    for (int rg = F.vcu; rg < MT / 32; rg += F.G) { const int b = rg / (SEQ / 32);
        if (b != cur_b) { __syncthreads(); load_mod(F, l_gate, b, q_gate, gateL); if (SECOND) { load_mod(F, l_mod, b, q_shift, shiftL); load_mod(F, l_mod, b, q_scale, scaleL); } cur_b = b; __syncthreads(); }
        if (YMODE == 0) {
#pragma unroll 1
            for (int rr = 0; rr < 4; ++rr) { const int row = rg * 32 + F.wave * 4 + rr;
                f32x4 y[8];
#pragma unroll
                for (int j = 0; j < 8; ++j) { const v2u w = *(const GAS v2u*)(Y + (size_t)row * DM + 4 * F.lane + 256 * j); y[j] = (f32x4){bf_lo(w.x), bf_hi(w.x), bf_lo(w.y), bf_hi(w.y)}; }
                row_tail<SECOND>(F, row, y, ga, gb, gateL, shiftL, scaleL); }
        } else {
#pragma unroll 1
            for (int half = 0; half < 2; ++half) { const int r0 = rg * 32 + half * 16, t0 = r0 & (SEQ - 1);
                __syncthreads();
                {
                    const int hw = 1 << (F.wave >> 1); const bf16* Yb = Y + (size_t)(r0 - t0) * DM + 4 * F.tid;
                    const f32x4 ps = *(const GAS f32x4*)(F.inp(I_POOLS) + 4 * F.tid);
#define LDV(trow) ({ const int _t = (trow); const bool _ok = _t >= 0 && _t < SEQ; const v2u _w = *(const GAS v2u*)(Yb + (size_t)(_ok ? _t : t0) * DM); const float _m = _ok ? 1.0f : 0.0f; \
                      (f32x4){bf_lo(_w.x) * _m, bf_hi(_w.x) * _m, bf_lo(_w.y) * _m, bf_hi(_w.y) * _m}; })
                    f32x4 s = {0.f, 0.f, 0.f, 0.f};
#pragma unroll 2
                    for (int o = -hw; o < hw; ++o) s += LDV(t0 + o);
#pragma unroll 4
                    for (int i = 0; i < 16; ++i) { const int t = t0 + i; const f32x4 self = LDV(t);
                        const int lo = t - hw < 0 ? 0 : t - hw, hi = t + hw - 1 > SEQ - 1 ? SEQ - 1 : t + hw - 1;
                        const f32x4 yv = (s * (1.0f / (float)(hi - lo + 1)) - self) * ps;
                        v2u w; w.x = pk2(yv[0], yv[1]); w.y = pk2(yv[2], yv[3]);
                        *(LAS v2u*)(stg + i * STG_PITCH + 8 * F.tid) = w;
                        s += LDV(t + hw) - LDV(t - hw); }
#undef LDV
                }
                __syncthreads();
#pragma unroll 1
                for (int rr = 0; rr < 2; ++rr) { const int lr = F.wave * 2 + rr, row = r0 + lr;
                    f32x4 y[8];
#pragma unroll
                    for (int j = 0; j < 8; ++j) { const v2u w = *(LAS v2u*)(stg + lr * STG_PITCH + 8 * F.lane + 512 * j); y[j] = (f32x4){bf_lo(w.x), bf_hi(w.x), bf_lo(w.y), bf_hi(w.y)}; }
                    row_tail<SECOND>(F, row, y, ga, gb, gateL, shiftL, scaleL); }
            }
        }
    }
    __syncthreads();
}

__device__ __forceinline__ void conv_phase(Frame& F, int l) {
    const bf16* H = (const bf16*)(F.ws + WS_H); bf16* ACT = (bf16*)(F.ws + WS_ACT);
    const float* cw = F.inp(I_CONV) + (size_t)l * 3 * DFF2; const float* cb = F.inp(I_CONVB) + (size_t)l * DFF2;
    const int gw = F.vcu * NWAVES + F.wave, NGW = F.G * NWAVES;
    for (int wi = gw; wi < (MT / 16) * 11; wi += NGW) { const int rb = wi / 11, cbk = wi % 11, f0 = (cbk * 64 + F.lane) * 8, t0 = rb * 16;
        float kv[3][8], kg[3][8], bv[8], bg[8];
#pragma unroll
        for (int tp = 0; tp < 3; ++tp) { const f32x4 a = *(const GAS f32x4*)(cw + tp * DFF2 + f0), b2 = *(const GAS f32x4*)(cw + tp * DFF2 + f0 + 4), c = *(const GAS f32x4*)(cw + tp * DFF2 + DFF + f0), d = *(const GAS f32x4*)(cw + tp * DFF2 + DFF + f0 + 4);
#pragma unroll
            for (int e = 0; e < 4; ++e) { kv[tp][e] = a[e]; kv[tp][4 + e] = b2[e]; kg[tp][e] = c[e]; kg[tp][4 + e] = d[e]; } }
        { const f32x4 a = *(const GAS f32x4*)(cb + f0), b2 = *(const GAS f32x4*)(cb + f0 + 4), c = *(const GAS f32x4*)(cb + DFF + f0), d = *(const GAS f32x4*)(cb + DFF + f0 + 4);
#pragma unroll
            for (int e = 0; e < 4; ++e) { bv[e] = a[e]; bv[4 + e] = b2[e]; bg[e] = c[e]; bg[4 + e] = d[e]; } }
        float pv[8], pg[8], cv[8], cg[8], nv[8], ng[8];
        const bool has_prev = (t0 & (SEQ - 1)) != 0, has_next = ((t0 + 16) & (SEQ - 1)) != 0;
#define LD8(dstv, dstg, trow) do { const v4u _a = *(const GAS v4u*)(H + (size_t)(trow) * DFF2 + f0), _b = *(const GAS v4u*)(H + (size_t)(trow) * DFF2 + DFF + f0); \
            dstv[0] = bf_lo(_a.x); dstv[1] = bf_hi(_a.x); dstv[2] = bf_lo(_a.y); dstv[3] = bf_hi(_a.y); dstv[4] = bf_lo(_a.z); dstv[5] = bf_hi(_a.z); dstv[6] = bf_lo(_a.w); dstv[7] = bf_hi(_a.w); \
            dstg[0] = bf_lo(_b.x); dstg[1] = bf_hi(_b.x); dstg[2] = bf_lo(_b.y); dstg[3] = bf_hi(_b.y); dstg[4] = bf_lo(_b.z); dstg[5] = bf_hi(_b.z); dstg[6] = bf_lo(_b.w); dstg[7] = bf_hi(_b.w); } while (0)
        if (has_prev) LD8(pv, pg, t0 - 1); else {
#pragma unroll
            for (int e = 0; e < 8; ++e) { pv[e] = 0.f; pg[e] = 0.f; } }
        LD8(cv, cg, t0);
#pragma unroll
        for (int i = 0; i < 16; ++i) {
            if (i < 15 || has_next) LD8(nv, ng, t0 + i + 1); else {
#pragma unroll
                for (int e = 0; e < 8; ++e) { nv[e] = 0.f; ng[e] = 0.f; } }
            float o[8];
#pragma unroll
            for (int e = 0; e < 8; ++e) { const float vv = kv[0][e] * pv[e] + kv[1][e] * cv[e] + kv[2][e] * nv[e] + bv[e], gg = kg[0][e] * pg[e] + kg[1][e] * cg[e] + kg[2][e] * ng[e] + bg[e];
                o[e] = gg * sigm(gg) * vv; }
            v4u w; w.x = pk2(o[0], o[1]); w.y = pk2(o[2], o[3]); w.z = pk2(o[4], o[5]); w.w = pk2(o[6], o[7]);
            *(GAS v4u*)(ACT + (size_t)(t0 + i) * DFF + f0) = w;
#pragma unroll
            for (int e = 0; e < 8; ++e) { pv[e] = cv[e]; pg[e] = cg[e]; cv[e] = nv[e]; cg[e] = ng[e]; }
        }
#undef LD8
    }
}

__global__ void __launch_bounds__(NTHR, 2) fwd_kernel(Args args) {
    extern __shared__ __attribute__((aligned(16))) unsigned char lds[];
    Frame F;
    F.lds = (LAS unsigned char*)lds;
    F.tid = threadIdx.x; F.lane = F.tid & 63; F.wave = __builtin_amdgcn_readfirstlane(F.tid >> 6);
    F.G = gridDim.x; { const int bx = blockIdx.x; F.vcu = (F.G % 8 == 0) ? (bx % 8) * (F.G / 8) + bx / 8 : bx; }
    F.out = args.out; F.ws = args.ws;
    volatile LAS unsigned* MISC = (volatile LAS unsigned*)(F.lds + MISC_OFF);
    for (int u = F.tid; u < (LDS_BYTES - LDSCTL_OFF) / 4; u += NTHR) ((LAS unsigned*)(F.lds + LDSCTL_OFF))[u] = 0u;
    __syncthreads();
    if (F.tid < 22) *(const float* LAS*)(F.lds + PTR_OFF + 8 * F.tid) = args.in[F.tid];
    __syncthreads();
    const bool one_launch = (args.ph_hi - args.ph_lo) > 1;
    XcdBarrier bar; bar.bar = (unsigned*)(F.ws + WS_CTL) + CW_BAR; bar.x = 0; bar.st = nullptr;
    if (one_launch) bar = xcd_barrier_post((unsigned*)(F.ws + WS_CTL) + CW_BAR, MISC + 8);
    const int lo = args.ph_lo, hi = args.ph_hi;
#ifndef PH_MASK
#define PH_MASK 0x1ffff
#endif
#ifndef REP_MASK
#define REP_MASK 0
#endif
#define IN(k) ((((PH_MASK) >> (k)) & 1) && lo <= (k) && (k) < hi)
#define REPF(k) (1 + (((REP_MASK) >> (k)) & 1))
#define REPS(k) for (int _rep = 0; _rep < 1 + (((REP_MASK) >> (k)) & 1); ++_rep, (_rep < 1 + (((REP_MASK) >> (k)) & 1) ? (xcd_barrier(bar), 0) : 0))
#define FENCE() do { asm volatile("" : "+v"(F.tid)); F.lane = F.tid & 63; { int _w = F.tid >> 6; asm volatile("" : "+v"(_w)); F.wave = __builtin_amdgcn_readfirstlane(_w); } \
        asm volatile("" : "+s"(F.vcu), "+s"(F.G), "+s"(F.ws), "+s"(F.out), "+s"(F.lds)); ring = F.lds + RING_OFF; } while (0)
#define SEAM(k) do { if (IN(k) && IN((k) + 1)) xcd_barrier(bar); FENCE(); } while (0)
    LAS unsigned char* ring = F.lds + RING_OFF;
    FENCE();

    if (IN(0)) REPS(0) { p0_prologue(F); } SEAM(0);
    if (IN(1)) REPS(1) { p1_rows(F); } SEAM(1);
    if (IN(2)) {
        for (int g = F.vcu; g < NG; g += F.G) p2_ctx_small(F, g);
        VM_WAIT(); __syncthreads();
        pg8::Gemm g{(const pg8::bf16_t*)(F.ws + WS_A2) + 256, (const pg8::bf16_t*)(F.ws + WS_WIN), 512, 256, 256, (size_t)512 * 512, (size_t)256 * 256};
        pg8::GroupedOrder S; S.init(NG, 2, 1, F.G, F.vcu, REPF(2));
        pg8::EpiF32G E{(float*)(F.ws + WS_SLOC), 256, (size_t)512 * 256};
        pg8::gemm_phase<pg8::EpiF32G, pg8::GroupedOrder, true, true>(ring, g, S, E, F.tid);
    } SEAM(2);
    if (IN(3)) REPS(3) { p3_scan(F); } SEAM(3);
    if (IN(4)) {
        pg8::Gemm g{(const pg8::bf16_t*)(F.ws + WS_A2), (const pg8::bf16_t*)(F.ws + WS_W2), 512, 512, 512, (size_t)512 * 512, (size_t)256 * 512};
        pg8::GroupedOrder S; S.init(NG, 2, 1, F.G, F.vcu, REPF(4));
        pg8::EpiGeluZ E{(pg8::bf16_t*)(F.ws + WS_UZ)};
        pg8::gemm_phase<pg8::EpiGeluZ, pg8::GroupedOrder, true, true>(ring, g, S, E, F.tid);
    } SEAM(4);
    if (IN(5)) {
        pg8::Gemm g{(const pg8::bf16_t*)(F.ws + WS_UZ), (const pg8::bf16_t*)(F.ws + WS_WGLU), DM, DM, DM, 0, 0};
        pg8::StaticOrder S; S.init(MT, 2 * DM, F.G, (int)blockIdx.x, REPF(5));
        pg8::EpiGlu E{(pg8::bf16_t*)(F.ws + WS_YF), DM};
        pg8::gemm_phase<pg8::EpiGlu, pg8::StaticOrder, true, true>(ring, g, S, E, F.tid);
    } SEAM(5);
    if (IN(6)) { row_phase<0, true>(F, 0, 2, 1, 0, 3, 4, 2); } SEAM(6);
    for (int l = 0; l < 2; ++l) {
        const int pb = l == 0 ? 7 : 13;
        if (IN(pb)) {
            pg8::Gemm g{(const pg8::bf16_t*)(F.ws + WS_UZ), (const pg8::bf16_t*)(F.ws + WS_WUP) + (size_t)l * DFF2 * DM, DM, DM, DM, 0, 0};
            pg8::StaticOrder S; S.init(MT, DFF2, F.G, (int)blockIdx.x, REPF(pb));
            pg8::EpiBf16G E{(pg8::bf16_t*)(F.ws + WS_H), DFF2, 0};
            pg8::gemm_phase<pg8::EpiBf16G, pg8::StaticOrder, true, true>(ring, g, S, E, F.tid);
        } SEAM(pb);
        if (IN(pb + 1)) REPS(pb + 1) { conv_phase(F, l); } SEAM(pb + 1);
        if (IN(pb + 2)) {
            pg8::Gemm g{(const pg8::bf16_t*)(F.ws + WS_ACT), (const pg8::bf16_t*)(F.ws + WS_WDN) + (size_t)l * DM * DFF, DFF, DFF, DFF, 0, 0};
            pg8::StaticOrder S; S.init(MT, DM, F.G, (int)blockIdx.x, REPF(pb + 2));
            pg8::EpiBf16G E{(pg8::bf16_t*)(F.ws + WS_YF), DM, 0};
            pg8::gemm_phase<pg8::EpiBf16G, pg8::StaticOrder, true, true>(ring, g, S, E, F.tid);
        } SEAM(pb + 2);
        if (l == 0) {
            if (IN(10)) { row_phase<0, true>(F, 0, 5, 3, 1, 0, 1, 4); } SEAM(10);
            if (IN(11)) {
                pg8::Gemm g{(const pg8::bf16_t*)(F.ws + WS_UZ), (const pg8::bf16_t*)(F.ws + WS_WPOOL), DM, 512, 512, (size_t)512, (size_t)512 * 512};
                pg8::GroupedOrder S; S.init(4, MT / 256, 2, F.G, F.vcu, REPF(11));
                pg8::EpiBf16G E{(pg8::bf16_t*)(F.ws + WS_YF), DM, (size_t)512};
                pg8::gemm_phase<pg8::EpiBf16G, pg8::GroupedOrder, true, true>(ring, g, S, E, F.tid);
            } SEAM(11);
            if (IN(12)) { row_phase<1, true>(F, 1, 2, 5, 1, 3, 4, 6); } SEAM(12);
        } else {
            if (IN(16)) { row_phase<0, false>(F, 1, 5, 7, 0, 0, 0, 0); }
        }
    }
#undef IN
#undef SEAM
}

extern "C" void kernel_launch(void* const* d_in, const int* in_sizes, int n_in, void* d_out, int out_size, void* d_ws, size_t ws_size, hipStream_t stream) {
    static int grid = 0;
    if (grid == 0) {
        if (n_in != 22 || out_size != MT * DM || ws_size < WS_END) { fprintf(stderr, "kernel_launch: unexpected problem (n_in %d, out %d, ws %zu); nothing launched\n", n_in, out_size, ws_size); grid = -1; return; }
        int dev = 0, cus = 0, per_cu = 0;
        if (hipGetDevice(&dev) != hipSuccess || hipDeviceGetAttribute(&cus, hipDeviceAttributeMultiprocessorCount, dev) != hipSuccess) { grid = -1; return; }
        if (hipFuncSetAttribute((const void*)fwd_kernel, hipFuncAttributeMaxDynamicSharedMemorySize, LDS_BYTES) != hipSuccess) { fprintf(stderr, "kernel_launch: hipFuncSetAttribute failed\n"); grid = -1; return; }
        if (hipOccupancyMaxActiveBlocksPerMultiprocessor(&per_cu, (const void*)fwd_kernel, NTHR, LDS_BYTES) != hipSuccess || per_cu < 1) { fprintf(stderr, "kernel_launch: occupancy query reports %d blocks per CU\n", per_cu); per_cu = 1; }
        (void)hipGetLastError();
        grid = cus;
    }
    if (grid < 0) return;
    if (hipMemsetAsync((char*)d_ws + WS_CTL, 0, CTL_ZERO_BYTES, stream) != hipSuccess) { fprintf(stderr, "kernel_launch: hipMemsetAsync failed\n"); return; }
    Args a{};
    for (int i = 0; i < 22; ++i) a.in[i] = (const float*)d_in[i];
    a.out = (float*)d_out; a.ws = (unsigned char*)d_ws;
#if MK_N_LAUNCHES == 1
    a.ph_lo = 0; a.ph_hi = NPHASE; a.li = 0;
    hipLaunchKernelGGL(fwd_kernel, dim3(grid), dim3(NTHR), LDS_BYTES, stream, a);
#else
    for (int p = 0; p < NPHASE; ++p) { a.ph_lo = p; a.ph_hi = p + 1; a.li = p; hipLaunchKernelGGL(fwd_kernel, dim3(grid), dim3(NTHR), LDS_BYTES, stream, a); }
#endif
    const hipError_t le = hipPeekAtLastError();
    if (le != hipSuccess) fprintf(stderr, "kernel_launch: launch failed: %s\n", hipGetErrorName(le));
}
```

```cpp
#include <hip/hip_runtime.h>
#include <cstdio>
#include <cstdint>

#ifndef MK_N_LAUNCHES
#define MK_N_LAUNCHES 1
#endif

namespace pg8 {
#define PG8_LAS __attribute__((address_space(3)))
typedef unsigned short bf16_t;
typedef short bf16x8 __attribute__((ext_vector_type(8)));
typedef float f32x4 __attribute__((ext_vector_type(4)));
typedef float f32x16 __attribute__((ext_vector_type(16)));
typedef unsigned u32x4 __attribute__((ext_vector_type(4)));
typedef unsigned u32x2 __attribute__((ext_vector_type(2)));
constexpr int BM = 256, BK = 64, HALF = 128, HTB = HALF * BK * 2  , STAGE_BYTES = 8 * HTB, NXCD = 8, WGM = 8;

__host__ __device__ __forceinline__ int lds_byte(int r, int c) { const int st = (r >> 4) * 2 + (c >> 5), rr = r & 15, cc = c & 31, ob = rr * 64 + cc * 2; return st * 1024 + (ob ^ (((ob >> 9) & 1) << 5)); }
__host__ __device__ __forceinline__ void stage_rc(int b, int& R, int& C) { const int st = b / 1024, sb = b % 1024, swz = sb ^ (((sb >> 9) & 1) << 5); R = (st >> 1) * 16 + swz / 64; C = (st & 1) * 32 + (swz % 64) / 2; }
__host__ __device__ __forceinline__ int perm32(int rho) { const int n = rho >> 4, i = rho & 15; return 8 * (i >> 2) + 4 * n + (i & 3); }

struct Unit { int pm, pn, g; };
struct Gemm { const bf16_t* A; const bf16_t* Bt; int lda, ldb, K; size_t gsA, gsB; };

struct StaticOrder {
    int nM, nN, nwg, G, c, rep;
    __device__ void init(int M, int N, int G_, int c_, int rep_ = 1) { nM = M / BM; nN = N / BM; nwg = nM * nN; G = G_; c = c_; rep = rep_; }
    __device__ bool next(int i, Unit& u) const {
        const long L = (long)i * G + c; if (L >= (long)nwg * rep) return false;
        int wgid = (int)(L % nwg); { const int q = nwg / NXCD, r = nwg % NXCD, xcd = wgid % NXCD, off = wgid / NXCD; wgid = (xcd < r ? xcd * (q + 1) : r * (q + 1) + (xcd - r) * q) + off; }
        const int nig = WGM * nN, gid = wgid / nig, fm = gid * WGM, gsz = (nM - fm) < WGM ? (nM - fm) : WGM;
        u.pm = fm + ((wgid % nig) % gsz); u.pn = (wgid % nig) / gsz; u.g = 0; return true;
    }
};
struct GroupedOrder {
    int nG, nM, nN, G, c, rep;
    __device__ void init(int nG_, int nM_, int nN_, int G_, int c_, int rep_ = 1) { nG = nG_; nM = nM_; nN = nN_; G = G_; c = c_; rep = rep_; }
    __device__ bool next(int i, Unit& u) const {
        long L = (long)i * G + c; if (L >= (long)nG * nM * nN * rep) return false; L %= (long)nG * nM * nN;
        const int per = nM * nN, r = (int)(L % per); u.g = (int)(L / per); u.pn = r / nM; u.pm = r % nM; return true;
    }
};

__device__ __forceinline__ unsigned cvt_pk_bf16(float lo, float hi) { unsigned r; asm volatile("v_cvt_pk_bf16_f32 %0, %1, %2" : "=v"(r) : "v"(lo), "v"(hi)); return r; }
__device__ __forceinline__ float sigmoidf_fast(float x) { return __builtin_amdgcn_rcpf(1.0f + __builtin_amdgcn_exp2f(-1.44269504089f * x)); }
__device__ __forceinline__ float gelu_tanh(float y) { const float z = 0.7978845608f * (y + 0.044715f * y * y * y); return y * sigmoidf_fast(2.0f * z); }

struct EpiF32G {
    static constexpr bool PERM = false;
    float* C; int ldc; size_t gsC;
    __device__ __forceinline__ void operator()(const f32x4 (&acc)[2][2][4][2], const Unit& u, int wr, int wc, int fr, int fq) const {
        const int row0 = u.pm * BM + wr * 64 + fr, col0 = u.pn * BM + wc * 32 + 4 * fq; float* rowp = C + (size_t)u.g * gsC + (size_t)row0 * ldc + col0;
#pragma unroll
        for (int ai = 0; ai < 2; ++ai) {
#pragma unroll
            for (int m = 0; m < 4; ++m) {
#pragma unroll
                for (int bj = 0; bj < 2; ++bj)
#pragma unroll
                    for (int n = 0; n < 2; ++n) *(f32x4*)(rowp + bj * HALF + n * 16) = acc[ai][bj][m][n];
                asm volatile("" : "+v"(rowp)); rowp += (size_t)16 * ldc; }
            rowp += (size_t)64 * ldc; }
    }
};
struct EpiBf16G {
    static constexpr bool PERM = true;
    bf16_t* O; int ldc; size_t gsO;
    __device__ __forceinline__ void operator()(const f32x4 (&acc)[2][2][4][2], const Unit& u, int wr, int wc, int fr, int fq) const {
        const int row0 = u.pm * BM + wr * 64 + fr, col0 = u.pn * BM + wc * 32 + 8 * fq; bf16_t* rowp = O + (size_t)u.g * gsO + (size_t)row0 * ldc + col0;
#pragma unroll
        for (int ai = 0; ai < 2; ++ai) {
#pragma unroll
            for (int m = 0; m < 4; ++m) {
#pragma unroll
                for (int bj = 0; bj < 2; ++bj) { const f32x4 v0 = acc[ai][bj][m][0], v1 = acc[ai][bj][m][1];
                    u32x4 w; w.x = cvt_pk_bf16(v0[0], v0[1]); w.y = cvt_pk_bf16(v0[2], v0[3]); w.z = cvt_pk_bf16(v1[0], v1[1]); w.w = cvt_pk_bf16(v1[2], v1[3]);
                    *(u32x4*)(rowp + bj * HALF) = w; }
                asm volatile("" : "+v"(rowp)); rowp += (size_t)16 * ldc; }
            rowp += (size_t)64 * ldc; }
    }
};
struct EpiGeluZ {
    static constexpr bool PERM = true;
    bf16_t* Z;
    __device__ __forceinline__ void operator()(const f32x4 (&acc)[2][2][4][2], const Unit& u, int wr, int wc, int fr, int fq) const {
        bf16_t* rowp = Z + ((size_t)(u.pm * 4096 + (wr * 64 + fr) * 16 + 2 * wc + (fq >> 1))) * 2048 + u.g * 16 + 8 * (fq & 1);
#pragma unroll
        for (int ai = 0; ai < 2; ++ai) {
#pragma unroll
            for (int m = 0; m < 4; ++m) {
#pragma unroll
                for (int bj = 0; bj < 2; ++bj) {
                    const f32x4 v0 = acc[ai][bj][m][0], v1 = acc[ai][bj][m][1];
                    u32x4 w; w.x = cvt_pk_bf16(gelu_tanh(v0[0]), gelu_tanh(v0[1])); w.y = cvt_pk_bf16(gelu_tanh(v0[2]), gelu_tanh(v0[3]));
                    w.z = cvt_pk_bf16(gelu_tanh(v1[0]), gelu_tanh(v1[1])); w.w = cvt_pk_bf16(gelu_tanh(v1[2]), gelu_tanh(v1[3]));
                    *(u32x4*)(rowp + (size_t)bj * 8 * 2048) = w; }
                asm volatile("" : "+v"(rowp)); rowp += (size_t)16 * 16 * 2048; }
            rowp += (size_t)64 * 16 * 2048; }
    }
};
struct EpiGlu {
    static constexpr bool PERM = true;
    bf16_t* O; int ldc;
    __device__ __forceinline__ void operator()(const f32x4 (&acc)[2][2][4][2], const Unit& u, int wr, int wc, int fr, int fq) const {
        const int row0 = u.pm * BM + wr * 64 + fr, col0 = u.pn * HALF + wc * 32 + 8 * fq; bf16_t* rowp = O + (size_t)row0 * ldc + col0;
#pragma unroll
        for (int ai = 0; ai < 2; ++ai) {
#pragma unroll
            for (int m = 0; m < 4; ++m) {
                const f32x4 v0 = acc[ai][0][m][0], v1 = acc[ai][0][m][1], g0 = acc[ai][1][m][0], g1 = acc[ai][1][m][1];
                u32x4 w; w.x = cvt_pk_bf16(v0[0] * sigmoidf_fast(g0[0]), v0[1] * sigmoidf_fast(g0[1])); w.y = cvt_pk_bf16(v0[2] * sigmoidf_fast(g0[2]), v0[3] * sigmoidf_fast(g0[3]));
                w.z = cvt_pk_bf16(v1[0] * sigmoidf_fast(g1[0]), v1[1] * sigmoidf_fast(g1[1])); w.w = cvt_pk_bf16(v1[2] * sigmoidf_fast(g1[2]), v1[3] * sigmoidf_fast(g1[3]));
                *(u32x4*)rowp = w;
                asm volatile("" : "+v"(rowp)); rowp += (size_t)16 * ldc; }
            rowp += (size_t)64 * ldc; }
    }
};

template <class Epi, class Sched, bool ALIGN_EPI = false, bool SP2 = false>
__device__ __forceinline__ void gemm_phase(PG8_LAS unsigned char* lds, const Gemm g, const Sched& S, const Epi& E, const int tid) {
    const int wid = __builtin_amdgcn_readfirstlane(tid >> 6), lane = tid & 63, wr = wid >> 2, wc = wid & 3, fr = lane & 15, fq = lane >> 4;
    const int K = g.K, nt = K / BK;
    unsigned voffA[2], voffB[2];
#pragma unroll
    for (int i = 0; i < 2; ++i) { int R, C; stage_rc(tid * 16 + i * 8192, R, C); const int Rb = Epi::PERM ? ((R & ~31) + perm32(R & 31)) : R;
        voffA[i] = (unsigned)(R * g.lda + C) * 2u; voffB[i] = (unsigned)(Rb * g.ldb + C) * 2u; }
    const size_t kstep = (size_t)(BK * 2);
    const size_t hstepA = (size_t)HALF * g.lda * 2, hstepB = (size_t)HALF * g.ldb * 2;
    const size_t tstepA = 2 * hstepA, tstepB = 2 * hstepB;
    const unsigned ldsw = (unsigned)wid * 1024u;
    const int aoff = lds_byte(wr * 64 + fr, fq * 8), boff = lds_byte(wc * 32 + fr, fq * 8);
#define PG8_SA(b, h) (((b) * 2 + (h)) * HTB)
#define PG8_SB(b, h) ((4 + (b) * 2 + (h)) * HTB)
#define PG8_STAGE(bufoff, gbase, voff) do { _Pragma("unroll") for (int _i = 0; _i < 2; ++_i) \
        __builtin_amdgcn_global_load_lds((const unsigned*)((const char*)(gbase) + (voff)[_i]), (PG8_LAS unsigned*)(lds + (bufoff) + ldsw + _i * 8192), 16, 0, 0); } while (0)
#define PG8_LDA(dst, b, h) do { _Pragma("unroll") for (int m = 0; m < 4; ++m) _Pragma("unroll") for (int k = 0; k < 2; ++k) dst[m][k] = *(const PG8_LAS bf16x8*)(lds + PG8_SA(b, h) + aoff + m * 2048 + k * 1024); } while (0)
#define PG8_LDB(dst, b, h) do { _Pragma("unroll") for (int n = 0; n < 2; ++n) _Pragma("unroll") for (int k = 0; k < 2; ++k) dst[n][k] = *(const PG8_LAS bf16x8*)(lds + PG8_SB(b, h) + boff + n * 2048 + k * 1024); } while (0)
#define PG8_MMA(ai, bj, At, Bt) do { __builtin_amdgcn_s_setprio(1); _Pragma("unroll") for (int m = 0; m < 4; ++m) _Pragma("unroll") for (int n = 0; n < 2; ++n) _Pragma("unroll") for (int k = 0; k < 2; ++k) \
        acc[ai][bj][m][n] = __builtin_amdgcn_mfma_f32_16x16x32_bf16(Bt[n][k], At[m][k], acc[ai][bj][m][n], 0, 0, 0); __builtin_amdgcn_s_setprio(0); } while (0)
#define PG8_WAIT_V(n) asm volatile("s_waitcnt vmcnt(" #n ")" ::: "memory")
#define PG8_WAIT_L(n) asm volatile("s_waitcnt lgkmcnt(" #n ")" ::: "memory")
#define PG8_BAR __builtin_amdgcn_s_barrier()
#define PG8_SCHED __builtin_amdgcn_sched_barrier(0)
    Unit cur, nxt; int ui = 0;
    if (!S.next(0, cur)) return;
    f32x4 acc[2][2][4][2];
#pragma unroll
    for (int a = 0; a < 2; ++a)
#pragma unroll
        for (int b = 0; b < 2; ++b)
#pragma unroll
            for (int m = 0; m < 4; ++m)
#pragma unroll
                for (int n = 0; n < 2; ++n) acc[a][b][m][n] = (f32x4){0.f, 0.f, 0.f, 0.f};
    bf16x8 At[4][2], B0[2][2], B1[2][2];
    const char* cA = (const char*)g.A + ((size_t)cur.g * g.gsA) * 2 + (size_t)cur.pm * tstepA; const char* cB = (const char*)g.Bt + ((size_t)cur.g * g.gsB) * 2 + (size_t)cur.pn * tstepB;
    if constexpr (SP2) {
        PG8_STAGE(PG8_SB(0, 0), cB, voffB); PG8_STAGE(PG8_SB(0, 1), cB + hstepB, voffB); PG8_STAGE(PG8_SA(0, 0), cA, voffA); PG8_STAGE(PG8_SA(0, 1), cA + hstepA, voffA);
        if (wr == 1) PG8_BAR;
        PG8_WAIT_V(2); PG8_BAR;
        PG8_STAGE(PG8_SB(1, 0), cB + kstep, voffB); PG8_STAGE(PG8_SA(1, 0), cA + kstep, voffA); PG8_STAGE(PG8_SB(1, 1), cB + hstepB + kstep, voffB);
        PG8_WAIT_V(6); PG8_BAR;
    } else {
        PG8_STAGE(PG8_SB(0, 0), cB, voffB); PG8_STAGE(PG8_SA(0, 0), cA, voffA); PG8_STAGE(PG8_SB(0, 1), cB + hstepB, voffB); PG8_STAGE(PG8_SA(0, 1), cA + hstepA, voffA);
        if (wr == 1) PG8_BAR;
        PG8_WAIT_V(4); PG8_BAR;
        PG8_STAGE(PG8_SB(1, 0), cB + kstep, voffB); PG8_STAGE(PG8_SA(1, 0), cA + kstep, voffA); PG8_STAGE(PG8_SB(1, 1), cB + hstepB + kstep, voffB);
        PG8_WAIT_V(6); PG8_BAR;
    }
    for (;;) {
        const bool has_next = S.next(ui + 1, nxt);
        const char* nA = has_next ? (const char*)g.A + ((size_t)nxt.g * g.gsA) * 2 + (size_t)nxt.pm * tstepA : cA; const char* nB = has_next ? (const char*)g.Bt + ((size_t)nxt.g * g.gsB) * 2 + (size_t)nxt.pn * tstepB : cB;
        for (int t = 0; t < nt; t += 2) {
            const bool last = (t == nt - 2);
            const char* a1 = cA + (size_t)(t + 1) * kstep;
            const char* a2 = last ? nA : cA + (size_t)(t + 2) * kstep; const char* b2 = last ? nB : cB + (size_t)(t + 2) * kstep;
            const char* a3 = a2 + kstep; const char* b3 = b2 + kstep;
            if constexpr (SP2) {
            PG8_LDB(B0, 0, 0); PG8_LDB(B1, 0, 1); PG8_SCHED; PG8_LDA(At, 0, 0); PG8_STAGE(PG8_SA(1, 1), a1 + hstepA, voffA);
            PG8_WAIT_V(8); PG8_WAIT_L(0); PG8_BAR; PG8_MMA(0, 0, At, B0); PG8_MMA(0, 1, At, B1); PG8_BAR; PG8_SCHED;
            PG8_LDA(At, 0, 1); PG8_STAGE(PG8_SB(0, 0), b2, voffB); PG8_STAGE(PG8_SB(0, 1), b2 + hstepB, voffB); PG8_STAGE(PG8_SA(0, 0), a2, voffA);
            PG8_WAIT_V(8); PG8_WAIT_L(0); PG8_BAR; PG8_MMA(1, 0, At, B0); PG8_MMA(1, 1, At, B1); PG8_BAR; PG8_SCHED;
            PG8_LDB(B0, 1, 0); PG8_LDB(B1, 1, 1); PG8_SCHED; PG8_LDA(At, 1, 0); PG8_STAGE(PG8_SA(0, 1), a2 + hstepA, voffA);
            PG8_WAIT_V(8); PG8_WAIT_L(0); PG8_BAR; PG8_MMA(0, 0, At, B0); PG8_MMA(0, 1, At, B1); PG8_BAR; PG8_SCHED;
            PG8_LDA(At, 1, 1); PG8_STAGE(PG8_SB(1, 0), b3, voffB); PG8_STAGE(PG8_SB(1, 1), b3 + hstepB, voffB); PG8_STAGE(PG8_SA(1, 0), a3, voffA);
            PG8_WAIT_V(8); PG8_WAIT_L(0); PG8_BAR; PG8_MMA(1, 0, At, B0); PG8_MMA(1, 1, At, B1); PG8_BAR; PG8_SCHED;
            } else {
            PG8_LDB(B0, 0, 0); PG8_SCHED; PG8_LDA(At, 0, 0); PG8_STAGE(PG8_SA(1, 1), a1 + hstepA, voffA);
            PG8_WAIT_L(8); PG8_BAR; PG8_WAIT_L(0); PG8_MMA(0, 0, At, B0); PG8_BAR; PG8_SCHED;
            PG8_LDB(B1, 0, 1); PG8_STAGE(PG8_SB(0, 0), b2, voffB);
            PG8_BAR; PG8_WAIT_L(0); PG8_MMA(0, 1, At, B1); PG8_BAR;
            PG8_LDA(At, 0, 1); PG8_STAGE(PG8_SA(0, 0), a2, voffA);
            PG8_BAR; PG8_WAIT_L(0); PG8_MMA(1, 0, At, B0); PG8_BAR; PG8_SCHED;
            PG8_STAGE(PG8_SB(0, 1), b2 + hstepB, voffB);
            PG8_WAIT_V(6); PG8_BAR; PG8_MMA(1, 1, At, B1); PG8_BAR;
            PG8_LDB(B0, 1, 0); PG8_SCHED; PG8_LDA(At, 1, 0); PG8_STAGE(PG8_SA(0, 1), a2 + hstepA, voffA);
            PG8_WAIT_L(8); PG8_BAR; PG8_WAIT_L(0); PG8_MMA(0, 0, At, B0); PG8_BAR; PG8_SCHED;
            PG8_LDB(B1, 1, 1); PG8_STAGE(PG8_SB(1, 0), b3, voffB);
            PG8_BAR; PG8_WAIT_L(0); PG8_MMA(0, 1, At, B1); PG8_BAR;
            PG8_LDA(At, 1, 1); PG8_STAGE(PG8_SA(1, 0), a3, voffA);
            PG8_BAR; PG8_WAIT_L(0); PG8_MMA(1, 0, At, B0); PG8_BAR; PG8_SCHED;
            PG8_STAGE(PG8_SB(1, 1), b3 + hstepB, voffB);
            PG8_WAIT_V(6); PG8_BAR; PG8_MMA(1, 1, At, B1); PG8_BAR;
            }
        }
        if constexpr (ALIGN_EPI) { if (wr == 0) PG8_BAR; }
        E(acc, cur, wr, wc, fr, fq);
        if (!has_next) break;
#pragma unroll
        for (int a = 0; a < 2; ++a)
#pragma unroll
            for (int b = 0; b < 2; ++b)
#pragma unroll
                for (int m = 0; m < 4; ++m)
#pragma unroll
                    for (int n = 0; n < 2; ++n) acc[a][b][m][n] = (f32x4){0.f, 0.f, 0.f, 0.f};
        cur = nxt; cA = nA; cB = nB; ++ui;
        if constexpr (ALIGN_EPI) { if (wr == 1) PG8_BAR; }
    }
    PG8_WAIT_V(0);
    if constexpr (!ALIGN_EPI) { if (wr == 0) PG8_BAR; }
    PG8_BAR;
#undef PG8_SA
#undef PG8_SB
#undef PG8_STAGE
#undef PG8_LDA
#undef PG8_LDB
#undef PG8_MMA
#undef PG8_WAIT_V
#undef PG8_WAIT_L
#undef PG8_BAR
#undef PG8_SCHED
}
}

constexpr int NWAVES = 8, NTHR = NWAVES * 64;
constexpr int DM = 2048, NBATCH = 2, SEQ = 4096, CTX = 256, MT = NBATCH * SEQ, MC = NBATCH * CTX, DFF = 5632, DFF2 = 2 * DFF, NMODC = 6 * DM, NG = 128;
constexpr float RMS_EPS = 1e-6f;
constexpr int NPHASE = 17;

constexpr size_t MiB = 1u << 20;
constexpr size_t WS_CTL = 0, CTL_ZERO_BYTES = 1 * MiB;
constexpr size_t WS_MODP = 1 * MiB;
constexpr size_t WS_A16 = 4 * MiB;
constexpr size_t WS_WGLU = 5 * MiB;
constexpr size_t WS_WUP = 21 * MiB;
constexpr size_t WS_WDN = 109 * MiB;
constexpr size_t WS_WPOOL = 153 * MiB;
constexpr size_t WS_UZ = 155 * MiB;
constexpr size_t WS_YF = 187 * MiB;
constexpr size_t WS_ACT = 219 * MiB;
constexpr size_t WS_H = 307 * MiB;
constexpr size_t WS_WIN = 307 * MiB;
constexpr size_t WS_W2 = 323 * MiB;
constexpr size_t WS_A2 = 355 * MiB;
constexpr size_t WS_UCG = 419 * MiB;
constexpr size_t WS_SLOC = 421 * MiB;
constexpr size_t WS_SCLOC = 485 * MiB;
constexpr size_t WS_END = 489 * MiB;
static_assert(WS_H + (size_t)MT * DFF2 * 2 <= WS_END && WS_SCLOC + (size_t)NG * 32 * 256 * 4 <= WS_END, "d_ws map");
constexpr int CW_BAR = 4096;

constexpr int RING_OFF = 0, RING_BYTES = 131072;
constexpr int LDSCTL_OFF = RING_BYTES, MISC_OFF = LDSCTL_OFF + 320, PTR_OFF = LDSCTL_OFF + 1024;
constexpr int LDS_BYTES = 147456;

#define GAS __attribute__((address_space(1)))
#define LAS __attribute__((address_space(3)))
typedef unsigned short bf16;
typedef unsigned v4u __attribute__((ext_vector_type(4)));
typedef unsigned v2u __attribute__((ext_vector_type(2)));
typedef float f32x4 __attribute__((ext_vector_type(4)));
typedef short bf16x8 __attribute__((ext_vector_type(8)));
typedef float f32x16 __attribute__((ext_vector_type(16)));
#define LDS_WAIT() asm volatile("s_waitcnt lgkmcnt(0)" ::: "memory")
#define VM_WAIT() asm volatile("s_waitcnt vmcnt(0)" ::: "memory")
__device__ __forceinline__ unsigned f2bf(float f) { unsigned u = __builtin_bit_cast(unsigned, f); return (u + 0x7fffu + ((u >> 16) & 1u)) >> 16; }
__device__ __forceinline__ unsigned pk2(float lo, float hi) { return f2bf(lo) | (f2bf(hi) << 16); }
__device__ __forceinline__ float bf_lo(unsigned w) { return __builtin_bit_cast(float, w << 16); }
__device__ __forceinline__ float bf_hi(unsigned w) { return __builtin_bit_cast(float, w & 0xffff0000u); }
__device__ __forceinline__ float sigm(float x) { return __builtin_amdgcn_rcpf(1.0f + __builtin_amdgcn_exp2f(-1.44269504089f * x)); }

#define XB_TMO      128
#define XB_XCNT(j)  (256  + 64 * (j))
#define XB_XSUB(j)  (1280 + 64 * (j))
#define XB_XGEN(j)  (2304 + 64 * (j))
#define XB_TOP      3328
#define XB_TOPGEN   3392
#define XCD_BAR_WORDS 3456
#define XB_SPIN_CAP (1u << 20)
__device__ __forceinline__ unsigned xb_ld(unsigned* p)              { return __hip_atomic_load(p, __ATOMIC_RELAXED, __HIP_MEMORY_SCOPE_AGENT); }
__device__ __forceinline__ unsigned xb_add(unsigned* p, unsigned v) { return __hip_atomic_fetch_add(p, v, __ATOMIC_RELAXED, __HIP_MEMORY_SCOPE_AGENT); }
__device__ __forceinline__ unsigned xb_xcc_id() { return (unsigned)__builtin_amdgcn_s_getreg((3 << 11) | 20) & 0xFu; }
#define XB_SPIN(cond, bar) do { unsigned _sp = 0; while (cond) { __builtin_amdgcn_s_sleep(1); \
    if ((++_sp & 255u) == 0u) { if (xb_ld(&(bar)[XB_TMO])) break; if (_sp > XB_SPIN_CAP) { atomicAdd(&(bar)[XB_TMO], 1u); break; } } } } while (0)
struct XcdBarrier { unsigned* bar; unsigned x; volatile LAS unsigned* st; };
__device__ __forceinline__ XcdBarrier xcd_barrier_post(unsigned* bar, volatile LAS unsigned* st) {
    XcdBarrier b; b.bar = bar; b.x = xb_xcc_id(); b.st = st;
    if (threadIdx.x == 0) (void)xb_add(&bar[XB_XCNT(b.x)], 1u);
    return b;
}
__device__ __forceinline__ void xcd_barrier_complete(unsigned* bar, unsigned x, unsigned& nloc, unsigned& nx) {
    const unsigned G = gridDim.x * gridDim.y * gridDim.z;
    unsigned sum, cnt, mine, sp = 0u;
    for (;;) {
        sum = 0u; cnt = 0u; mine = 0u;
#pragma unroll
        for (unsigned j = 0; j < 16; ++j) { const unsigned c = xb_ld(&bar[XB_XCNT(j)]); sum += c; cnt += (c > 0u) ? 1u : 0u; mine = (j == x) ? c : mine; }
        if (sum == G) break;
        __builtin_amdgcn_s_sleep(1);
        if ((++sp & 255u) == 0u) { if (xb_ld(&bar[XB_TMO])) break; if (sp > XB_SPIN_CAP) { atomicAdd(&bar[XB_TMO], 1u); break; } }
    }
    nloc = mine > 0u ? mine : 1u; nx = cnt > 0u ? cnt : 1u;
}
__device__ __forceinline__ void xcd_barrier(const XcdBarrier& b) {
    asm volatile("s_waitcnt vmcnt(0)" ::: "memory");
    __syncthreads();
    if (threadIdx.x == 0) {
        unsigned* bar = b.bar;
        __builtin_amdgcn_s_waitcnt(0);
        unsigned nloc = b.st[0], nx = b.st[1];
        if (nloc == 0u) { xcd_barrier_complete(bar, b.x, nloc, nx); b.st[0] = nloc; b.st[1] = nx; }
        const unsigned old = xb_add(&bar[XB_XSUB(b.x)], 1u);
        const unsigned gen = old / nloc;
        if (old + 1u == (gen + 1u) * nloc) {
            __builtin_amdgcn_fence(__ATOMIC_RELEASE, "agent");
            asm volatile("s_waitcnt vmcnt(0)" ::: "memory");
            const unsigned og = xb_add(&bar[XB_TOP], 1u);
            const unsigned tg = og / nx;
            if (og + 1u == (tg + 1u) * nx) xb_add(&bar[XB_TOPGEN], 1u);
            else XB_SPIN(xb_ld(&bar[XB_TOPGEN]) == tg, bar);
            __builtin_amdgcn_fence(__ATOMIC_ACQUIRE, "agent");
            xb_add(&bar[XB_XGEN(b.x)], 1u);
            asm volatile("s_waitcnt vmcnt(0)" ::: "memory");
        } else {
            XB_SPIN(xb_ld(&bar[XB_XGEN(b.x)]) == gen, bar);
            __builtin_amdgcn_fence(__ATOMIC_ACQUIRE, "agent");
            asm volatile("s_waitcnt vmcnt(0)" ::: "memory");
        }
    }
    __syncthreads();
}

struct Args { const float* in[22]; float* out; unsigned char* ws; int ph_lo, ph_hi, li, pad; };
struct Frame {
    LAS unsigned char* lds;
    int tid, lane, wave, vcu, G;
    float* out; unsigned char* ws;
    __device__ __forceinline__ const float* inp(int i) const { return *(const float* LAS*)(lds + PTR_OFF + 8 * i); }
};
enum { I_X = 0, I_C, I_CTX, I_CCTX, I_ADAW, I_ADAB, I_NORMG, I_LAMRE, I_LAMIM, I_LOGSTEP, I_BRE, I_BIM, I_CRE, I_CIM, I_S5D, I_GLUW, I_POOLW, I_POOLS, I_UP, I_CONV, I_CONVB, I_DOWN };

__device__ __forceinline__ float wave_sum(float v) {
#pragma unroll
    for (int o = 1; o < 64; o <<= 1) v += __shfl_xor(v, o);
    return v;
}

__device__ __forceinline__ void sincos_d(double x, double& s, double& c) {
    const double q = __builtin_rint(x * 0.63661977236758134308);
    double r = __builtin_fma(-q, 1.57079632679489655800e+00, x); r = __builtin_fma(-q, 6.12323399573676603587e-17, r);
    const int iq = ((int)q) & 3; const double r2 = r * r;
    double sp = 1.0 / 6227020800.0; sp = sp * r2 - 1.0 / 39916800.0; sp = sp * r2 + 1.0 / 362880.0; sp = sp * r2 - 1.0 / 5040.0; sp = sp * r2 + 1.0 / 120.0; sp = sp * r2 - 1.0 / 6.0; sp = sp * r2 + 1.0; sp *= r;
    double cp = -1.0 / 87178291200.0; cp = cp * r2 + 1.0 / 479001600.0; cp = cp * r2 - 1.0 / 3628800.0; cp = cp * r2 + 1.0 / 40320.0; cp = cp * r2 - 1.0 / 720.0; cp = cp * r2 + 1.0 / 24.0; cp = cp * r2 - 0.5; cp = cp * r2 + 1.0;
    s = (iq == 0) ? sp : (iq == 1) ? cp : (iq == 2) ? -sp : -cp;
    c = (iq == 0) ? cp : (iq == 1) ? -sp : (iq == 2) ? -cp : sp;
}
__device__ __forceinline__ double exp_d(double x) {
    const double n = __builtin_rint(x * 1.44269504088896340736);
    double r = __builtin_fma(-n, 6.93147180369123816490e-01, x); r = __builtin_fma(-n, 1.90821492927058770002e-10, r);
    double p = 1.0 / 479001600.0;
    p = p * r + 1.0 / 39916800.0; p = p * r + 1.0 / 3628800.0; p = p * r + 1.0 / 362880.0; p = p * r + 1.0 / 40320.0; p = p * r + 1.0 / 5040.0; p = p * r + 1.0 / 720.0;
    p = p * r + 1.0 / 120.0; p = p * r + 1.0 / 24.0; p = p * r + 1.0 / 6.0; p = p * r + 0.5; p = p * r + 1.0; p = p * r + 1.0;
    return __builtin_ldexp(p, (int)n);
}

template <int MODE>
__device__ __forceinline__ void p0_transpose_item(const float* W, int K, int N, bf16* WT, LAS unsigned* scr, int item, int lane) {
    const int nblk = N / 64, kb = item / nblk, nb = item % nblk, k0 = 64 * kb, n0 = 64 * nb;
    const float* src = W + (size_t)k0 * N + n0 + lane;
    float v[64];
#pragma unroll
    for (int i = 0; i < 64; ++i) v[i] = *(const GAS float*)(src + (size_t)i * N);
#pragma unroll
    for (int i = 0; i < 32; ++i) scr[i * 65 + lane] = pk2(v[2 * i], v[2 * i + 1]);
    LDS_WAIT(); asm volatile("" ::: "memory");
    const int c = lane & 7;
    int r0 = n0;
    if (MODE == 1) { r0 = (n0 < 2048) ? (256 * (n0 >> 7) + (n0 & 127)) : (256 * ((n0 - 2048) >> 7) + 128 + ((n0 - 2048) & 127)); }
#pragma unroll
    for (int j = 0; j < 8; ++j) { const int n = (lane >> 3) + 8 * j; const LAS unsigned* q = scr + (4 * c) * 65 + n;
        v4u o; o.x = q[0]; o.y = q[65]; o.z = q[130]; o.w = q[195];
        *(GAS v4u*)(WT + (size_t)(r0 + n) * K + k0 + 8 * c) = o; }
    LDS_WAIT(); asm volatile("" ::: "memory");
}

__device__ __forceinline__ void p0_ada_item(Frame& F, int it) {
    LAS float* cond = (LAS float*)(F.lds);
    LAS float* red = (LAS float*)(F.lds + 24576);
    const int l = it / 384, r = it % 384, s = r / 48, ct = r % 48, k0 = s * 256 + F.wave * 32, n0 = ct * 256;
    const float* W = F.inp(I_ADAW) + (size_t)l * DM * NMODC + (size_t)k0 * NMODC + n0 + 4 * F.lane;
    f32x4 a0 = {0.f, 0.f, 0.f, 0.f}, a1 = a0, a2 = a0;
#pragma unroll 8
    for (int i = 0; i < 32; ++i) { const f32x4 w = *(const GAS f32x4*)(W + (size_t)i * NMODC);
        const float c0 = cond[k0 + i], c1 = cond[2048 + k0 + i], c2 = cond[4096 + k0 + i];
        a0 += w * c0; a1 += w * c1; a2 += w * c2; }
    *(LAS f32x4*)(red + (F.wave * 3 + 0) * 256 + 4 * F.lane) = a0;
    *(LAS f32x4*)(red + (F.wave * 3 + 1) * 256 + 4 * F.lane) = a1;
    *(LAS f32x4*)(red + (F.wave * 3 + 2) * 256 + 4 * F.lane) = a2;
    __syncthreads();
    float* MODP = (float*)(F.ws + WS_MODP);
    for (int o = F.tid; o < 768; o += NTHR) { const int v = o >> 8, col = o & 255; float sum = 0.f;
#pragma unroll
        for (int w = 0; w < 8; ++w) sum += red[(w * 3 + v) * 256 + col];
        MODP[((size_t)(l * 8 + s) * 3 + v) * NMODC + n0 + col] = sum; }
    __syncthreads();
}

__device__ __forceinline__ void p0_s5_item(Frame& F, int g) {
    LAS float* APR = (LAS float*)(F.lds);
    LAS float* API = APR + 2176;
    LAS float* BBR = API + 2176;
    LAS float* BBI = BBR + 2048;
    LAS float* CCR = BBI + 2048;
    LAS float* CCI = CCR + 2048;
    LAS float* KT = CCI + 2048;
    const float* lam_re = F.inp(I_LAMRE); const float* lam_im = F.inp(I_LAMIM); const float* logst = F.inp(I_LOGSTEP);
    for (int idx = F.tid; idx < 2176; idx += NTHR) { const int p = idx & 63, dk = idx >> 6, d = dk / 17, k = dk % 17;
        const double dt = exp_d((double)logst[d * NG + g]); const double lr = (double)lam_re[(d * NG + g) * 64 + p], li = (double)lam_im[(d * NG + g) * 64 + p];
        const double mag = exp_d((double)k * lr * dt); double sn, cs; sincos_d((double)k * li * dt, sn, cs);
        APR[idx] = (float)(mag * cs); API[idx] = (float)(mag * sn); }
    for (int idx = F.tid; idx < 2048; idx += NTHR) { const int c = idx & 15, dp = idx >> 4, d = dp >> 6, p = dp & 63;
        const double dt = exp_d((double)logst[d * NG + g]); const double lr = (double)lam_re[(d * NG + g) * 64 + p], li = (double)lam_im[(d * NG + g) * 64 + p];
        const double mag = exp_d(lr * dt); double sn, cs; sincos_d(li * dt, sn, cs);
        const double nr = mag * cs - 1.0, ni = mag * sn, den = lr * lr + li * li;
        const double fr = (nr * lr + ni * li) / den, fi = (ni * lr - nr * li) / den;
        const size_t bi = ((size_t)(d * NG + g) * 64 + p) * 16 + c; const double br = (double)F.inp(I_BRE)[bi], bim = (double)F.inp(I_BIM)[bi];
        BBR[idx] = (float)(fr * br - fi * bim); BBI[idx] = (float)(fr * bim + fi * br);
        const int cc = idx >> 6, pp = idx & 63;
        const int d2 = cc >> 4, c2 = cc & 15; const size_t ci = ((size_t)(d2 * NG + g) * 16 + c2) * 64 + pp;
        CCR[idx] = F.inp(I_CRE)[ci]; CCI[idx] = F.inp(I_CIM)[ci]; }
    __syncthreads();
    bf16* WIN = (bf16*)(F.ws + WS_WIN) + (size_t)g * 256 * 256;
    for (int q = F.tid; q < 8192; q += NTHR) { const int n = q >> 5, kc = q & 31, d = n >> 7, part = (n >> 6) & 1, p = n & 63, j = kc >> 1, c0 = 8 * (kc & 1);
        const int e = d == 0 ? 15 - j : j; const float ar = APR[(d * 17 + e) * 64 + p], ai = API[(d * 17 + e) * 64 + p];
        float v[8];
#pragma unroll
        for (int x = 0; x < 8; ++x) { const float br = BBR[(d * 64 + p) * 16 + c0 + x], bi = BBI[(d * 64 + p) * 16 + c0 + x]; v[x] = part == 0 ? ar * br - ai * bi : ar * bi + ai * br; }
        v4u o; o.x = pk2(v[0], v[1]); o.y = pk2(v[2], v[3]); o.z = pk2(v[4], v[5]); o.w = pk2(v[6], v[7]);
        *(GAS v4u*)(WIN + (size_t)n * 256 + 8 * kc) = o; }
    { const int cp = F.tid & 15, tau = (F.tid >> 4) & 15, d = F.tid >> 8; f32x4 s0 = {0.f, 0.f, 0.f, 0.f}, s1 = s0, s2 = s0, s3 = s0;
#pragma unroll 4
      for (int p = 0; p < 64; ++p) { const float cr = CCR[(d * 16 + cp) * 64 + p], ci = CCI[(d * 16 + cp) * 64 + p], ar = APR[(d * 17 + tau) * 64 + p], ai = API[(d * 17 + tau) * 64 + p];
          const float mr = cr * ar - ci * ai, mi = cr * ai + ci * ar; const LAS f32x4* br = (const LAS f32x4*)(BBR + (d * 64 + p) * 16); const LAS f32x4* bi = (const LAS f32x4*)(BBI + (d * 64 + p) * 16);
          s0 += br[0] * mr - bi[0] * mi; s1 += br[1] * mr - bi[1] * mi; s2 += br[2] * mr - bi[2] * mi; s3 += br[3] * mr - bi[3] * mi; }
      LAS f32x4* o = (LAS f32x4*)(KT + ((d * 16 + tau) * 16 + cp) * 16); o[0] = s0; o[1] = s1; o[2] = s2; o[3] = s3; }
    __syncthreads();
    bf16* W2 = (bf16*)(F.ws + WS_W2) + (size_t)g * 256 * 512;
    const float* dsk = F.inp(I_S5D) + g * 16;
    for (int q = F.tid; q < 16384; q += NTHR) { const int n = q >> 6, kc = q & 63, jp = n >> 4, cp = n & 15; float v[8];
        if (kc < 32) { const int d = kc >> 4, part = (kc >> 3) & 1, p0 = 8 * (kc & 7), e = d == 0 ? jp + 1 : 16 - jp;
#pragma unroll
            for (int x = 0; x < 8; ++x) { const int p = p0 + x; const float cr = CCR[(d * 16 + cp) * 64 + p], ci = CCI[(d * 16 + cp) * 64 + p], ar = APR[(d * 17 + e) * 64 + p], ai = API[(d * 17 + e) * 64 + p];
                v[x] = part == 0 ? cr * ar - ci * ai : -(cr * ai + ci * ar); }
        } else { const int j = (kc - 32) >> 1, c0 = 8 * ((kc - 32) & 1);
#pragma unroll
            for (int x = 0; x < 8; ++x) { const int c = c0 + x; float s = 0.f;
                if (j <= jp) s += KT[((0 * 16 + (jp - j)) * 16 + cp) * 16 + c];
                if (j >= jp) s += KT[((1 * 16 + (j - jp)) * 16 + cp) * 16 + c];
                if (j == jp && c == cp) s += dsk[c];
                v[x] = s; } }
        v4u o; o.x = pk2(v[0], v[1]); o.y = pk2(v[2], v[3]); o.z = pk2(v[4], v[5]); o.w = pk2(v[6], v[7]);
        *(GAS v4u*)(W2 + (size_t)n * 512 + 8 * kc) = o; }
    if (F.tid < 128) { const int d = F.tid >> 6, p = F.tid & 63; float* A16 = (float*)(F.ws + WS_A16) + ((size_t)(d * NG + g) * 64 + p) * 2;
        A16[0] = APR[(d * 17 + 16) * 64 + p]; A16[1] = API[(d * 17 + 16) * 64 + p]; }
    __syncthreads();
}

__device__ __forceinline__ void p0_prologue(Frame& F) {
    for (int g = F.vcu; g < NG; g += F.G) p0_s5_item(F, g);
    { LAS float* cond = (LAS float*)(F.lds);
      for (int i = F.tid; i < 3 * DM; i += NTHR) { const float x = i < 2 * DM ? F.inp(I_C)[i] : F.inp(I_CCTX)[i - 2 * DM]; cond[i] = x * sigm(x); }
      __syncthreads();
      for (int it = F.vcu; it < 768; it += F.G) p0_ada_item(F, it); }
    __syncthreads();
    LAS unsigned* scr = (LAS unsigned*)(F.lds + F.wave * 16384);
    const int gw = F.vcu * NWAVES + F.wave, NGW = F.G * NWAVES;
    constexpr int I_G = (DM / 64) * (2 * DM / 64), I_U = (DM / 64) * (DFF2 / 64), I_D = (DFF / 64) * (DM / 64), I_P = (512 / 64) * (512 / 64);
    constexpr int NITEMS = I_G + I_U + I_D + 4 * I_P;
    for (int it = gw; it < NITEMS; it += NGW) {
        int r = it;
        if (r < I_G) { p0_transpose_item<1>(F.inp(I_GLUW), DM, 2 * DM, (bf16*)(F.ws + WS_WGLU), scr, r, F.lane); continue; } r -= I_G;
        if (r < I_U) { p0_transpose_item<0>(F.inp(I_UP), DM, DFF2, (bf16*)(F.ws + WS_WUP), scr, r, F.lane); continue; } r -= I_U;
        if (r < I_D) { p0_transpose_item<0>(F.inp(I_DOWN), DFF, DM, (bf16*)(F.ws + WS_WDN), scr, r, F.lane); continue; } r -= I_D;
        { const int gi = r / I_P; p0_transpose_item<0>(F.inp(I_POOLW) + (size_t)gi * 512 * 512, 512, 512, (bf16*)(F.ws + WS_WPOOL) + (size_t)gi * 512 * 512, scr, r % I_P, F.lane); }
    }
}
__device__ __forceinline__ void l1_weight_copies(Frame& F, int wi, int nw) {
    LAS unsigned* scr = (LAS unsigned*)(F.lds + F.wave * 16384);
    constexpr int I_U = (DM / 64) * (DFF2 / 64), I_D = (DFF / 64) * (DM / 64);
    for (int it = wi; it < I_U + I_D; it += nw) {
        if (it < I_U) p0_transpose_item<0>(F.inp(I_UP) + (size_t)DM * DFF2, DM, DFF2, (bf16*)(F.ws + WS_WUP) + (size_t)DFF2 * DM, scr, it, F.lane);
        else p0_transpose_item<0>(F.inp(I_DOWN) + (size_t)DFF * DM, DFF, DM, (bf16*)(F.ws + WS_WDN) + (size_t)DM * DFF, scr, it - I_U, F.lane);
    }
}

__device__ __forceinline__ void load_mod(Frame& F, int l, int v, int q, LAS float* dst) {
    const float* MODP = (const float*)(F.ws + WS_MODP); const int col = q * DM + 4 * F.tid;
    f32x4 s = *(const GAS f32x4*)(F.inp(I_ADAB) + l * NMODC + col);
#pragma unroll
    for (int sl = 0; sl < 8; ++sl) s += *(const GAS f32x4*)(MODP + ((size_t)(l * 8 + sl) * 3 + v) * NMODC + col);
    *(LAS f32x4*)(dst + 4 * F.tid) = s;
}

constexpr int STG_PITCH = 4112;
__device__ __forceinline__ void p1_rows(Frame& F) {
    LAS float* shiftL = (LAS float*)(F.lds + 98304);
    LAS float* scaleL = shiftL + 2048;
    LAS unsigned char* stg = F.lds;
    const float* g0 = F.inp(I_NORMG);
    int cur_vec = -1;
    for (int unit = F.vcu; unit < 544; unit += F.G) {
        const bool is_ctx = unit >= 512; const int b = is_ctx ? (unit - 512) >> 4 : unit >> 8, blk = is_ctx ? (unit - 512) & 15 : unit & 255;
        const int vec = is_ctx ? 2 : b;
        if (vec != cur_vec) { __syncthreads(); load_mod(F, 0, vec, 0, shiftL); load_mod(F, 0, vec, 1, scaleL); cur_vec = vec; }
        __syncthreads();
#pragma unroll 1
        for (int rr = 0; rr < 2; ++rr) { const int row = F.wave + 8 * rr, t = blk * 16 + row;
            const float* src = is_ctx ? F.inp(I_CTX) + ((size_t)(b * CTX + t)) * DM : F.inp(I_X) + ((size_t)(b * SEQ + t)) * DM;
            f32x4 v[8]; float ss = 0.f;
#pragma unroll
            for (int j = 0; j < 8; ++j) { v[j] = *(const GAS f32x4*)(src + 4 * F.lane + 256 * j); }
            if (!is_ctx) { const float prow = (float)(t >> 6), pcol = (float)(t & 63);
#pragma unroll
                for (int j = 0; j < 8; ++j) { const float pos = j < 4 ? prow : pcol; const bool is_cos = (j & 2) != 0;
#pragma unroll
                    for (int e = 0; e < 4; ++e) { const int i = (4 * F.lane + 256 * j + e) & 511;
                        const float omega = __builtin_amdgcn_exp2f(-(float)i * (13.287712379549449f / 512.0f));
                        const float rev = pos * omega * 0.15915494309189535f;
                        v[j][e] += is_cos ? __builtin_amdgcn_cosf(rev) : __builtin_amdgcn_sinf(rev); } }
                float* dst = F.out + ((size_t)(b * SEQ + t)) * DM;
#pragma unroll
                for (int j = 0; j < 8; ++j) *(GAS f32x4*)(dst + 4 * F.lane + 256 * j) = v[j]; }
#pragma unroll
            for (int j = 0; j < 8; ++j) ss += (v[j][0] * v[j][0] + v[j][1] * v[j][1]) + (v[j][2] * v[j][2] + v[j][3] * v[j][3]);
            const float rstd = 1.0f / sqrtf(wave_sum(ss) * (1.0f / DM) + RMS_EPS);
#pragma unroll
            for (int j = 0; j < 8; ++j) { const int col = 4 * F.lane + 256 * j; const f32x4 gg = *(const GAS f32x4*)(g0 + col), sc = *(LAS f32x4*)(scaleL + col), sh = *(LAS f32x4*)(shiftL + col);
                const f32x4 u = (v[j] * rstd * gg) * (sc + 1.0f) + sh;
                v2u w; w.x = pk2(u[0], u[1]); w.y = pk2(u[2], u[3]);
                *(LAS v2u*)(stg + row * STG_PITCH + col * 2) = w; } }
        __syncthreads();
        for (int q = F.tid; q < 4096; q += NTHR) { const int g = q >> 5, jh = q & 31, j = jh >> 1, h = jh & 1;
            const v4u w = *(LAS v4u*)(stg + j * STG_PITCH + g * 32 + h * 16);
            bf16* dst = is_ctx ? (bf16*)(F.ws + WS_UCG) + ((size_t)g * 32 + b * 16 + blk) * 256 + jh * 8
                               : (bf16*)(F.ws + WS_A2) + ((size_t)g * 512 + b * 256 + blk) * 512 + 256 + jh * 8;
            *(GAS v4u*)dst = w; }
    }
    __syncthreads();
}

__device__ __forceinline__ void p2_ctx_small(Frame& F, int g) {
    const bf16* A = (const bf16*)(F.ws + WS_UCG) + (size_t)g * 32 * 256; const bf16* Bt = (const bf16*)(F.ws + WS_WIN) + (size_t)g * 256 * 256;
    const int r = F.lane & 31, h = F.lane >> 5; f32x16 acc;
#pragma unroll
    for (int i = 0; i < 16; ++i) acc[i] = 0.f;
#pragma unroll 4
    for (int ks = 0; ks < 16; ++ks) { const bf16x8 a = *(const GAS bf16x8*)(A + r * 256 + ks * 16 + 8 * h), bq = *(const GAS bf16x8*)(Bt + (size_t)(32 * F.wave + r) * 256 + ks * 16 + 8 * h);
        acc = __builtin_amdgcn_mfma_f32_32x32x16_bf16(a, bq, acc, 0, 0, 0); }
    float* O = (float*)(F.ws + WS_SCLOC) + (size_t)g * 32 * 256;
#pragma unroll
    for (int i = 0; i < 16; ++i) { const int row = (i & 3) + 8 * (i >> 2) + 4 * h; O[row * 256 + 32 * F.wave + r] = acc[i]; }
}

__device__ __forceinline__ void p3_scan(Frame& F) {
    LAS float* EX = (LAS float*)(F.lds);
    for (int item = F.vcu; item < 2 * NG; item += F.G) { const int g = item >> 1, b = item & 1;
        const int p = F.lane, d = F.wave >> 2, ch = F.wave & 3;
        const float* A16 = (const float*)(F.ws + WS_A16) + ((size_t)(d * NG + g) * 64 + p) * 2; const float ar = A16[0], ai = A16[1];
        const int row0 = d == 0 ? ch * 64 : 255 - ch * 64; const long rstep = d == 0 ? 256 : -256;
        const float* SL = (const float*)(F.ws + WS_SLOC) + ((size_t)g * 512 + b * 256 + row0) * 256 + d * 128 + p;
        const float* SC = (const float*)(F.ws + WS_SCLOC) + ((size_t)g * 32 + b * 16 + (d == 0 ? 0 : 15)) * 256 + d * 128 + p;
        float cr = 0.f, ci = 0.f;
        { const float* q = SC;
#pragma unroll 8
          for (int k = 0; k < 16; ++k) { const float xr = q[0], xi = q[64]; q += rstep;
            const float nr = ar * cr - ai * ci + xr, ni = ar * ci + ai * cr + xi; cr = nr; ci = ni; } }
        float sr = 0.f, si = 0.f;
        { const float* q = SL;
#pragma unroll 8
          for (int i = 0; i < 64; ++i) { const float xr = q[0], xi = q[64]; q += rstep;
            const float nr = ar * sr - ai * si + xr, ni = ar * si + ai * sr + xi; sr = nr; si = ni; } }
        __syncthreads();
        EX[((d * 4 + ch) * 64 + p) * 2] = sr; EX[((d * 4 + ch) * 64 + p) * 2 + 1] = si;
        __syncthreads();
        float pr = ar, pi = ai;
#pragma unroll
        for (int k = 0; k < 6; ++k) { const float nr = pr * pr - pi * pi, ni = 2.f * pr * pi; pr = nr; pi = ni; }
        for (int q = 0; q < ch; ++q) { const float er = EX[((d * 4 + q) * 64 + p) * 2], ei = EX[((d * 4 + q) * 64 + p) * 2 + 1];
            const float nr = pr * cr - pi * ci + er, ni = pr * ci + pi * cr + ei; cr = nr; ci = ni; }
        bf16* OUT = (bf16*)(F.ws + WS_A2) + ((size_t)g * 512 + b * 256 + row0) * 512 + d * 128 + p;
        { const float* q = SL; const long ostep = 2 * rstep;
#pragma unroll 8
          for (int i = 0; i < 64; ++i) { const float xr = q[0], xi = q[64]; q += rstep;
            OUT[0] = (bf16)f2bf(cr); OUT[64] = (bf16)f2bf(ci); OUT += ostep;
            const float nr = ar * cr - ai * ci + xr, ni = ar * ci + ai * cr + xi; cr = nr; ci = ni; } }
    }
    __syncthreads();
}

template <bool SECOND>
__device__ __forceinline__ void row_tail(Frame& F, int row, f32x4 (&y)[8], const float* ga, const float* gb, LAS float* gateL, LAS float* shiftL, LAS float* scaleL) {
    float ss = 0.f;
#pragma unroll
    for (int j = 0; j < 8; ++j) ss += (y[j][0] * y[j][0] + y[j][1] * y[j][1]) + (y[j][2] * y[j][2] + y[j][3] * y[j][3]);
    const float ry = 1.0f / sqrtf(wave_sum(ss) * (1.0f / DM) + RMS_EPS);
    float* xrow = F.out + (size_t)row * DM; float s2 = 0.f;
#pragma unroll
    for (int j = 0; j < 8; ++j) { const int col = 4 * F.lane + 256 * j; const f32x4 x = *(const GAS f32x4*)(xrow + col), gg = *(const GAS f32x4*)(ga + col), gt = *(LAS f32x4*)(gateL + col);
        y[j] = x + gt * (y[j] * ry * gg);
        *(GAS f32x4*)(xrow + col) = y[j];
        s2 += (y[j][0] * y[j][0] + y[j][1] * y[j][1]) + (y[j][2] * y[j][2] + y[j][3] * y[j][3]); }
    if (SECOND) { const float rx = 1.0f / sqrtf(wave_sum(s2) * (1.0f / DM) + RMS_EPS); bf16* U = (bf16*)(F.ws + WS_UZ);
#pragma unroll
        for (int j = 0; j < 8; ++j) { const int col = 4 * F.lane + 256 * j; const f32x4 gg = *(const GAS f32x4*)(gb + col), sc = *(LAS f32x4*)(scaleL + col), sh = *(LAS f32x4*)(shiftL + col);
            const f32x4 u = (y[j] * rx * gg) * (sc + 1.0f) + sh; v2u w; w.x = pk2(u[0], u[1]); w.y = pk2(u[2], u[3]);
            *(GAS v2u*)(U + (size_t)row * DM + col) = w; } }
}
template <int YMODE, bool SECOND>
__device__ __forceinline__ void row_phase(Frame& F, int l_gate, int q_gate, int ga_idx, int l_mod, int q_shift, int q_scale, int gb_idx) {
    LAS float* gateL = (LAS float*)(F.lds);
    LAS float* shiftL = gateL + 2048;
    LAS float* scaleL = shiftL + 2048;
    LAS unsigned char* stg = F.lds + 32768;
    const bf16* Y = (const bf16*)(F.ws + WS_YF);
    const float* ga = F.inp(I_NORMG) + ga_idx * DM; const float* gb = F.inp(I_NORMG) + gb_idx * DM;
    int cur_b = -1;
    for (int rg = F.vcu; rg < MT / 32; rg += F.G) { const int b = rg / (SEQ / 32);
        if (b != cur_b) { __syncthreads(); load_mod(F, l_gate, b, q_gate, gateL); if (SECOND) { load_mod(F, l_mod, b, q_shift, shiftL); load_mod(F, l_mod, b, q_scale, scaleL); } cur_b = b; __syncthreads(); }
        if (YMODE == 0) {
#pragma unroll 1
            for (int rr = 0; rr < 4; ++rr) { const int row = rg * 32 + F.wave * 4 + rr;
                f32x4 y[8];
#pragma unroll
                for (int j = 0; j < 8; ++j) { const v2u w = *(const GAS v2u*)(Y + (size_t)row * DM + 4 * F.lane + 256 * j); y[j] = (f32x4){bf_lo(w.x), bf_hi(w.x), bf_lo(w.y), bf_hi(w.y)}; }
                row_tail<SECOND>(F, row, y, ga, gb, gateL, shiftL, scaleL); }
        } else {
#pragma unroll 1
            for (int half = 0; half < 2; ++half) { const int r0 = rg * 32 + half * 16, t0 = r0 & (SEQ - 1);
                __syncthreads();
                {
                    const int hw = 1 << (F.wave >> 1); const bf16* Yb = Y + (size_t)(r0 - t0) * DM + 4 * F.tid;
                    const f32x4 ps = *(const GAS f32x4*)(F.inp(I_POOLS) + 4 * F.tid);
#define LDV(trow) ({ const int _t = (trow); const bool _ok = _t >= 0 && _t < SEQ; const v2u _w = *(const GAS v2u*)(Yb + (size_t)(_ok ? _t : t0) * DM); const float _m = _ok ? 1.0f : 0.0f; \
                      (f32x4){bf_lo(_w.x) * _m, bf_hi(_w.x) * _m, bf_lo(_w.y) * _m, bf_hi(_w.y) * _m}; })
                    f32x4 s = {0.f, 0.f, 0.f, 0.f};
#pragma unroll 2
                    for (int o = -hw; o < hw; ++o) s += LDV(t0 + o);
#pragma unroll 4
                    for (int i = 0; i < 16; ++i) { const int t = t0 + i; const f32x4 self = LDV(t);
                        const int lo = t - hw < 0 ? 0 : t - hw, hi = t + hw - 1 > SEQ - 1 ? SEQ - 1 : t + hw - 1;
                        const f32x4 yv = (s * (1.0f / (float)(hi - lo + 1)) - self) * ps;
                        v2u w; w.x = pk2(yv[0], yv[1]); w.y = pk2(yv[2], yv[3]);
                        *(LAS v2u*)(stg + i * STG_PITCH + 8 * F.tid) = w;
                        s += LDV(t + hw) - LDV(t - hw); }
#undef LDV
                }
                __syncthreads();
#pragma unroll 1
                for (int rr = 0; rr < 2; ++rr) { const int lr = F.wave * 2 + rr, row = r0 + lr;
                    f32x4 y[8];
#pragma unroll
                    for (int j = 0; j < 8; ++j) { const v2u w = *(LAS v2u*)(stg + lr * STG_PITCH + 8 * F.lane + 512 * j); y[j] = (f32x4){bf_lo(w.x), bf_hi(w.x), bf_lo(w.y), bf_hi(w.y)}; }
                    row_tail<SECOND>(F, row, y, ga, gb, gateL, shiftL, scaleL); }
            }
        }
    }
    __syncthreads();
}

__device__ __forceinline__ void conv_phase(Frame& F, int l) {
    const bf16* H = (const bf16*)(F.ws + WS_H); bf16* ACT = (bf16*)(F.ws + WS_ACT);
    const float* cw = F.inp(I_CONV) + (size_t)l * 3 * DFF2; const float* cb = F.inp(I_CONVB) + (size_t)l * DFF2;
    const int gw = F.vcu * NWAVES + F.wave, NGW = F.G * NWAVES;
    for (int wi = gw; wi < (MT / 16) * 11; wi += NGW) { const int rb = wi / 11, cbk = wi % 11, f0 = (cbk * 64 + F.lane) * 8, t0 = rb * 16;
        float kv[3][8], kg[3][8], bv[8], bg[8];
#pragma unroll
        for (int tp = 0; tp < 3; ++tp) { const f32x4 a = *(const GAS f32x4*)(cw + tp * DFF2 + f0), b2 = *(const GAS f32x4*)(cw + tp * DFF2 + f0 + 4), c = *(const GAS f32x4*)(cw + tp * DFF2 + DFF + f0), d = *(const GAS f32x4*)(cw + tp * DFF2 + DFF + f0 + 4);
#pragma unroll
            for (int e = 0; e < 4; ++e) { kv[tp][e] = a[e]; kv[tp][4 + e] = b2[e]; kg[tp][e] = c[e]; kg[tp][4 + e] = d[e]; } }
        { const f32x4 a = *(const GAS f32x4*)(cb + f0), b2 = *(const GAS f32x4*)(cb + f0 + 4), c = *(const GAS f32x4*)(cb + DFF + f0), d = *(const GAS f32x4*)(cb + DFF + f0 + 4);
#pragma unroll
            for (int e = 0; e < 4; ++e) { bv[e] = a[e]; bv[4 + e] = b2[e]; bg[e] = c[e]; bg[4 + e] = d[e]; } }
        float pv[8], pg[8], cv[8], cg[8], nv[8], ng[8];
        const bool has_prev = (t0 & (SEQ - 1)) != 0, has_next = ((t0 + 16) & (SEQ - 1)) != 0;
#define LD8(dstv, dstg, trow) do { const v4u _a = *(const GAS v4u*)(H + (size_t)(trow) * DFF2 + f0), _b = *(const GAS v4u*)(H + (size_t)(trow) * DFF2 + DFF + f0); \
            dstv[0] = bf_lo(_a.x); dstv[1] = bf_hi(_a.x); dstv[2] = bf_lo(_a.y); dstv[3] = bf_hi(_a.y); dstv[4] = bf_lo(_a.z); dstv[5] = bf_hi(_a.z); dstv[6] = bf_lo(_a.w); dstv[7] = bf_hi(_a.w); \
            dstg[0] = bf_lo(_b.x); dstg[1] = bf_hi(_b.x); dstg[2] = bf_lo(_b.y); dstg[3] = bf_hi(_b.y); dstg[4] = bf_lo(_b.z); dstg[5] = bf_hi(_b.z); dstg[6] = bf_lo(_b.w); dstg[7] = bf_hi(_b.w); } while (0)
        if (has_prev) LD8(pv, pg, t0 - 1); else {
#pragma unroll
            for (int e = 0; e < 8; ++e) { pv[e] = 0.f; pg[e] = 0.f; } }
        LD8(cv, cg, t0);
#pragma unroll
        for (int i = 0; i < 16; ++i) {
            if (i < 15 || has_next) LD8(nv, ng, t0 + i + 1); else {
#pragma unroll
                for (int e = 0; e < 8; ++e) { nv[e] = 0.f; ng[e] = 0.f; } }
            float o[8];
#pragma unroll
            for (int e = 0; e < 8; ++e) { const float vv = kv[0][e] * pv[e] + kv[1][e] * cv[e] + kv[2][e] * nv[e] + bv[e], gg = kg[0][e] * pg[e] + kg[1][e] * cg[e] + kg[2][e] * ng[e] + bg[e];
                o[e] = gg * sigm(gg) * vv; }
            v4u w; w.x = pk2(o[0], o[1]); w.y = pk2(o[2], o[3]); w.z = pk2(o[4], o[5]); w.w = pk2(o[6], o[7]);
            *(GAS v4u*)(ACT + (size_t)(t0 + i) * DFF + f0) = w;
#pragma unroll
            for (int e = 0; e < 8; ++e) { pv[e] = cv[e]; pg[e] = cg[e]; cv[e] = nv[e]; cg[e] = ng[e]; }
        }
#undef LD8
    }
}

__global__ void __launch_bounds__(NTHR, 2) fwd_kernel(Args args) {
    extern __shared__ __attribute__((aligned(16))) unsigned char lds[];
    Frame F;
    F.lds = (LAS unsigned char*)lds;
    F.tid = threadIdx.x; F.lane = F.tid & 63; F.wave = __builtin_amdgcn_readfirstlane(F.tid >> 6);
    F.G = gridDim.x; { const int bx = blockIdx.x; F.vcu = (F.G % 8 == 0) ? (bx % 8) * (F.G / 8) + bx / 8 : bx; }
    F.out = args.out; F.ws = args.ws;
    volatile LAS unsigned* MISC = (volatile LAS unsigned*)(F.lds + MISC_OFF);
    for (int u = F.tid; u < (LDS_BYTES - LDSCTL_OFF) / 4; u += NTHR) ((LAS unsigned*)(F.lds + LDSCTL_OFF))[u] = 0u;
    __syncthreads();
    if (F.tid < 22) *(const float* LAS*)(F.lds + PTR_OFF + 8 * F.tid) = args.in[F.tid];
    __syncthreads();
    const bool one_launch = (args.ph_hi - args.ph_lo) > 1;
    XcdBarrier bar; bar.bar = (unsigned*)(F.ws + WS_CTL) + CW_BAR; bar.x = 0; bar.st = nullptr;
    if (one_launch) bar = xcd_barrier_post((unsigned*)(F.ws + WS_CTL) + CW_BAR, MISC + 8);
    const int lo = args.ph_lo, hi = args.ph_hi;
#ifndef PH_MASK
#define PH_MASK 0x1ffff
#endif
#ifndef REP_MASK
#define REP_MASK 0
#endif
#define IN(k) ((((PH_MASK) >> (k)) & 1) && lo <= (k) && (k) < hi)
#define REPF(k) (1 + (((REP_MASK) >> (k)) & 1))
#define REPS(k) for (int _rep = 0; _rep < 1 + (((REP_MASK) >> (k)) & 1); ++_rep, (_rep < 1 + (((REP_MASK) >> (k)) & 1) ? (xcd_barrier(bar), 0) : 0))
#define FENCE() do { asm volatile("" : "+v"(F.tid)); F.lane = F.tid & 63; { int _w = F.tid >> 6; asm volatile("" : "+v"(_w)); F.wave = __builtin_amdgcn_readfirstlane(_w); } \
        asm volatile("" : "+s"(F.vcu), "+s"(F.G), "+s"(F.ws), "+s"(F.out), "+s"(F.lds)); ring = F.lds + RING_OFF; } while (0)
#ifndef BAR_REP
#define BAR_REP 1
#endif
#define SEAM(k) do { if (IN(k) && IN((k) + 1)) { for (int _b = 0; _b < BAR_REP; ++_b) xcd_barrier(bar); } FENCE(); } while (0)
    LAS unsigned char* ring = F.lds + RING_OFF;
    FENCE();

    if (IN(0)) REPS(0) { p0_prologue(F); } SEAM(0);
    if (IN(1)) REPS(1) { p1_rows(F); } SEAM(1);
    if (IN(2)) {
        for (int g = F.vcu; g < NG; g += F.G) p2_ctx_small(F, g);
        VM_WAIT(); __syncthreads();
        pg8::Gemm g{(const pg8::bf16_t*)(F.ws + WS_A2) + 256, (const pg8::bf16_t*)(F.ws + WS_WIN), 512, 256, 256, (size_t)512 * 512, (size_t)256 * 256};
        pg8::GroupedOrder S; S.init(NG, 2, 1, F.G, F.vcu, REPF(2));
        pg8::EpiF32G E{(float*)(F.ws + WS_SLOC), 256, (size_t)512 * 256};
        pg8::gemm_phase<pg8::EpiF32G, pg8::GroupedOrder, true, true>(ring, g, S, E, F.tid);
    } SEAM(2);
    if (IN(3)) REPS(3) { p3_scan(F); } SEAM(3);
    if (IN(4)) {
        pg8::Gemm g{(const pg8::bf16_t*)(F.ws + WS_A2), (const pg8::bf16_t*)(F.ws + WS_W2), 512, 512, 512, (size_t)512 * 512, (size_t)256 * 512};
        pg8::GroupedOrder S; S.init(NG, 2, 1, F.G, F.vcu, REPF(4));
        pg8::EpiGeluZ E{(pg8::bf16_t*)(F.ws + WS_UZ)};
        pg8::gemm_phase<pg8::EpiGeluZ, pg8::GroupedOrder, true, true>(ring, g, S, E, F.tid);
    } SEAM(4);
    if (IN(5)) {
        pg8::Gemm g{(const pg8::bf16_t*)(F.ws + WS_UZ), (const pg8::bf16_t*)(F.ws + WS_WGLU), DM, DM, DM, 0, 0};
        pg8::StaticOrder S; S.init(MT, 2 * DM, F.G, (int)blockIdx.x, REPF(5));
        pg8::EpiGlu E{(pg8::bf16_t*)(F.ws + WS_YF), DM};
        pg8::gemm_phase<pg8::EpiGlu, pg8::StaticOrder, true, true>(ring, g, S, E, F.tid);
    } SEAM(5);
    if (IN(6)) { row_phase<0, true>(F, 0, 2, 1, 0, 3, 4, 2); } SEAM(6);
    for (int l = 0; l < 2; ++l) {
        const int pb = l == 0 ? 7 : 13;
        if (IN(pb)) {
            pg8::Gemm g{(const pg8::bf16_t*)(F.ws + WS_UZ), (const pg8::bf16_t*)(F.ws + WS_WUP) + (size_t)l * DFF2 * DM, DM, DM, DM, 0, 0};
            pg8::StaticOrder S; S.init(MT, DFF2, F.G, (int)blockIdx.x, REPF(pb));
            pg8::EpiBf16G E{(pg8::bf16_t*)(F.ws + WS_H), DFF2, 0};
            pg8::gemm_phase<pg8::EpiBf16G, pg8::StaticOrder, true, true>(ring, g, S, E, F.tid);
            if (l == 0) {
                const int nwg = (MT / 256) * (DFF2 / 256), rem = nwg % F.G, bx = (int)blockIdx.x;
                if (rem == 0) l1_weight_copies(F, bx * NWAVES + F.wave, F.G * NWAVES);
                else if (bx >= rem) l1_weight_copies(F, (bx - rem) * NWAVES + F.wave, (F.G - rem) * NWAVES);
            }
        } SEAM(pb);
        if (IN(pb + 1)) REPS(pb + 1) { conv_phase(F, l); } SEAM(pb + 1);
        if (IN(pb + 2)) {
            pg8::Gemm g{(const pg8::bf16_t*)(F.ws + WS_ACT), (const pg8::bf16_t*)(F.ws + WS_WDN) + (size_t)l * DM * DFF, DFF, DFF, DFF, 0, 0};
            pg8::StaticOrder S; S.init(MT, DM, F.G, (int)blockIdx.x, REPF(pb + 2));
            pg8::EpiBf16G E{(pg8::bf16_t*)(F.ws + WS_YF), DM, 0};
            pg8::gemm_phase<pg8::EpiBf16G, pg8::StaticOrder, true, true>(ring, g, S, E, F.tid);
        } SEAM(pb + 2);
        if (l == 0) {
            if (IN(10)) { row_phase<0, true>(F, 0, 5, 3, 1, 0, 1, 4); } SEAM(10);
            if (IN(11)) {
                pg8::Gemm g{(const pg8::bf16_t*)(F.ws + WS_UZ), (const pg8::bf16_t*)(F.ws + WS_WPOOL), DM, 512, 512, (size_t)512, (size_t)512 * 512};
                pg8::GroupedOrder S; S.init(4, MT / 256, 2, F.G, F.vcu, REPF(11));
                pg8::EpiBf16G E{(pg8::bf16_t*)(F.ws + WS_YF), DM, (size_t)512};
                pg8::gemm_phase<pg8::EpiBf16G, pg8::GroupedOrder, true, true>(ring, g, S, E, F.tid);
            } SEAM(11);
            if (IN(12)) { row_phase<1, true>(F, 1, 2, 5, 1, 3, 4, 6); } SEAM(12);
        } else {
            if (IN(16)) { row_phase<0, false>(F, 1, 5, 7, 0, 0, 0, 0); }
        }
    }
#undef IN
#undef SEAM
}

extern "C" void kernel_launch(void* const* d_in, const int* in_sizes, int n_in, void* d_out, int out_size, void* d_ws, size_t ws_size, hipStream_t stream) {
    static int grid = 0;
    if (grid == 0) {
        if (n_in != 22 || out_size != MT * DM || ws_size < WS_END) { fprintf(stderr, "kernel_launch: unexpected problem (n_in %d, out %d, ws %zu); nothing launched\n", n_in, out_size, ws_size); grid = -1; return; }
        int dev = 0, cus = 0, per_cu = 0;
        if (hipGetDevice(&dev) != hipSuccess || hipDeviceGetAttribute(&cus, hipDeviceAttributeMultiprocessorCount, dev) != hipSuccess) { grid = -1; return; }
        if (hipFuncSetAttribute((const void*)fwd_kernel, hipFuncAttributeMaxDynamicSharedMemorySize, LDS_BYTES) != hipSuccess) { fprintf(stderr, "kernel_launch: hipFuncSetAttribute failed\n"); grid = -1; return; }
        if (hipOccupancyMaxActiveBlocksPerMultiprocessor(&per_cu, (const void*)fwd_kernel, NTHR, LDS_BYTES) != hipSuccess || per_cu < 1) { fprintf(stderr, "kernel_launch: occupancy query reports %d blocks per CU\n", per_cu); per_cu = 1; }
        (void)hipGetLastError();
        grid = cus;
    }
    if (grid < 0) return;
    if (hipMemsetAsync((char*)d_ws + WS_CTL, 0, CTL_ZERO_BYTES, stream) != hipSuccess) { fprintf(stderr, "kernel_launch: hipMemsetAsync failed\n"); return; }
    Args a{};
    for (int i = 0; i < 22; ++i) a.in[i] = (const float*)d_in[i];
    a.out = (float*)d_out; a.ws = (unsigned char*)d_ws;
#if MK_N_LAUNCHES == 1
    a.ph_lo = 0; a.ph_hi = NPHASE; a.li = 0;
    hipLaunchKernelGGL(fwd_kernel, dim3(grid), dim3(NTHR), LDS_BYTES, stream, a);
#else
    for (int p = 0; p < NPHASE; ++p) { a.ph_lo = p; a.ph_hi = p + 1; a.li = p; hipLaunchKernelGGL(fwd_kernel, dim3(grid), dim3(NTHR), LDS_BYTES, stream, a); }
#endif
    const hipError_t le = hipPeekAtLastError();
    if (le != hipSuccess) fprintf(stderr, "kernel_launch: launch failed: %s\n", hipGetErrorName(le));
}
```

```cpp
#include <hip/hip_runtime.h>
#include <cstdio>
#include <cstdint>

#ifndef MK_N_LAUNCHES
#define MK_N_LAUNCHES 1
#endif

namespace pg8 {
#define PG8_LAS __attribute__((address_space(3)))
typedef unsigned short bf16_t;
typedef short bf16x8 __attribute__((ext_vector_type(8)));
typedef float f32x4 __attribute__((ext_vector_type(4)));
typedef float f32x16 __attribute__((ext_vector_type(16)));
typedef unsigned u32x4 __attribute__((ext_vector_type(4)));
typedef unsigned u32x2 __attribute__((ext_vector_type(2)));
typedef int i32x4 __attribute__((ext_vector_type(4)));
template <bool I8> struct AccT { typedef f32x4 T; };
template <> struct AccT<true> { typedef i32x4 T; };
constexpr int BM = 256, BK = 64, HALF = 128, HTB = HALF * BK * 2  , STAGE_BYTES = 8 * HTB, NXCD = 8, WGM = 8;

__host__ __device__ __forceinline__ int lds_byte(int r, int c) { const int st = (r >> 4) * 2 + (c >> 5), rr = r & 15, cc = c & 31, ob = rr * 64 + cc * 2; return st * 1024 + (ob ^ (((ob >> 9) & 1) << 5)); }
__host__ __device__ __forceinline__ void stage_rc(int b, int& R, int& C) { const int st = b / 1024, sb = b % 1024, swz = sb ^ (((sb >> 9) & 1) << 5); R = (st >> 1) * 16 + swz / 64; C = (st & 1) * 32 + (swz % 64) / 2; }
__host__ __device__ __forceinline__ int perm32(int rho) { const int n = rho >> 4, i = rho & 15; return 8 * (i >> 2) + 4 * n + (i & 3); }

struct Unit { int pm, pn, g; };
struct Gemm { const bf16_t* A; const bf16_t* Bt; int lda, ldb, K; size_t gsA, gsB; };

struct StaticOrder {
    int nM, nN, nwg, G, c, pm0, nx;
    __device__ __forceinline__ void init(int M, int N, int G_, int c_, int pm0_, int nx_) { nM = M / BM; nN = N / BM; nwg = nM * nN; G = G_; c = c_; pm0 = pm0_; nx = nx_; }
    __device__ __forceinline__ bool next(int i, Unit& u) const {
        const long L = (long)i * G + c; if (L >= (long)nwg) return false;
        int wgid = (int)L; { const int q = nwg / nx, r = nwg % nx, xcd = wgid % nx, off = wgid / nx; wgid = (xcd < r ? xcd * (q + 1) : r * (q + 1) + (xcd - r) * q) + off; }
        const int nig = WGM * nN, gid = wgid / nig, fm = gid * WGM, gsz = (nM - fm) < WGM ? (nM - fm) : WGM;
        u.pm = pm0 + fm + ((wgid % nig) % gsz); u.pn = (wgid % nig) / gsz; u.g = 0; return true;
    }
};
struct GroupedOrder {
    int nG, nM, nN, G, c, pm0;
    __device__ __forceinline__ void init(int nG_, int nM_, int nN_, int G_, int c_, int pm0_) { nG = nG_; nM = nM_; nN = nN_; G = G_; c = c_; pm0 = pm0_; }
    __device__ __forceinline__ bool next(int i, Unit& u) const {
        const long L = (long)i * G + c; if (L >= (long)nG * nM * nN) return false;
        const int per = nM * nN, r = (int)(L % per); u.g = (int)(L / per); u.pn = r / nM; u.pm = pm0 + r % nM; return true;
    }
};

__device__ __forceinline__ unsigned cvt_pk_bf16(float lo, float hi) { unsigned r; asm volatile("v_cvt_pk_bf16_f32 %0, %1, %2" : "=v"(r) : "v"(lo), "v"(hi)); return r; }
__device__ __forceinline__ float sigmoidf_fast(float x) { return __builtin_amdgcn_rcpf(1.0f + __builtin_amdgcn_exp2f(-1.44269504089f * x)); }
__device__ __forceinline__ float gelu_tanh(float y) { const float z = 0.7978845608f * (y + 0.044715f * y * y * y); return y * sigmoidf_fast(2.0f * z); }

struct EpiF32G {
    static constexpr bool PERM = false, AFTER_DRAIN = false, I8 = false;
    float* C; int ldc; size_t gsC;
    __device__ __forceinline__ void operator()(const f32x4 (&acc)[2][2][4][2], const Unit& u, int wr, int wc, int fr, int fq) const {
        const int row0 = u.pm * BM + wr * 64 + fr, col0 = u.pn * BM + wc * 32 + 4 * fq; float* rowp = C + (size_t)u.g * gsC + (size_t)row0 * ldc + col0;
#pragma unroll
        for (int ai = 0; ai < 2; ++ai) {
#pragma unroll
            for (int m = 0; m < 4; ++m) {
#pragma unroll
                for (int bj = 0; bj < 2; ++bj)
#pragma unroll
                    for (int n = 0; n < 2; ++n) *(f32x4*)(rowp + bj * HALF + n * 16) = acc[ai][bj][m][n];
                asm volatile("" : "+v"(rowp)); rowp += (size_t)16 * ldc; }
            rowp += (size_t)64 * ldc; }
    }
};
struct EpiBf16G {
    static constexpr bool PERM = true, AFTER_DRAIN = false, I8 = false;
    bf16_t* O; int ldc; size_t gsO;
    __device__ __forceinline__ void operator()(const f32x4 (&acc)[2][2][4][2], const Unit& u, int wr, int wc, int fr, int fq) const {
        const int row0 = u.pm * BM + wr * 64 + fr, col0 = u.pn * BM + wc * 32 + 8 * fq; bf16_t* rowp = O + (size_t)u.g * gsO + (size_t)row0 * ldc + col0;
#pragma unroll
        for (int ai = 0; ai < 2; ++ai) {
#pragma unroll
            for (int m = 0; m < 4; ++m) {
#pragma unroll
                for (int bj = 0; bj < 2; ++bj) { const f32x4 v0 = acc[ai][bj][m][0], v1 = acc[ai][bj][m][1];
                    u32x4 w; w.x = cvt_pk_bf16(v0[0], v0[1]); w.y = cvt_pk_bf16(v0[2], v0[3]); w.z = cvt_pk_bf16(v1[0], v1[1]); w.w = cvt_pk_bf16(v1[2], v1[3]);
                    *(u32x4*)(rowp + bj * HALF) = w; }
                asm volatile("" : "+v"(rowp)); rowp += (size_t)16 * ldc; }
            rowp += (size_t)64 * ldc; }
    }
};
struct EpiGeluZ {
    static constexpr bool PERM = true, AFTER_DRAIN = false, I8 = false;
    bf16_t* Z;
    __device__ __forceinline__ void operator()(const f32x4 (&acc)[2][2][4][2], const Unit& u, int wr, int wc, int fr, int fq) const {
        bf16_t* rowp = Z + ((size_t)(u.pm * 4096 + (wr * 64 + fr) * 16 + 2 * wc + (fq >> 1))) * 2048 + u.g * 16 + 8 * (fq & 1);
#pragma unroll
        for (int ai = 0; ai < 2; ++ai) {
#pragma unroll
            for (int m = 0; m < 4; ++m) {
#pragma unroll
                for (int bj = 0; bj < 2; ++bj) {
                    const f32x4 v0 = acc[ai][bj][m][0], v1 = acc[ai][bj][m][1];
                    u32x4 w; w.x = cvt_pk_bf16(gelu_tanh(v0[0]), gelu_tanh(v0[1])); w.y = cvt_pk_bf16(gelu_tanh(v0[2]), gelu_tanh(v0[3]));
                    w.z = cvt_pk_bf16(gelu_tanh(v1[0]), gelu_tanh(v1[1])); w.w = cvt_pk_bf16(gelu_tanh(v1[2]), gelu_tanh(v1[3]));
                    *(u32x4*)(rowp + (size_t)bj * 8 * 2048) = w; }
                asm volatile("" : "+v"(rowp)); rowp += (size_t)16 * 16 * 2048; }
            rowp += (size_t)64 * 16 * 2048; }
    }
};
struct EpiGlu {
    static constexpr bool PERM = true, AFTER_DRAIN = false, I8 = false;
    bf16_t* O; int ldc;
    __device__ __forceinline__ void operator()(const f32x4 (&acc)[2][2][4][2], const Unit& u, int wr, int wc, int fr, int fq) const {
        const int row0 = u.pm * BM + wr * 64 + fr, col0 = u.pn * HALF + wc * 32 + 8 * fq; bf16_t* rowp = O + (size_t)row0 * ldc + col0;
#pragma unroll
        for (int ai = 0; ai < 2; ++ai) {
#pragma unroll
            for (int m = 0; m < 4; ++m) {
                const f32x4 v0 = acc[ai][0][m][0], v1 = acc[ai][0][m][1], g0 = acc[ai][1][m][0], g1 = acc[ai][1][m][1];
                u32x4 w; w.x = cvt_pk_bf16(v0[0] * sigmoidf_fast(g0[0]), v0[1] * sigmoidf_fast(g0[1])); w.y = cvt_pk_bf16(v0[2] * sigmoidf_fast(g0[2]), v0[3] * sigmoidf_fast(g0[3]));
                w.z = cvt_pk_bf16(v1[0] * sigmoidf_fast(g1[0]), v1[1] * sigmoidf_fast(g1[1])); w.w = cvt_pk_bf16(v1[2] * sigmoidf_fast(g1[2]), v1[3] * sigmoidf_fast(g1[3]));
                *(u32x4*)rowp = w;
                asm volatile("" : "+v"(rowp)); rowp += (size_t)16 * ldc; }
            rowp += (size_t)64 * ldc; }
    }
};

__device__ __forceinline__ float dpp_shr1(float old, float src) { return __builtin_bit_cast(float, __builtin_amdgcn_update_dpp(__builtin_bit_cast(int, old), __builtin_bit_cast(int, src), 0x111, 0xF, 0xF, false)); }
__device__ __forceinline__ float dpp_shl1(float old, float src) { return __builtin_bit_cast(float, __builtin_amdgcn_update_dpp(__builtin_bit_cast(int, old), __builtin_bit_cast(int, src), 0x101, 0xF, 0xF, false)); }
__device__ __forceinline__ float dpp_ror1(float src) { return __builtin_bit_cast(float, __builtin_amdgcn_update_dpp(0, __builtin_bit_cast(int, src), 0x121, 0xF, 0xF, false)); }
__device__ __forceinline__ float dpp_ror15(float src) { return __builtin_bit_cast(float, __builtin_amdgcn_update_dpp(0, __builtin_bit_cast(int, src), 0x12F, 0xF, 0xF, false)); }
struct EpiConvGlu {
    static constexpr bool PERM = true, AFTER_DRAIN = false, I8 = true;
    bf16_t* ACT; const float* cw; const float* cb; float* PRE; float* RAW; PG8_LAS float* xch; const float* su; const float* sw;
    __device__ __forceinline__ void operator()(const i32x4 (&acci)[2][2][4][2], const Unit& u, int wr, int wc, int fr_in, int fq_in) const {
        constexpr int DF = 5632;
        int fr = fr_in, fq = fq_in; asm volatile("" : "+v"(fr), "+v"(fq));
        f32x4 acc[2][2][4][2];
#pragma unroll
        for (int ai = 0; ai < 2; ++ai)
#pragma unroll
            for (int m = 0; m < 4; ++m) { const float rs = su[u.pm * BM + ai * HALF + wr * 64 + m * 16 + fr];
#pragma unroll
                for (int bj = 0; bj < 2; ++bj)
#pragma unroll
                    for (int n = 0; n < 2; ++n) { const i32x4 q = acci[ai][bj][m][n]; acc[ai][bj][m][n] = (f32x4){(float)q[0], (float)q[1], (float)q[2], (float)q[3]} * rs; } }
        const int f0 = u.pn * HALF + wc * 32 + 8 * fq;
        PG8_LAS float* coef = xch + 2048;
        { int tid = (wr * 4 + wc) * 64 + fq * 16 + fr; asm volatile("" : "+v"(tid));
          if (tid < 256) { const int which = tid >> 5, ch = tid & 31, t = which & 3; const float* src = (t < 3 ? cw + t * (2 * DF) : cb) + (which >> 2) * DF + u.pn * HALF + 4 * ch;
              f32x4 cv4 = *(const f32x4*)src; if (t < 3) cv4 = cv4 * *(const f32x4*)(sw + u.pn * BM + (which >> 2) * HALF + 4 * ch);
              *(PG8_LAS f32x4*)(coef + which * 128 + 4 * ch) = cv4; }
          else if (tid < 320) { const int h = (tid - 256) >> 5, ch = tid & 31; *(PG8_LAS f32x4*)(coef + 1024 + h * 128 + 4 * ch) = *(const f32x4*)(sw + u.pn * BM + h * HALF + 4 * ch); } }
#pragma unroll
        for (int ai = 0; ai < 2; ++ai) { const int s = 2 * ai + wr;
            if (fr == 0) { PG8_LAS f32x4* q = (PG8_LAS f32x4*)(xch + ((((s * 2 + 0) * 4 + wc) * 4 + fq) * 2) * 8); q[0] = acc[ai][0][0][0]; q[1] = acc[ai][0][0][1]; q[2] = acc[ai][1][0][0]; q[3] = acc[ai][1][0][1]; }
            if (fr == 15) { PG8_LAS f32x4* q = (PG8_LAS f32x4*)(xch + ((((s * 2 + 1) * 4 + wc) * 4 + fq) * 2) * 8); q[0] = acc[ai][0][3][0]; q[1] = acc[ai][0][3][1]; q[2] = acc[ai][1][3][0]; q[3] = acc[ai][1][3][1]; } }
        asm volatile("s_waitcnt lgkmcnt(0)" ::: "memory"); __builtin_amdgcn_s_barrier(); asm volatile("" ::: "memory");
        bf16_t* rowp0 = ACT + (size_t)(u.pm * BM + wr * 64 + fr) * DF + f0;
#define FMAC_DPP(t, src, k, ctrl) asm("v_fmac_f32_dpp %0, %1, %2 " ctrl " row_mask:0xf bank_mask:0xf" : "+v"(t) : "v"(src), "v"(k))
#pragma unroll
        for (int n = 0; n < 2; ++n) {
            asm volatile("" ::: "memory");
            const int cc = wc * 32 + 8 * fq + 4 * n;
            const f32x4 kv0 = *(const PG8_LAS f32x4*)(coef + cc), kv1 = *(const PG8_LAS f32x4*)(coef + 128 + cc), kv2 = *(const PG8_LAS f32x4*)(coef + 256 + cc), bv = *(const PG8_LAS f32x4*)(coef + 384 + cc);
            const f32x4 kg0 = *(const PG8_LAS f32x4*)(coef + 512 + cc), kg1 = *(const PG8_LAS f32x4*)(coef + 640 + cc), kg2 = *(const PG8_LAS f32x4*)(coef + 768 + cc), bg = *(const PG8_LAS f32x4*)(coef + 896 + cc);
            const float m0 = fr == 0 ? 1.0f : 0.0f, m15 = fr == 15 ? 1.0f : 0.0f;
            bf16_t* rowp = rowp0;
#pragma unroll
            for (int ai = 0; ai < 2; ++ai) { const int s = 2 * ai + wr;
#pragma unroll
                for (int m = 0; m < 4; ++m) {
                    const f32x4 cv = acc[ai][0][m][n], cg = acc[ai][1][m][n];
                    f32x4 vv = kv1 * cv + bv, gg = kg1 * cg + bg;
                    float m0l = m0, m15l = m15; asm volatile("" : "+v"(m0l), "+v"(m15l));
                    const f32x4 kv0e = kv0 * m0l, kg0e = kg0 * m0l, kv2e = kv2 * m15l, kg2e = kg2 * m15l;
                    f32x4 hpv = {0.f, 0.f, 0.f, 0.f}, hpg = hpv, hnv = hpv, hng = hpv;
                    if (m == 0 && s > 0) { const PG8_LAS f32x4* q = (const PG8_LAS f32x4*)(xch + (((((s - 1) * 2 + 1) * 4 + wc) * 4 + fq) * 2) * 8); hpv = q[n]; hpg = q[2 + n]; }
                    if (m == 3 && s < 3) { const PG8_LAS f32x4* q = (const PG8_LAS f32x4*)(xch + (((((s + 1) * 2 + 0) * 4 + wc) * 4 + fq) * 2) * 8); hnv = q[n]; hng = q[2 + n]; }
#pragma unroll
                    for (int e = 0; e < 4; ++e) {
                        FMAC_DPP(vv[e], cv[e], kv0[e], "row_shr:1"); FMAC_DPP(vv[e], cv[e], kv2[e], "row_shl:1");
                        FMAC_DPP(gg[e], cg[e], kg0[e], "row_shr:1"); FMAC_DPP(gg[e], cg[e], kg2[e], "row_shl:1");
                        if (m > 0) { FMAC_DPP(vv[e], acc[ai][0][m == 0 ? 0 : m - 1][n][e], kv0e[e], "row_ror:1"); FMAC_DPP(gg[e], acc[ai][1][m == 0 ? 0 : m - 1][n][e], kg0e[e], "row_ror:1"); }
                        else { vv[e] += hpv[e] * kv0e[e]; gg[e] += hpg[e] * kg0e[e]; }
                        if (m < 3) { FMAC_DPP(vv[e], acc[ai][0][m == 3 ? 3 : m + 1][n][e], kv2e[e], "row_ror:15"); FMAC_DPP(gg[e], acc[ai][1][m == 3 ? 3 : m + 1][n][e], kg2e[e], "row_ror:15"); }
                        else { vv[e] += hnv[e] * kv2e[e]; gg[e] += hng[e] * kg2e[e]; }
                    }
                    if ((s == 0 && m == 0 && fr == 0) || (s == 3 && m == 3 && fr == 15)) {
                        const size_t eo = ((size_t)(u.pm * 2 + (s == 0 ? 0 : 1)) * 2) * DF + f0 + 4 * n;
                        *(f32x4*)(PRE + eo) = vv; *(f32x4*)(PRE + eo + DF) = gg;
                        *(f32x4*)(RAW + eo) = cv * *(const PG8_LAS f32x4*)(coef + 1024 + cc); *(f32x4*)(RAW + eo + DF) = cg * *(const PG8_LAS f32x4*)(coef + 1152 + cc); }
                    u32x2 w; w.x = cvt_pk_bf16(gg[0] * sigmoidf_fast(gg[0]) * vv[0], gg[1] * sigmoidf_fast(gg[1]) * vv[1]); w.y = cvt_pk_bf16(gg[2] * sigmoidf_fast(gg[2]) * vv[2], gg[3] * sigmoidf_fast(gg[3]) * vv[3]);
                    *(u32x2*)(rowp + 4 * n) = w; asm volatile("" : "+v"(rowp)); rowp += (size_t)16 * DF;
                }
                rowp += (size_t)64 * DF;
            }
        }
#undef FMAC_DPP
    }
};


struct OneUnit { Unit u; __device__ bool next(int i, Unit& o) const { if (i != 0) return false; o = u; return true; } };
struct EpiScan {
    static constexpr bool PERM = false, AFTER_DRAIN = true, I8 = false;
    const float* A16; bf16_t* A2; PG8_LAS float* xc;
    __device__ __forceinline__ void operator()(const f32x4 (&)[2][2][4][2], const Unit&, int, int, int, int) const {}
    __device__ __forceinline__ void fused(const f32x4 (&acc)[2][2][4][2], const Unit& u, int wr, int wc, int fr, int fq, PG8_LAS unsigned char* lds, int wid, int lane) const {
        PG8_LAS float* SL = (PG8_LAS float*)lds; const int p = lane, ch = wid;
#pragma unroll
        for (int d = 0; d < 2; ++d) {
#pragma unroll
            for (int ai = 0; ai < 2; ++ai)
#pragma unroll
                for (int m = 0; m < 4; ++m) { const int row = ai * HALF + wr * 64 + m * 16 + fr;
#pragma unroll
                    for (int n = 0; n < 2; ++n) { const int c = wc * 32 + n * 16 + 4 * fq; *(PG8_LAS f32x4*)(SL + row * 128 + (c ^ ((row & 7) << 2))) = acc[ai][d][m][n]; } }
            asm volatile("s_waitcnt lgkmcnt(0)" ::: "memory"); __builtin_amdgcn_s_barrier(); asm volatile("" ::: "memory");
            const float* a16 = A16 + ((size_t)(d * 128 + u.g) * 64 + p) * 2; const float ar = a16[0], ai_ = a16[1];
            const int row0 = d == 0 ? ch * 32 : 255 - ch * 32, rst = d == 0 ? 1 : -1;
            float sr = 0.f, si = 0.f;
#pragma unroll 8
            for (int i = 0; i < 32; ++i) { const int row = row0 + rst * i, sw = (row & 7) << 2; const float xr = SL[row * 128 + (p ^ sw)], xi = SL[row * 128 + ((64 + p) ^ sw)];
                const float nr = ar * sr - ai_ * si + xr, ni = ar * si + ai_ * sr + xi; sr = nr; si = ni; }
            xc[(ch * 64 + p) * 2] = sr; xc[(ch * 64 + p) * 2 + 1] = si;
            asm volatile("s_waitcnt lgkmcnt(0)" ::: "memory"); __builtin_amdgcn_s_barrier(); asm volatile("" ::: "memory");
            float pr = ar, pi = ai_;
#pragma unroll
            for (int k = 0; k < 5; ++k) { const float nr = pr * pr - pi * pi, ni = 2.f * pr * pi; pr = nr; pi = ni; }
            float cr = xc[1024 + (d * 64 + p) * 2], ci = xc[1024 + (d * 64 + p) * 2 + 1];
            for (int q = 0; q < ch; ++q) { const float er = xc[(q * 64 + p) * 2], ei = xc[(q * 64 + p) * 2 + 1]; const float nr = pr * cr - pi * ci + er, ni = pr * ci + pi * cr + ei; cr = nr; ci = ni; }
            bf16_t* OUT = A2 + ((size_t)u.g * 512 + (size_t)u.pm * 256) * 512 + d * 128 + p;
#pragma unroll 8
            for (int i = 0; i < 32; ++i) { const int row = row0 + rst * i, sw = (row & 7) << 2; const float xr = SL[row * 128 + (p ^ sw)], xi = SL[row * 128 + ((64 + p) ^ sw)];
                const unsigned pk = cvt_pk_bf16(cr, ci); OUT[(size_t)row * 512] = (bf16_t)(pk & 0xffffu); OUT[(size_t)row * 512 + 64] = (bf16_t)(pk >> 16);
                const float nr = ar * cr - ai_ * ci + xr, ni = ar * ci + ai_ * cr + xi; cr = nr; ci = ni; }
            asm volatile("s_waitcnt lgkmcnt(0)" ::: "memory"); __builtin_amdgcn_s_barrier(); asm volatile("" ::: "memory");
        }
    }
};

template <bool SECOND> struct EpiRms {
    static constexpr bool PERM = false, AFTER_DRAIN = true, I8 = false;
    float* X; const float* fmod; const float* ng; bf16_t* U; float* xs; unsigned* cnt; unsigned* tmo;
    int lg, qg, iga, lm, qsh, qsc, igb, bank;
    __device__ __forceinline__ void operator()(const f32x4 (&)[2][2][4][2], const Unit&, int, int, int, int) const {}
    __device__ __forceinline__ void stats(const f32x4 (&v)[2][2][4][2], const Unit& u, int bk, int wr, int wc, int fr, int fq, PG8_LAS unsigned char* lds, int wid, int lane) const {
        PG8_LAS float* P = (PG8_LAS float*)lds; PG8_LAS float* S = P + 1024; const int tid = wid * 64 + lane;
        float* xb = xs + (size_t)bk * 65536 + (size_t)u.pm * 2048; unsigned* cb = cnt + bk * 2048 + 64 * u.pm;
#pragma unroll
        for (int ai = 0; ai < 2; ++ai)
#pragma unroll
            for (int m = 0; m < 4; ++m) { float q = 0.f;
#pragma unroll
                for (int bj = 0; bj < 2; ++bj)
#pragma unroll
                    for (int n = 0; n < 2; ++n) { const f32x4 x = v[ai][bj][m][n]; q += (x[0] * x[0] + x[1] * x[1]) + (x[2] * x[2] + x[3] * x[3]); }
                { const int ln = fq * 16 + fr;
                  q += __builtin_bit_cast(float, __builtin_amdgcn_ds_bpermute((ln ^ 16) << 2, __builtin_bit_cast(int, q)));
                  q += __builtin_bit_cast(float, __builtin_amdgcn_ds_bpermute((ln ^ 32) << 2, __builtin_bit_cast(int, q))); }
                if (fq == 0) P[(ai * HALF + wr * 64 + m * 16 + fr) * 4 + wc] = q; }
        asm volatile("s_waitcnt lgkmcnt(0)" ::: "memory"); __builtin_amdgcn_s_barrier(); asm volatile("" ::: "memory");
        if (tid < 256) { const f32x4 p4 = *(PG8_LAS f32x4*)(P + tid * 4); const float t = (p4[0] + p4[1]) + (p4[2] + p4[3]);
            __hip_atomic_store((unsigned*)(xb + tid * 8 + u.pn), __builtin_bit_cast(unsigned, t), __ATOMIC_RELAXED, __HIP_MEMORY_SCOPE_AGENT); }
        asm volatile("s_waitcnt vmcnt(0)" ::: "memory");
        if (wid < 4 && lane == 0) __hip_atomic_fetch_add(cb, 1u, __ATOMIC_RELAXED, __HIP_MEMORY_SCOPE_AGENT);
        if (wid == 0) { unsigned sp = 0;
            while ((unsigned)__builtin_amdgcn_readfirstlane((int)__hip_atomic_load(cb, __ATOMIC_RELAXED, __HIP_MEMORY_SCOPE_AGENT)) < 32u) { __builtin_amdgcn_s_sleep(2);
                if ((++sp & 255u) == 0u) { if (__hip_atomic_load(tmo, __ATOMIC_RELAXED, __HIP_MEMORY_SCOPE_AGENT)) break; if (sp > (1u << 22)) { if (lane == 0) atomicAdd(tmo, 1u); break; } } }
            __builtin_amdgcn_fence(__ATOMIC_ACQUIRE, "agent"); }
        asm volatile("s_waitcnt vmcnt(0) lgkmcnt(0)" ::: "memory"); __builtin_amdgcn_s_barrier(); asm volatile("" ::: "memory");
        if (tid < 256) { float t = 0.f;
#pragma unroll
            for (int k = 0; k < 8; ++k) t += __builtin_bit_cast(float, __hip_atomic_load((unsigned*)(xb + tid * 8 + k), __ATOMIC_RELAXED, __HIP_MEMORY_SCOPE_AGENT));
            S[tid] = 1.0f / sqrtf(t * (1.0f / 2048.0f) + 1e-6f); }
        asm volatile("s_waitcnt lgkmcnt(0)" ::: "memory"); __builtin_amdgcn_s_barrier(); asm volatile("" ::: "memory");
    }
    __device__ __forceinline__ void fused(f32x4 (&acc)[2][2][4][2], const Unit& u, int wr, int wc, int fr, int fq, PG8_LAS unsigned char* lds, int wid, int lane) const {
        const PG8_LAS float* S = (const PG8_LAS float*)lds + 1024;
        const int b = u.pm >> 4, col0 = u.pn * BM + wc * 32 + 4 * fq;
        const float* gate = fmod + ((size_t)(lg * 3 + b) * 6 + qg) * 2048; const float* ga = ng + iga * 2048;
        f32x4 GG[2][2];
#pragma unroll
        for (int bj = 0; bj < 2; ++bj)
#pragma unroll
            for (int n = 0; n < 2; ++n) { const int c = col0 + bj * HALF + n * 16; GG[bj][n] = *(const f32x4*)(gate + c) * *(const f32x4*)(ga + c); }
        stats(acc, u, bank, wr, wc, fr, fq, lds, wid, lane);
#pragma unroll
        for (int ai = 0; ai < 2; ++ai)
#pragma unroll
            for (int m = 0; m < 4; ++m) { const int r = ai * HALF + wr * 64 + m * 16 + fr; const float ry = S[r]; float* xp = X + (size_t)(u.pm * BM + r) * 2048 + col0;
#pragma unroll
                for (int bj = 0; bj < 2; ++bj)
#pragma unroll
                    for (int n = 0; n < 2; ++n) { const f32x4 x = *(const f32x4*)(xp + bj * HALF + n * 16); acc[ai][bj][m][n] = x + GG[bj][n] * (acc[ai][bj][m][n] * ry); *(f32x4*)(xp + bj * HALF + n * 16) = acc[ai][bj][m][n]; }
                asm volatile("" : "+v"(acc[ai][0][m][0]), "+v"(acc[ai][0][m][1]), "+v"(acc[ai][1][m][0]), "+v"(acc[ai][1][m][1]));
                if (m & 1) asm volatile("" ::: "memory"); }
        if (SECOND) {
            stats(acc, u, bank + 1, wr, wc, fr, fq, lds, wid, lane);
            const float* sh = fmod + ((size_t)(lm * 3 + b) * 6 + qsh) * 2048; const float* sc = fmod + ((size_t)(lm * 3 + b) * 6 + qsc) * 2048; const float* gb = ng + igb * 2048;
            f32x4 SC[2][2], SH[2][2];
#pragma unroll
            for (int bj = 0; bj < 2; ++bj)
#pragma unroll
                for (int n = 0; n < 2; ++n) { const int c = col0 + bj * HALF + n * 16; SC[bj][n] = (*(const f32x4*)(sc + c) + 1.0f) * *(const f32x4*)(gb + c); SH[bj][n] = *(const f32x4*)(sh + c); }
#pragma unroll
            for (int ai = 0; ai < 2; ++ai)
#pragma unroll
                for (int m = 0; m < 4; ++m) { const int r = ai * HALF + wr * 64 + m * 16 + fr; const float rx = S[r]; bf16_t* up = U + (size_t)(u.pm * BM + r) * 2048 + col0;
#pragma unroll
                    for (int bj = 0; bj < 2; ++bj)
#pragma unroll
                        for (int n = 0; n < 2; ++n) { const f32x4 uu = (acc[ai][bj][m][n] * rx) * SC[bj][n] + SH[bj][n]; u32x2 w; w.x = cvt_pk_bf16(uu[0], uu[1]); w.y = cvt_pk_bf16(uu[2], uu[3]); *(u32x2*)(up + bj * HALF + n * 16) = w; } }
        }
    }
};

__device__ __forceinline__ f32x4 mma_one(bf16x8 b, bf16x8 a, f32x4 c) { return __builtin_amdgcn_mfma_f32_16x16x32_bf16(b, a, c, 0, 0, 0); }
__device__ __forceinline__ i32x4 mma_one(bf16x8 b, bf16x8 a, i32x4 c) { return __builtin_amdgcn_mfma_i32_16x16x64_i8(__builtin_bit_cast(i32x4, b), __builtin_bit_cast(i32x4, a), c, 0, 0, 0); }
template <class Epi, class Sched, bool ALIGN_EPI = false, bool SP2 = false>
__device__ __forceinline__ void gemm_phase(PG8_LAS unsigned char* lds, const Gemm g, const Sched& S, const Epi& E, const int tid) {
    const int wid = __builtin_amdgcn_readfirstlane(tid >> 6), lane = tid & 63, wr = wid >> 2, wc = wid & 3, fr = lane & 15, fq = lane >> 4;
    const int K = g.K, nt = K / BK;
    unsigned voffA[2], voffB[2];
#pragma unroll
    for (int i = 0; i < 2; ++i) { int R, C; stage_rc(tid * 16 + i * 8192, R, C); const int Rb = Epi::PERM ? ((R & ~31) + perm32(R & 31)) : R;
        voffA[i] = (unsigned)(R * g.lda + C) * 2u; voffB[i] = (unsigned)(Rb * g.ldb + C) * 2u; }
    const size_t kstep = (size_t)(BK * 2);
    const size_t hstepA = (size_t)HALF * g.lda * 2, hstepB = (size_t)HALF * g.ldb * 2;
    const size_t tstepA = 2 * hstepA, tstepB = 2 * hstepB;
    const unsigned ldsw = (unsigned)wid * 1024u;
    const int aoff = lds_byte(wr * 64 + fr, fq * 8), boff = lds_byte(wc * 32 + fr, fq * 8);
#define PG8_SA(b, h) (((b) * 2 + (h)) * HTB)
#define PG8_SB(b, h) ((4 + (b) * 2 + (h)) * HTB)
#define PG8_STAGE(bufoff, gbase, voff) do { _Pragma("unroll") for (int _i = 0; _i < 2; ++_i) \
        __builtin_amdgcn_global_load_lds((const unsigned*)((const char*)(gbase) + (voff)[_i]), (PG8_LAS unsigned*)(lds + (bufoff) + ldsw + _i * 8192), 16, 0, 0); } while (0)
#define PG8_LDA(dst, b, h) do { _Pragma("unroll") for (int m = 0; m < 4; ++m) _Pragma("unroll") for (int k = 0; k < 2; ++k) dst[m][k] = *(const PG8_LAS bf16x8*)(lds + PG8_SA(b, h) + aoff + m * 2048 + k * 1024); } while (0)
#define PG8_LDB(dst, b, h) do { _Pragma("unroll") for (int n = 0; n < 2; ++n) _Pragma("unroll") for (int k = 0; k < 2; ++k) dst[n][k] = *(const PG8_LAS bf16x8*)(lds + PG8_SB(b, h) + boff + n * 2048 + k * 1024); } while (0)
#define PG8_MMA(ai, bj, At, Bt) do { __builtin_amdgcn_s_setprio(1); _Pragma("unroll") for (int m = 0; m < 4; ++m) _Pragma("unroll") for (int n = 0; n < 2; ++n) _Pragma("unroll") for (int k = 0; k < 2; ++k) \
        acc[ai][bj][m][n] = mma_one(Bt[n][k], At[m][k], acc[ai][bj][m][n]); __builtin_amdgcn_s_setprio(0); } while (0)
#define PG8_WAIT_V(n) asm volatile("s_waitcnt vmcnt(" #n ")" ::: "memory")
#define PG8_WAIT_L(n) asm volatile("s_waitcnt lgkmcnt(" #n ")" ::: "memory")
#define PG8_BAR __builtin_amdgcn_s_barrier()
#define PG8_SCHED __builtin_amdgcn_sched_barrier(0)
    Unit cur, nxt; int ui = 0;
    if (!S.next(0, cur)) return;
    typedef typename AccT<Epi::I8>::T acc_t; const acc_t acc_zero = {};
    acc_t acc[2][2][4][2];
#pragma unroll
    for (int a = 0; a < 2; ++a)
#pragma unroll
        for (int b = 0; b < 2; ++b)
#pragma unroll
            for (int m = 0; m < 4; ++m)
#pragma unroll
                for (int n = 0; n < 2; ++n) acc[a][b][m][n] = acc_zero;
    bf16x8 At[4][2], B0[2][2], B1[2][2];
    const char* cA = (const char*)g.A + ((size_t)cur.g * g.gsA) * 2 + (size_t)cur.pm * tstepA; const char* cB = (const char*)g.Bt + ((size_t)cur.g * g.gsB) * 2 + (size_t)cur.pn * tstepB;
    if constexpr (SP2) {
        PG8_STAGE(PG8_SB(0, 0), cB, voffB); PG8_STAGE(PG8_SB(0, 1), cB + hstepB, voffB); PG8_STAGE(PG8_SA(0, 0), cA, voffA); PG8_STAGE(PG8_SA(0, 1), cA + hstepA, voffA);
        if (wr == 1) PG8_BAR;
        PG8_WAIT_V(2); PG8_BAR;
        PG8_STAGE(PG8_SB(1, 0), cB + kstep, voffB); PG8_STAGE(PG8_SA(1, 0), cA + kstep, voffA); PG8_STAGE(PG8_SB(1, 1), cB + hstepB + kstep, voffB);
        PG8_WAIT_V(6); PG8_BAR;
    } else {
        PG8_STAGE(PG8_SB(0, 0), cB, voffB); PG8_STAGE(PG8_SA(0, 0), cA, voffA); PG8_STAGE(PG8_SB(0, 1), cB + hstepB, voffB); PG8_STAGE(PG8_SA(0, 1), cA + hstepA, voffA);
        if (wr == 1) PG8_BAR;
        PG8_WAIT_V(4); PG8_BAR;
        PG8_STAGE(PG8_SB(1, 0), cB + kstep, voffB); PG8_STAGE(PG8_SA(1, 0), cA + kstep, voffA); PG8_STAGE(PG8_SB(1, 1), cB + hstepB + kstep, voffB);
        PG8_WAIT_V(6); PG8_BAR;
    }
    for (;;) {
        const bool has_next = S.next(ui + 1, nxt);
        const char* nA = has_next ? (const char*)g.A + ((size_t)nxt.g * g.gsA) * 2 + (size_t)nxt.pm * tstepA : cA; const char* nB = has_next ? (const char*)g.Bt + ((size_t)nxt.g * g.gsB) * 2 + (size_t)nxt.pn * tstepB : cB;
        for (int t = 0; t < nt; t += 2) {
            const bool last = (t == nt - 2);
            const char* a1 = cA + (size_t)(t + 1) * kstep;
            const char* a2 = last ? nA : cA + (size_t)(t + 2) * kstep; const char* b2 = last ? nB : cB + (size_t)(t + 2) * kstep;
            const char* a3 = a2 + kstep; const char* b3 = b2 + kstep;
            if constexpr (SP2) {
            PG8_LDB(B0, 0, 0); PG8_LDB(B1, 0, 1); PG8_SCHED; PG8_LDA(At, 0, 0); PG8_STAGE(PG8_SA(1, 1), a1 + hstepA, voffA);
            PG8_WAIT_V(8); PG8_WAIT_L(0); PG8_BAR; PG8_MMA(0, 0, At, B0); PG8_MMA(0, 1, At, B1); PG8_BAR; PG8_SCHED;
            PG8_LDA(At, 0, 1); PG8_STAGE(PG8_SB(0, 0), b2, voffB); PG8_STAGE(PG8_SB(0, 1), b2 + hstepB, voffB); PG8_STAGE(PG8_SA(0, 0), a2, voffA);
            PG8_WAIT_V(8); PG8_WAIT_L(0); PG8_BAR; PG8_MMA(1, 0, At, B0); PG8_MMA(1, 1, At, B1); PG8_BAR; PG8_SCHED;
            PG8_LDB(B0, 1, 0); PG8_LDB(B1, 1, 1); PG8_SCHED; PG8_LDA(At, 1, 0); PG8_STAGE(PG8_SA(0, 1), a2 + hstepA, voffA);
            PG8_WAIT_V(8); PG8_WAIT_L(0); PG8_BAR; PG8_MMA(0, 0, At, B0); PG8_MMA(0, 1, At, B1); PG8_BAR; PG8_SCHED;
            PG8_LDA(At, 1, 1); PG8_STAGE(PG8_SB(1, 0), b3, voffB); PG8_STAGE(PG8_SB(1, 1), b3 + hstepB, voffB); PG8_STAGE(PG8_SA(1, 0), a3, voffA);
            PG8_WAIT_V(8); PG8_WAIT_L(0); PG8_BAR; PG8_MMA(1, 0, At, B0); PG8_MMA(1, 1, At, B1); PG8_BAR; PG8_SCHED;
            } else {
            PG8_LDB(B0, 0, 0); PG8_SCHED; PG8_LDA(At, 0, 0); PG8_STAGE(PG8_SA(1, 1), a1 + hstepA, voffA);
            PG8_WAIT_L(8); PG8_BAR; PG8_WAIT_L(0); PG8_MMA(0, 0, At, B0); PG8_BAR; PG8_SCHED;
            PG8_LDB(B1, 0, 1); PG8_STAGE(PG8_SB(0, 0), b2, voffB);
            PG8_BAR; PG8_WAIT_L(0); PG8_MMA(0, 1, At, B1); PG8_BAR;
            PG8_LDA(At, 0, 1); PG8_STAGE(PG8_SA(0, 0), a2, voffA);
            PG8_BAR; PG8_WAIT_L(0); PG8_MMA(1, 0, At, B0); PG8_BAR; PG8_SCHED;
            PG8_STAGE(PG8_SB(0, 1), b2 + hstepB, voffB);
            PG8_WAIT_V(6); PG8_BAR; PG8_MMA(1, 1, At, B1); PG8_BAR;
            PG8_LDB(B0, 1, 0); PG8_SCHED; PG8_LDA(At, 1, 0); PG8_STAGE(PG8_SA(0, 1), a2 + hstepA, voffA);
            PG8_WAIT_L(8); PG8_BAR; PG8_WAIT_L(0); PG8_MMA(0, 0, At, B0); PG8_BAR; PG8_SCHED;
            PG8_LDB(B1, 1, 1); PG8_STAGE(PG8_SB(1, 0), b3, voffB);
            PG8_BAR; PG8_WAIT_L(0); PG8_MMA(0, 1, At, B1); PG8_BAR;
            PG8_LDA(At, 1, 1); PG8_STAGE(PG8_SA(1, 0), a3, voffA);
            PG8_BAR; PG8_WAIT_L(0); PG8_MMA(1, 0, At, B0); PG8_BAR; PG8_SCHED;
            PG8_STAGE(PG8_SB(1, 1), b3 + hstepB, voffB);
            PG8_WAIT_V(6); PG8_BAR; PG8_MMA(1, 1, At, B1); PG8_BAR;
            }
        }
        if constexpr (ALIGN_EPI) { if (wr == 0) PG8_BAR; }
        if constexpr (!Epi::AFTER_DRAIN) E(acc, cur, wr, wc, fr, fq);
        if (!has_next) break;
#pragma unroll
        for (int a = 0; a < 2; ++a)
#pragma unroll
            for (int b = 0; b < 2; ++b)
#pragma unroll
                for (int m = 0; m < 4; ++m)
#pragma unroll
                    for (int n = 0; n < 2; ++n) acc[a][b][m][n] = acc_zero;
        cur = nxt; cA = nA; cB = nB; ++ui;
        if constexpr (ALIGN_EPI) { if (wr == 1) PG8_BAR; }
    }
    PG8_WAIT_V(0);
    if constexpr (!ALIGN_EPI) { if (wr == 0) PG8_BAR; }
    PG8_BAR;
    if constexpr (Epi::AFTER_DRAIN) E.fused(acc, cur, wr, wc, fr, fq, lds, wid, lane);
#undef PG8_SA
#undef PG8_SB
#undef PG8_STAGE
#undef PG8_LDA
#undef PG8_LDB
#undef PG8_MMA
#undef PG8_WAIT_V
#undef PG8_WAIT_L
#undef PG8_BAR
#undef PG8_SCHED
}
}

constexpr int NWAVES = 8, NTHR = NWAVES * 64;
constexpr int DM = 2048, NBATCH = 2, SEQ = 4096, CTX = 256, MT = NBATCH * SEQ, MC = NBATCH * CTX, DFF = 5632, DFF2 = 2 * DFF, NMODC = 6 * DM, NG = 128;
constexpr float RMS_EPS = 1e-6f;
constexpr int NPHASE = 17;

constexpr size_t MiB = 1u << 20;
constexpr size_t WS_CTL = 0, CTL_ZERO_BYTES = 1 * MiB;
constexpr size_t WS_MODP = 1 * MiB;
constexpr size_t WS_A16 = 4 * MiB;
constexpr size_t WS_WGLU = 5 * MiB;
constexpr size_t WS_WUP = 21 * MiB;
constexpr size_t WS_WDN = 109 * MiB;
constexpr size_t WS_WPOOL = 153 * MiB;
constexpr size_t WS_UZ = 155 * MiB;
constexpr size_t WS_YF = 187 * MiB;
constexpr size_t WS_ACT = 219 * MiB;
constexpr size_t WS_WIN = 307 * MiB;
constexpr size_t WS_W2 = 323 * MiB;
constexpr size_t WS_A2 = 355 * MiB;
constexpr size_t WS_UCG = 419 * MiB;
constexpr size_t WS_SLOC = 421 * MiB;
constexpr size_t WS_SCLOC = 485 * MiB;
constexpr size_t WS_PRE = 489 * MiB;
constexpr size_t WS_RAW = 493 * MiB;
constexpr size_t WS_FMOD = 497 * MiB;
constexpr size_t WS_XS = 498 * MiB;
constexpr size_t WS_WUP8 = 499 * MiB;
constexpr size_t WS_U8 = 543 * MiB;
constexpr size_t WS_SU = 559 * MiB;
constexpr size_t WS_SW = 559 * MiB + 65536;
constexpr size_t WS_END = 560 * MiB;
static_assert(WS_SCLOC + (size_t)NG * 32 * 256 * 4 <= WS_PRE && WS_PRE + (size_t)32 * 2 * 2 * DFF * 4 <= WS_RAW && WS_RAW + (size_t)32 * 2 * 2 * DFF * 4 <= WS_FMOD && WS_XS + 3 * 262144 <= WS_WUP8 && WS_WUP8 + (size_t)2 * DFF2 * DM <= WS_U8 && WS_U8 + (size_t)MT * DM <= WS_SU && WS_SW + 2 * DFF2 * 4 <= WS_END, "d_ws map");

constexpr int RING_OFF = 0, RING_BYTES = 131072;
constexpr int LDSCTL_OFF = RING_BYTES, MISC_OFF = LDSCTL_OFF + 320, PTR_OFF = LDSCTL_OFF + 1024;
constexpr int XCH_OFF = LDSCTL_OFF + 2048;
constexpr int LDS_BYTES = 163840;

#define GAS __attribute__((address_space(1)))
#define LAS __attribute__((address_space(3)))
typedef unsigned short bf16;
typedef unsigned v4u __attribute__((ext_vector_type(4)));
typedef unsigned v2u __attribute__((ext_vector_type(2)));
typedef float f32x4 __attribute__((ext_vector_type(4)));
typedef short bf16x8 __attribute__((ext_vector_type(8)));
typedef float f32x16 __attribute__((ext_vector_type(16)));
#define LDS_WAIT() asm volatile("s_waitcnt lgkmcnt(0)" ::: "memory")
#define VM_WAIT() asm volatile("s_waitcnt vmcnt(0)" ::: "memory")
__device__ __forceinline__ unsigned f2bf(float f) { unsigned u = __builtin_bit_cast(unsigned, f); return (u + 0x7fffu + ((u >> 16) & 1u)) >> 16; }
__device__ __forceinline__ unsigned pk2(float lo, float hi) { return f2bf(lo) | (f2bf(hi) << 16); }
__device__ __forceinline__ float bf_lo(unsigned w) { return __builtin_bit_cast(float, w << 16); }
__device__ __forceinline__ float bf_hi(unsigned w) { return __builtin_bit_cast(float, w & 0xffff0000u); }
__device__ __forceinline__ float sigm(float x) { return __builtin_amdgcn_rcpf(1.0f + __builtin_amdgcn_exp2f(-1.44269504089f * x)); }

#define XB_TMO      128
#define XB_XCNT(j)  (256  + 64 * (j))
#define XB_XSUB(j)  (1280 + 64 * (j))
#define XB_XGEN(j)  (2304 + 64 * (j))
#define XB_TOP      3328
#define XB_TOPGEN   3392
#define XCD_BAR_WORDS 3456
#define XB_SPIN_CAP (1u << 20)
__device__ __forceinline__ unsigned xb_ld(unsigned* p)              { return __hip_atomic_load(p, __ATOMIC_RELAXED, __HIP_MEMORY_SCOPE_AGENT); }
__device__ __forceinline__ unsigned xb_add(unsigned* p, unsigned v) { return __hip_atomic_fetch_add(p, v, __ATOMIC_RELAXED, __HIP_MEMORY_SCOPE_AGENT); }
__device__ __forceinline__ unsigned xb_xcc_id() { return (unsigned)__builtin_amdgcn_s_getreg((3 << 11) | 20) & 0xFu; }
#define XB_SPIN(cond, bar) do { unsigned _sp = 0; while (cond) { __builtin_amdgcn_s_sleep(1); \
    if ((++_sp & 255u) == 0u) { if (xb_ld(&(bar)[XB_TMO])) break; if (_sp > XB_SPIN_CAP) { atomicAdd(&(bar)[XB_TMO], 1u); break; } } } } while (0)
struct XcdBarrier { unsigned* bar; unsigned x; volatile LAS unsigned* st; unsigned expect; };
__device__ __forceinline__ XcdBarrier xcd_barrier_post(unsigned* bar, volatile LAS unsigned* st, unsigned expect) {
    XcdBarrier b; b.bar = bar; b.x = xb_xcc_id(); b.st = st; b.expect = expect;
    if (threadIdx.x == 0) (void)xb_add(&bar[XB_XCNT(b.x)], 1u);
    return b;
}
__device__ __forceinline__ void xcd_barrier_complete(unsigned* bar, unsigned x, unsigned& nloc, unsigned& nx, const unsigned G) {
    unsigned sum, cnt, mine, sp = 0u;
    for (;;) {
        sum = 0u; cnt = 0u; mine = 0u;
#pragma unroll
        for (unsigned j = 0; j < 16; ++j) { const unsigned c = xb_ld(&bar[XB_XCNT(j)]); sum += c; cnt += (c > 0u) ? 1u : 0u; mine = (j == x) ? c : mine; }
        if (sum == G) break;
        __builtin_amdgcn_s_sleep(1);
        if ((++sp & 255u) == 0u) { if (xb_ld(&bar[XB_TMO])) break; if (sp > XB_SPIN_CAP) { atomicAdd(&bar[XB_TMO], 1u); break; } }
    }
    nloc = mine > 0u ? mine : 1u; nx = cnt > 0u ? cnt : 1u;
}
__device__ __forceinline__ void xcd_barrier(const XcdBarrier& b) {
    asm volatile("s_waitcnt vmcnt(0)" ::: "memory");
    __syncthreads();
    if (threadIdx.x == 0) {
        unsigned* bar = b.bar;
        __builtin_amdgcn_s_waitcnt(0);
        unsigned nloc = b.st[0], nx = b.st[1];
        if (nloc == 0u) { xcd_barrier_complete(bar, b.x, nloc, nx, b.expect); b.st[0] = nloc; b.st[1] = nx; }
        const unsigned old = xb_add(&bar[XB_XSUB(b.x)], 1u);
        const unsigned gen = old / nloc;
        if (old + 1u == (gen + 1u) * nloc) {
            __builtin_amdgcn_fence(__ATOMIC_RELEASE, "agent");
            asm volatile("s_waitcnt vmcnt(0)" ::: "memory");
            const unsigned og = xb_add(&bar[XB_TOP], 1u);
            const unsigned tg = og / nx;
            if (og + 1u == (tg + 1u) * nx) xb_add(&bar[XB_TOPGEN], 1u);
            else XB_SPIN(xb_ld(&bar[XB_TOPGEN]) == tg, bar);
            __builtin_amdgcn_fence(__ATOMIC_ACQUIRE, "agent");
            xb_add(&bar[XB_XGEN(b.x)], 1u);
            asm volatile("s_waitcnt vmcnt(0)" ::: "memory");
        } else {
            XB_SPIN(xb_ld(&bar[XB_XGEN(b.x)]) == gen, bar);
            __builtin_amdgcn_fence(__ATOMIC_ACQUIRE, "agent");
            asm volatile("s_waitcnt vmcnt(0)" ::: "memory");
        }
    }
    __syncthreads();
}

struct Args { const float* in[22]; float* out; unsigned char* ws; int ph_lo, ph_hi, li, pad; };
struct Frame {
    LAS unsigned char* lds;
    int tid, lane, wave, vcu, G;
    int b0, nb;
    float* out; unsigned char* ws;
    __device__ __forceinline__ const float* inp(int i) const { return *(const float* LAS*)(lds + PTR_OFF + 8 * i); }
    __device__ __forceinline__ const float* inp_s(int i) const { const unsigned long long p = (unsigned long long)inp(i);
        return (const float*)(((unsigned long long)(unsigned)__builtin_amdgcn_readfirstlane((int)(p >> 32)) << 32) | (unsigned)__builtin_amdgcn_readfirstlane((int)p)); }
};
enum { I_X = 0, I_C, I_CTX, I_CCTX, I_ADAW, I_ADAB, I_NORMG, I_LAMRE, I_LAMIM, I_LOGSTEP, I_BRE, I_BIM, I_CRE, I_CIM, I_S5D, I_GLUW, I_POOLW, I_POOLS, I_UP, I_CONV, I_CONVB, I_DOWN };

__device__ __forceinline__ float wave_sum(float v) {
    v += __builtin_bit_cast(float, __builtin_amdgcn_update_dpp(0, __builtin_bit_cast(int, v), 0xB1, 0xF, 0xF, false));
    v += __builtin_bit_cast(float, __builtin_amdgcn_update_dpp(0, __builtin_bit_cast(int, v), 0x4E, 0xF, 0xF, false));
    v += __builtin_bit_cast(float, __builtin_amdgcn_update_dpp(0, __builtin_bit_cast(int, v), 0x141, 0xF, 0xF, false));
    v += __builtin_bit_cast(float, __builtin_amdgcn_update_dpp(0, __builtin_bit_cast(int, v), 0x140, 0xF, 0xF, false));
    const int iv = __builtin_bit_cast(int, v);
    const float a = __builtin_bit_cast(float, __builtin_amdgcn_readlane(iv, 0)), b = __builtin_bit_cast(float, __builtin_amdgcn_readlane(iv, 16)),
                c = __builtin_bit_cast(float, __builtin_amdgcn_readlane(iv, 32)), d = __builtin_bit_cast(float, __builtin_amdgcn_readlane(iv, 48));
    return (a + b) + (c + d);
}

__device__ __forceinline__ float wave_max(float v) {
    v = fmaxf(v, __builtin_bit_cast(float, __builtin_amdgcn_update_dpp(0, __builtin_bit_cast(int, v), 0xB1, 0xF, 0xF, false)));
    v = fmaxf(v, __builtin_bit_cast(float, __builtin_amdgcn_update_dpp(0, __builtin_bit_cast(int, v), 0x4E, 0xF, 0xF, false)));
    v = fmaxf(v, __builtin_bit_cast(float, __builtin_amdgcn_update_dpp(0, __builtin_bit_cast(int, v), 0x141, 0xF, 0xF, false)));
    v = fmaxf(v, __builtin_bit_cast(float, __builtin_amdgcn_update_dpp(0, __builtin_bit_cast(int, v), 0x140, 0xF, 0xF, false)));
    const int iv = __builtin_bit_cast(int, v);
    const float a = __builtin_bit_cast(float, __builtin_amdgcn_readlane(iv, 0)), b = __builtin_bit_cast(float, __builtin_amdgcn_readlane(iv, 16)),
                c = __builtin_bit_cast(float, __builtin_amdgcn_readlane(iv, 32)), d = __builtin_bit_cast(float, __builtin_amdgcn_readlane(iv, 48));
    return fmaxf(fmaxf(a, b), fmaxf(c, d));
}
__device__ __forceinline__ unsigned q8x4(f32x4 v, float inv) {
    const float M = 12582912.0f;
    const unsigned a = __builtin_bit_cast(unsigned, __builtin_fmaf(v[0], inv, M)), b = __builtin_bit_cast(unsigned, __builtin_fmaf(v[1], inv, M)),
                   c = __builtin_bit_cast(unsigned, __builtin_fmaf(v[2], inv, M)), d = __builtin_bit_cast(unsigned, __builtin_fmaf(v[3], inv, M));
    return __builtin_amdgcn_perm(b, a, 0x0c0c0400u) | __builtin_amdgcn_perm(d, c, 0x04000c0cu);
}

__device__ __forceinline__ void sincos_d(double x, double& s, double& c) {
    const double q = __builtin_rint(x * 0.63661977236758134308);
    double r = __builtin_fma(-q, 1.57079632679489655800e+00, x); r = __builtin_fma(-q, 6.12323399573676603587e-17, r);
    const int iq = ((int)q) & 3; const double r2 = r * r;
    double sp = 1.0 / 6227020800.0; sp = sp * r2 - 1.0 / 39916800.0; sp = sp * r2 + 1.0 / 362880.0; sp = sp * r2 - 1.0 / 5040.0; sp = sp * r2 + 1.0 / 120.0; sp = sp * r2 - 1.0 / 6.0; sp = sp * r2 + 1.0; sp *= r;
    double cp = -1.0 / 87178291200.0; cp = cp * r2 + 1.0 / 479001600.0; cp = cp * r2 - 1.0 / 3628800.0; cp = cp * r2 + 1.0 / 40320.0; cp = cp * r2 - 1.0 / 720.0; cp = cp * r2 + 1.0 / 24.0; cp = cp * r2 - 0.5; cp = cp * r2 + 1.0;
    s = (iq == 0) ? sp : (iq == 1) ? cp : (iq == 2) ? -sp : -cp;
    c = (iq == 0) ? cp : (iq == 1) ? -sp : (iq == 2) ? -cp : sp;
}
__device__ __forceinline__ double exp_d(double x) {
    const double n = __builtin_rint(x * 1.44269504088896340736);
    double r = __builtin_fma(-n, 6.93147180369123816490e-01, x); r = __builtin_fma(-n, 1.90821492927058770002e-10, r);
    double p = 1.0 / 479001600.0;
    p = p * r + 1.0 / 39916800.0; p = p * r + 1.0 / 3628800.0; p = p * r + 1.0 / 362880.0; p = p * r + 1.0 / 40320.0; p = p * r + 1.0 / 5040.0; p = p * r + 1.0 / 720.0;
    p = p * r + 1.0 / 120.0; p = p * r + 1.0 / 24.0; p = p * r + 1.0 / 6.0; p = p * r + 0.5; p = p * r + 1.0; p = p * r + 1.0;
    return __builtin_ldexp(p, (int)n);
}

struct TrItem { const float* W; bf16* WT; int K, N, mode, item; };
__device__ __forceinline__ void tr_load(const TrItem& d, int lane, float (&v)[64]) {
    const int nblk = d.N / 64, kb = d.item / nblk, nb = d.item % nblk; const float* src = d.W + (size_t)(64 * kb) * d.N + 64 * nb + lane;
#pragma unroll
    for (int i = 0; i < 64; ++i) v[i] = *(const GAS float*)(src + (size_t)i * d.N);
}
__device__ __forceinline__ void tr_finish(const TrItem& d, int lane, const float (&v)[64], LAS unsigned* scr) {
    const int nblk = d.N / 64, kb = d.item / nblk, nb = d.item % nblk, k0 = 64 * kb, n0 = 64 * nb;
#pragma unroll
    for (int i = 0; i < 32; ++i) scr[i * 65 + lane] = pk2(v[2 * i], v[2 * i + 1]);
    LDS_WAIT(); asm volatile("" ::: "memory");
    const int c = lane & 7;
    int r0 = n0;
    if (d.mode == 1) { r0 = (n0 < 2048) ? (256 * (n0 >> 7) + (n0 & 127)) : (256 * ((n0 - 2048) >> 7) + 128 + ((n0 - 2048) & 127)); }
#pragma unroll
    for (int j = 0; j < 8; ++j) { const int n = (lane >> 3) + 8 * j; const LAS unsigned* q = scr + (4 * c) * 65 + n;
        v4u o; o.x = q[0]; o.y = q[65]; o.z = q[130]; o.w = q[195];
        *(GAS v4u*)(d.WT + (size_t)(r0 + n) * d.K + k0 + 8 * c) = o; }
    LDS_WAIT(); asm volatile("" ::: "memory");
}

__device__ __forceinline__ void p0_ada_item(Frame& F, int it) {
    LAS float* cond = (LAS float*)(F.lds);
    LAS float* red = (LAS float*)(F.lds + 24576);
    const int l = it / 384, r = it % 384, s = r / 48, ct = r % 48, k0 = s * 256 + F.wave * 32, n0 = ct * 256;
    const float* W = F.inp(I_ADAW) + (size_t)l * DM * NMODC + (size_t)k0 * NMODC + n0 + 4 * F.lane;
    f32x4 a0 = {0.f, 0.f, 0.f, 0.f}, a1 = a0, a2 = a0;
    f32x4 wv[32];
#pragma unroll
    for (int i = 0; i < 32; ++i) wv[i] = *(const GAS f32x4*)(W + (size_t)i * NMODC);
#pragma unroll
    for (int i = 0; i < 32; ++i) { const float c0 = cond[k0 + i], c1 = cond[2048 + k0 + i], c2 = cond[4096 + k0 + i];
        a0 += wv[i] * c0; a1 += wv[i] * c1; a2 += wv[i] * c2; }
    *(LAS f32x4*)(red + (F.wave * 3 + 0) * 256 + 4 * F.lane) = a0;
    *(LAS f32x4*)(red + (F.wave * 3 + 1) * 256 + 4 * F.lane) = a1;
    *(LAS f32x4*)(red + (F.wave * 3 + 2) * 256 + 4 * F.lane) = a2;
    __syncthreads();
    float* MODP = (float*)(F.ws + WS_MODP);
    for (int o = F.tid; o < 768; o += NTHR) { const int v = o >> 8, col = o & 255; float sum = 0.f;
#pragma unroll
        for (int w = 0; w < 8; ++w) sum += red[(w * 3 + v) * 256 + col];
        MODP[((size_t)(l * 8 + s) * 3 + v) * NMODC + n0 + col] = sum; }
    __syncthreads();
}

__device__ __forceinline__ void p0_s5_item(Frame& F, int g) {
    constexpr int AP = 68;
    LAS float* APR = (LAS float*)(F.lds);
    LAS float* API = APR + 2 * 17 * AP;
    LAS float* BBR = API + 2 * 17 * AP;
    LAS float* BBI = BBR + 2048;
    LAS float* CCR = BBI + 2048;
    LAS float* CCI = CCR + 2048;
    LAS float* CTR = CCI + 2048;
    LAS float* CTI = CTR + 2048;
    LAS float* KT = CTI + 2048;
    LAS float* DSK = KT + 8192;
    LAS double* LD = (LAS double*)(DSK + 16);
    static_assert(((2 * 2 * 17 * AP + 6 * 2048 + 8192 + 16) * 4) % 8 == 0, "LD alignment");
    float bre[4], bim[4], cre[4], cim[4];
#pragma unroll
    for (int i = 0; i < 4; ++i) { const int idx = F.tid + NTHR * i, c = idx & 15, dp = idx >> 4, d = dp >> 6, p = dp & 63;
        const size_t bi = ((size_t)(d * NG + g) * 64 + p) * 16 + c; bre[i] = F.inp(I_BRE)[bi]; bim[i] = F.inp(I_BIM)[bi];
        const int cc = idx >> 6, pp = idx & 63, d2 = cc >> 4, c2 = cc & 15; const size_t ci = ((size_t)(d2 * NG + g) * 16 + c2) * 64 + pp;
        cre[i] = F.inp(I_CRE)[ci]; cim[i] = F.inp(I_CIM)[ci]; }
    if (F.tid < 128) { const int d = F.tid >> 6, p = F.tid & 63;
        const double dt = exp_d((double)F.inp(I_LOGSTEP)[d * NG + g]); const double lr = (double)F.inp(I_LAMRE)[(d * NG + g) * 64 + p], li = (double)F.inp(I_LAMIM)[(d * NG + g) * 64 + p];
        const double mag = exp_d(lr * dt); double sn, cs; sincos_d(li * dt, sn, cs);
        const double nr = mag * cs - 1.0, ni = mag * sn, den = lr * lr + li * li;
        LD[F.tid] = lr * dt; LD[128 + F.tid] = li * dt; LD[256 + F.tid] = (nr * lr + ni * li) / den; LD[384 + F.tid] = (ni * lr - nr * li) / den; }
    if (F.tid < 16) DSK[F.tid] = F.inp(I_S5D)[g * 16 + F.tid];
#pragma unroll
    for (int i = 0; i < 4; ++i) { const int idx = F.tid + NTHR * i, cc = idx >> 6, pp = idx & 63, d2 = cc >> 4, c2 = cc & 15;
        CCR[idx] = cre[i]; CCI[idx] = cim[i]; CTR[(d2 * 64 + pp) * 16 + c2] = cre[i]; CTI[(d2 * 64 + pp) * 16 + c2] = cim[i]; }
    __syncthreads();
    for (int idx = F.tid; idx < 2176; idx += NTHR) { const int p = idx & 63, dk = idx >> 6, d = dk / 17, k = dk % 17;
        const double mag = exp_d((double)k * LD[d * 64 + p]); double sn, cs; sincos_d((double)k * LD[128 + d * 64 + p], sn, cs);
        APR[dk * AP + p] = (float)(mag * cs); API[dk * AP + p] = (float)(mag * sn); }
#pragma unroll
    for (int i = 0; i < 4; ++i) { const int idx = F.tid + NTHR * i, dp = idx >> 4; const double fr = LD[256 + dp], fi = LD[384 + dp], br = (double)bre[i], bm = (double)bim[i];
        BBR[idx] = (float)(fr * br - fi * bm); BBI[idx] = (float)(fr * bm + fi * br); }
    __syncthreads();
    bf16* WIN = (bf16*)(F.ws + WS_WIN) + (size_t)g * 256 * 256;
    for (int q = F.tid; q < 8192; q += NTHR) { const int n = q >> 5, kc = q & 31, d = n >> 7, part = (n >> 6) & 1, p = n & 63, j = kc >> 1, c0 = 8 * (kc & 1);
        const int e = d == 0 ? 15 - j : j; const float ar = APR[(d * 17 + e) * AP + p], ai = API[(d * 17 + e) * AP + p];
        const LAS f32x4* br = (const LAS f32x4*)(BBR + (d * 64 + p) * 16 + c0); const LAS f32x4* bi = (const LAS f32x4*)(BBI + (d * 64 + p) * 16 + c0);
        const f32x4 r0 = br[0], r1 = br[1], i0 = bi[0], i1 = bi[1];
        const f32x4 v0 = part == 0 ? r0 * ar - i0 * ai : i0 * ar + r0 * ai, v1 = part == 0 ? r1 * ar - i1 * ai : i1 * ar + r1 * ai;
        v4u o; o.x = pk2(v0[0], v0[1]); o.y = pk2(v0[2], v0[3]); o.z = pk2(v1[0], v1[1]); o.w = pk2(v1[2], v1[3]);
        *(GAS v4u*)(WIN + (size_t)n * 256 + 8 * kc) = o; }
    { const int cp = F.tid & 15, tau = (F.tid >> 4) & 15, d = F.tid >> 8; f32x4 s0 = {0.f, 0.f, 0.f, 0.f}, s1 = s0, s2 = s0, s3 = s0;
#pragma unroll 4
      for (int p = 0; p < 64; ++p) { const float cr = CTR[(d * 64 + p) * 16 + cp], ci = CTI[(d * 64 + p) * 16 + cp], ar = APR[(d * 17 + tau) * AP + p], ai = API[(d * 17 + tau) * AP + p];
          const float mr = cr * ar - ci * ai, mi = cr * ai + ci * ar; const LAS f32x4* br = (const LAS f32x4*)(BBR + (d * 64 + p) * 16); const LAS f32x4* bi = (const LAS f32x4*)(BBI + (d * 64 + p) * 16);
          s0 += br[0] * mr - bi[0] * mi; s1 += br[1] * mr - bi[1] * mi; s2 += br[2] * mr - bi[2] * mi; s3 += br[3] * mr - bi[3] * mi; }
      LAS f32x4* o = (LAS f32x4*)(KT + ((d * 16 + tau) * 16 + cp) * 16); o[0] = s0; o[1] = s1; o[2] = s2; o[3] = s3; }
    __syncthreads();
    bf16* W2 = (bf16*)(F.ws + WS_W2) + (size_t)g * 256 * 512;
    for (int q = F.tid; q < 8192; q += NTHR) { const int n = q >> 5, kc = q & 31, jp = n >> 4, cp = n & 15;
        const int d = kc >> 4, part = (kc >> 3) & 1, p0 = 8 * (kc & 7), e = d == 0 ? jp + 1 : 16 - jp;
        const LAS f32x4* cr = (const LAS f32x4*)(CCR + (d * 16 + cp) * 64 + p0); const LAS f32x4* ci = (const LAS f32x4*)(CCI + (d * 16 + cp) * 64 + p0);
        const LAS f32x4* ar = (const LAS f32x4*)(APR + (d * 17 + e) * AP + p0); const LAS f32x4* ai = (const LAS f32x4*)(API + (d * 17 + e) * AP + p0);
        const f32x4 cr0 = cr[0], cr1 = cr[1], ci0 = ci[0], ci1 = ci[1], ar0 = ar[0], ar1 = ar[1], ai0 = ai[0], ai1 = ai[1];
        const f32x4 v0 = part == 0 ? cr0 * ar0 - ci0 * ai0 : -(cr0 * ai0 + ci0 * ar0), v1 = part == 0 ? cr1 * ar1 - ci1 * ai1 : -(cr1 * ai1 + ci1 * ar1);
        v4u o; o.x = pk2(v0[0], v0[1]); o.y = pk2(v0[2], v0[3]); o.z = pk2(v1[0], v1[1]); o.w = pk2(v1[2], v1[3]);
        *(GAS v4u*)(W2 + (size_t)n * 512 + 8 * kc) = o; }
    for (int q = F.tid; q < 8192; q += NTHR) { const int n = q >> 5, kc = q & 31, jp = n >> 4, cp = n & 15, j = kc >> 1, c0 = 8 * (kc & 1);
        const int tf = jp - j < 0 ? 0 : jp - j, tb = j - jp < 0 ? 0 : j - jp; const float mf = j <= jp ? 1.0f : 0.0f, mb = j >= jp ? 1.0f : 0.0f;
        const LAS f32x4* kf = (const LAS f32x4*)(KT + ((0 * 16 + tf) * 16 + cp) * 16 + c0); const LAS f32x4* kb = (const LAS f32x4*)(KT + ((1 * 16 + tb) * 16 + cp) * 16 + c0);
        f32x4 v0 = kf[0] * mf + kb[0] * mb, v1 = kf[1] * mf + kb[1] * mb;
        if (j == jp && (cp >> 3) == (kc & 1)) { const float dv = DSK[cp]; const int x = cp & 7;
            if (x < 4) v0[x] += dv; else v1[x - 4] += dv; }
        v4u o; o.x = pk2(v0[0], v0[1]); o.y = pk2(v0[2], v0[3]); o.z = pk2(v1[0], v1[1]); o.w = pk2(v1[2], v1[3]);
        *(GAS v4u*)(W2 + (size_t)n * 512 + 256 + 8 * kc) = o; }
    if (F.tid < 128) { const int d = F.tid >> 6, p = F.tid & 63; float* A16 = (float*)(F.ws + WS_A16) + ((size_t)(d * NG + g) * 64 + p) * 2;
        A16[0] = APR[(d * 17 + 16) * AP + p]; A16[1] = API[(d * 17 + 16) * AP + p]; }
    __syncthreads();
}

__device__ __forceinline__ void p0_s5_tables(Frame& F, int ia, int nA) { for (int g = ia; g < NG; g += nA) p0_s5_item(F, g); }
__device__ __forceinline__ void p0_roleA(Frame& F, int ia, int nA) {
    { LAS float* cond = (LAS float*)(F.lds);
      for (int i = F.tid; i < 3 * DM; i += NTHR) { const float x = i < 2 * DM ? F.inp(I_C)[i] : F.inp(I_CCTX)[i - 2 * DM]; cond[i] = x * sigm(x); }
      __syncthreads();
      for (int it = ia; it < 768; it += nA) p0_ada_item(F, it); }
    __syncthreads();
}
__device__ __forceinline__ TrItem tr_decode(Frame& F, int part, int it) {
    constexpr int I_G = (DM / 64) * (2 * DM / 64), I_D = (DFF / 64) * (DM / 64), I_P = (512 / 64) * (512 / 64);
    TrItem d;
    if (part == 0) { int r = it;
        if (r < I_G) { d.W = F.inp(I_GLUW); d.WT = (bf16*)(F.ws + WS_WGLU); d.K = DM; d.N = 2 * DM; d.mode = 1; d.item = r; return d; } r -= I_G;
        if (r < I_D) { d.W = F.inp(I_DOWN); d.WT = (bf16*)(F.ws + WS_WDN); d.K = DFF; d.N = DM; d.mode = 0; d.item = r; return d; } r -= I_D;
        const int gi = r / I_P; d.W = F.inp(I_POOLW) + (size_t)gi * 512 * 512; d.WT = (bf16*)(F.ws + WS_WPOOL) + (size_t)gi * 512 * 512; d.K = 512; d.N = 512; d.mode = 0; d.item = r % I_P; return d;
    }
    d.W = F.inp(I_DOWN) + (size_t)DFF * DM; d.WT = (bf16*)(F.ws + WS_WDN) + (size_t)DM * DFF; d.K = DFF; d.N = DM; d.mode = 0; d.item = it; return d;
}
constexpr int TR_I_G = (DM / 64) * (2 * DM / 64), TR_I_D = (DFF / 64) * (DM / 64), TR_I_P = (512 / 64) * (512 / 64);
__device__ __forceinline__ void p0_roleB(Frame& F, int part, int wi, int nw, int lo = 0, int hi = -1) {
    LAS unsigned* scr = (LAS unsigned*)(F.lds + F.wave * 16384);
    const int nit = hi >= 0 ? hi : (part == 0 ? TR_I_G + TR_I_D + 4 * TR_I_P : TR_I_D);
    float va[64], vb[64];
    int it = lo + wi;
    if (it < nit) { TrItem da = tr_decode(F, part, it); tr_load(da, F.lane, va);
        for (;;) {
            const int itb = it + nw; TrItem db = da; const bool hb = itb < nit;
            if (hb) { db = tr_decode(F, part, itb); tr_load(db, F.lane, vb); }
            tr_finish(da, F.lane, va, scr);
            if (!hb) break;
            const int ita = itb + nw; const bool ha = ita < nit;
            if (ha) { da = tr_decode(F, part, ita); tr_load(da, F.lane, va); }
            tr_finish(db, F.lane, vb, scr);
            if (!ha) break;
            it = ita;
        }
    }
    LDS_WAIT(); __syncthreads();
}
__device__ __forceinline__ void flag_arrive(unsigned* word) {
    VM_WAIT(); __syncthreads();
    if (threadIdx.x == 0) { __builtin_amdgcn_fence(__ATOMIC_RELEASE, "agent"); asm volatile("s_waitcnt vmcnt(0)" ::: "memory"); (void)xb_add(word, 1u); }
}
__device__ __forceinline__ void flag_wait(unsigned* word, unsigned expect, unsigned* tmo) {
    if (threadIdx.x == 0) { unsigned sp = 0;
        while (xb_ld(word) < expect) { __builtin_amdgcn_s_sleep(2); if ((++sp & 255u) == 0u) { if (xb_ld(tmo)) break; if (sp > (1u << 22)) { atomicAdd(tmo, 1u); break; } } }
        __builtin_amdgcn_fence(__ATOMIC_ACQUIRE, "agent"); asm volatile("s_waitcnt vmcnt(0)" ::: "memory"); }
    __syncthreads();
}

__device__ __forceinline__ void wqd_item(Frame& F, int l, int item) {
    const float* W = F.inp(I_UP) + (size_t)l * DM * DFF2; unsigned char* Q = F.ws + WS_WUP8 + (size_t)l * DFF2 * DM; float* SW = (float*)(F.ws + WS_SW) + l * DFF2;
    LAS float* red = (LAS float*)(F.lds);
    const int n4 = F.tid & 7, kq = F.tid >> 3, n0 = item * 32 + 4 * n4;
    const float* src = W + (size_t)(8 * kq) * DFF2 + n0;
    f32x4 v[4][2][4];
#pragma unroll
    for (int i = 0; i < 4; ++i)
#pragma unroll
        for (int kk = 0; kk < 2; ++kk)
#pragma unroll
            for (int e = 0; e < 4; ++e) v[i][kk][e] = *(const GAS f32x4*)(src + (size_t)(512 * i + 4 * kk + e) * DFF2);
#pragma unroll
    for (int i = 0; i < 4; ++i)
#pragma unroll
        for (int kk = 0; kk < 2; ++kk) { const f32x4 p0 = v[i][kk][0] + v[i][kk][1], p1 = v[i][kk][0] - v[i][kk][1], p2 = v[i][kk][2] + v[i][kk][3], p3 = v[i][kk][2] - v[i][kk][3];
            v[i][kk][0] = p0 + p2; v[i][kk][1] = p1 + p3; v[i][kk][2] = p0 - p2; v[i][kk][3] = p1 - p3; }
#pragma unroll
    for (int st = 1; st < 4; st <<= 1)
#pragma unroll
        for (int i = 0; i < 4; ++i) if (!(i & st))
#pragma unroll
            for (int kk = 0; kk < 2; ++kk)
#pragma unroll
                for (int e = 0; e < 4; ++e) { const f32x4 a2 = v[i][kk][e], b2 = v[i + st][kk][e]; v[i][kk][e] = a2 + b2; v[i + st][kk][e] = a2 - b2; }
    f32x4 am = {0.f, 0.f, 0.f, 0.f};
#pragma unroll
    for (int i = 0; i < 4; ++i)
#pragma unroll
        for (int kk = 0; kk < 2; ++kk)
#pragma unroll
            for (int e = 0; e < 4; ++e)
#pragma unroll
                for (int c = 0; c < 4; ++c) am[c] = fmaxf(am[c], fabsf(v[i][kk][e][c]));
#pragma unroll
    for (int c = 0; c < 4; ++c) { float x = am[c];
        x = fmaxf(x, __builtin_bit_cast(float, __builtin_amdgcn_update_dpp(0, __builtin_bit_cast(int, x), 0x128, 0xF, 0xF, false)));
        x = fmaxf(x, __builtin_bit_cast(float, __builtin_amdgcn_ds_bpermute((F.lane ^ 16) << 2, __builtin_bit_cast(int, x))));
        x = fmaxf(x, __builtin_bit_cast(float, __builtin_amdgcn_ds_bpermute((F.lane ^ 32) << 2, __builtin_bit_cast(int, x))));
        am[c] = x; }
    if (F.lane < 8) *(LAS f32x4*)(red + F.wave * 32 + 4 * n4) = am;
    __syncthreads();
#pragma unroll
    for (int w = 0; w < 8; ++w) { const f32x4 o = *(const LAS f32x4*)(red + w * 32 + 4 * n4);
#pragma unroll
        for (int c = 0; c < 4; ++c) am[c] = fmaxf(am[c], o[c]); }
    const int r0 = n0 < DFF ? 256 * (n0 >> 7) + (n0 & 127) : 256 * ((n0 - DFF) >> 7) + 128 + ((n0 - DFF) & 127);
    unsigned char* dst = Q + (size_t)r0 * DM + 8 * kq;
#pragma unroll
    for (int c = 0; c < 4; ++c) { const float inv = am[c] > 0.f ? 127.0f / am[c] : 0.f;
#pragma unroll
        for (int i = 0; i < 4; ++i) { v2u o; o.x = q8x4((f32x4){v[i][0][0][c], v[i][0][1][c], v[i][0][2][c], v[i][0][3][c]}, inv); o.y = q8x4((f32x4){v[i][1][0][c], v[i][1][1][c], v[i][1][2][c], v[i][1][3][c]}, inv);
            *(GAS v2u*)(dst + (size_t)c * DM + 512 * i) = o; } }
    if (kq == 0) *(GAS f32x4*)(SW + r0) = am * (1.0f / (127.0f * 16.0f));
    __syncthreads();
}
__device__ __forceinline__ void wqd_rows(Frame& F, int l, int idx, int n) { for (int it = idx; it < DFF2 / 32; it += n) { asm volatile("" : "+s"(it)); wqd_item(F, l, it); } }
__device__ __forceinline__ void load_mod(Frame& F, int l, int v, int q, LAS float* dst) {
    *(LAS f32x4*)(dst + 4 * F.tid) = *(const GAS f32x4*)((const float*)(F.ws + WS_FMOD) + (size_t)(l * 3 + v) * NMODC + q * DM + 4 * F.tid);
}
__device__ __forceinline__ void mod_finalize(Frame& F, int idx, int n) {
    const float* MODP = (const float*)(F.ws + WS_MODP); float* FM = (float*)(F.ws + WS_FMOD);
    for (int o = idx * NTHR + F.tid; o < 2 * 3 * (NMODC / 4); o += n * NTHR) { const int lv = o / (NMODC / 4), col = (o % (NMODC / 4)) * 4, l = lv / 3, v = lv % 3;
        f32x4 sum = *(const GAS f32x4*)(F.inp(I_ADAB) + l * NMODC + col);
#pragma unroll
        for (int sl = 0; sl < 8; ++sl) sum += *(const GAS f32x4*)(MODP + ((size_t)(l * 8 + sl) * 3 + v) * NMODC + col);
        *(GAS f32x4*)(FM + (size_t)lv * NMODC + col) = sum; }
}

constexpr int STG_PITCH = 4112;
__device__ __forceinline__ void p1_rows(Frame& F) {
    LAS float* shiftL = (LAS float*)(F.lds + 98304);
    LAS float* scaleL = shiftL + 2048;
    LAS unsigned char* stg = F.lds;
    const float* g0 = F.inp(I_NORMG);
    int cur_vec = -1;
    for (int ui = F.vcu; ui < F.nb * 272; ui += F.G) {
        const int b = F.b0 + ui / 272, r272 = ui % 272; const bool is_ctx = r272 >= 256; const int blk = is_ctx ? r272 - 256 : r272;
        const int vec = is_ctx ? 2 : b;
        if (vec != cur_vec) { __syncthreads(); load_mod(F, 0, vec, 0, shiftL); load_mod(F, 0, vec, 1, scaleL); cur_vec = vec; }
        __syncthreads();
#pragma unroll 1
        for (int rr = 0; rr < 2; ++rr) { const int row = F.wave + 8 * rr, t = blk * 16 + row;
            const float* src = is_ctx ? F.inp(I_CTX) + ((size_t)(b * CTX + t)) * DM : F.inp(I_X) + ((size_t)(b * SEQ + t)) * DM;
            f32x4 v[8]; float ss = 0.f;
#pragma unroll
            for (int j = 0; j < 8; ++j) { v[j] = *(const GAS f32x4*)(src + 4 * F.lane + 256 * j); }
            if (!is_ctx) { const float prow = (float)(t >> 6), pcol = (float)(t & 63);
#pragma unroll
                for (int j = 0; j < 8; ++j) { const float pos = j < 4 ? prow : pcol; const bool is_cos = (j & 2) != 0;
#pragma unroll
                    for (int e = 0; e < 4; ++e) { const int i = (4 * F.lane + 256 * j + e) & 511;
                        const float omega = __builtin_amdgcn_exp2f(-(float)i * (13.287712379549449f / 512.0f));
                        const float rev = pos * omega * 0.15915494309189535f;
                        v[j][e] += is_cos ? __builtin_amdgcn_cosf(rev) : __builtin_amdgcn_sinf(rev); } }
                float* dst = F.out + ((size_t)(b * SEQ + t)) * DM;
#pragma unroll
                for (int j = 0; j < 8; ++j) *(GAS f32x4*)(dst + 4 * F.lane + 256 * j) = v[j]; }
#pragma unroll
            for (int j = 0; j < 8; ++j) ss += (v[j][0] * v[j][0] + v[j][1] * v[j][1]) + (v[j][2] * v[j][2] + v[j][3] * v[j][3]);
            const float rstd = 1.0f / sqrtf(wave_sum(ss) * (1.0f / DM) + RMS_EPS);
#pragma unroll
            for (int j = 0; j < 8; ++j) { const int col = 4 * F.lane + 256 * j; const f32x4 gg = *(const GAS f32x4*)(g0 + col), sc = *(LAS f32x4*)(scaleL + col), sh = *(LAS f32x4*)(shiftL + col);
                const f32x4 u = (v[j] * rstd * gg) * (sc + 1.0f) + sh;
                v2u w; w.x = pk2(u[0], u[1]); w.y = pk2(u[2], u[3]);
                *(LAS v2u*)(stg + row * STG_PITCH + col * 2) = w; } }
        __syncthreads();
        for (int q = F.tid; q < 4096; q += NTHR) { const int g = q >> 5, jh = q & 31, j = jh >> 1, h = jh & 1;
            const v4u w = *(LAS v4u*)(stg + j * STG_PITCH + g * 32 + h * 16);
            bf16* dst = is_ctx ? (bf16*)(F.ws + WS_UCG) + ((size_t)g * 32 + b * 16 + blk) * 256 + jh * 8
                               : (bf16*)(F.ws + WS_A2) + ((size_t)g * 512 + b * 256 + blk) * 512 + 256 + jh * 8;
            *(GAS v4u*)dst = w; }
    }
    __syncthreads();
}

__device__ __forceinline__ void s5_ctx_carry(Frame& F, int g, int b) {
    const bf16* A = (const bf16*)(F.ws + WS_UCG) + ((size_t)g * 32 + b * 16) * 256; const bf16* Bt = (const bf16*)(F.ws + WS_WIN) + (size_t)g * 256 * 256;
    LAS float* CT = (LAS float*)(F.lds); LAS float* xc = (LAS float*)(F.lds + XCH_OFF);
    const int r = F.lane & 15, q = F.lane >> 4; f32x4 c0 = {0.f, 0.f, 0.f, 0.f}, c1 = c0;
#pragma unroll
    for (int ks = 0; ks < 8; ++ks) { const bf16x8 a = *(const GAS bf16x8*)(A + r * 256 + ks * 32 + 8 * q);
        const bf16x8 b0 = *(const GAS bf16x8*)(Bt + (size_t)(32 * F.wave + r) * 256 + ks * 32 + 8 * q), b1 = *(const GAS bf16x8*)(Bt + (size_t)(32 * F.wave + 16 + r) * 256 + ks * 32 + 8 * q);
        c0 = __builtin_amdgcn_mfma_f32_16x16x32_bf16(a, b0, c0, 0, 0, 0); c1 = __builtin_amdgcn_mfma_f32_16x16x32_bf16(a, b1, c1, 0, 0, 0); }
#pragma unroll
    for (int i = 0; i < 4; ++i) { CT[(4 * q + i) * 256 + 32 * F.wave + r] = c0[i]; CT[(4 * q + i) * 256 + 32 * F.wave + 16 + r] = c1[i]; }
    __syncthreads();
    if (F.tid < 128) { const int d = F.tid >> 6, p = F.tid & 63; const float* a16 = (const float*)(F.ws + WS_A16) + ((size_t)(d * NG + g) * 64 + p) * 2; const float ar = a16[0], ai = a16[1];
        float cr = 0.f, ci = 0.f;
#pragma unroll
        for (int k = 0; k < 16; ++k) { const int row = d == 0 ? k : 15 - k; const float xr = CT[row * 256 + d * 128 + p], xi = CT[row * 256 + d * 128 + 64 + p];
            const float nr = ar * cr - ai * ci + xr, ni = ar * ci + ai * cr + xi; cr = nr; ci = ni; }
        xc[1024 + (d * 64 + p) * 2] = cr; xc[1024 + (d * 64 + p) * 2 + 1] = ci; }
    __syncthreads();
}

template <bool SECOND, bool U8OUT>
__device__ __forceinline__ void row_tail(Frame& F, int row, f32x4 (&y)[8], const f32x4 (&x)[8], LAS float* GGL, LAS float* SCL, LAS float* SHL) {
    float ss = 0.f;
#pragma unroll
    for (int j = 0; j < 8; ++j) ss += (y[j][0] * y[j][0] + y[j][1] * y[j][1]) + (y[j][2] * y[j][2] + y[j][3] * y[j][3]);
    const float ry = 1.0f / sqrtf(wave_sum(ss) * (1.0f / DM) + RMS_EPS);
    float* xrow = F.out + (size_t)row * DM; float s2 = 0.f;
#pragma unroll
    for (int j = 0; j < 8; ++j) { const int col = 4 * F.lane + 256 * j; const f32x4 gg = *(LAS f32x4*)(GGL + col);
        y[j] = x[j] + (y[j] * ry) * gg;
        *(GAS f32x4*)(xrow + col) = y[j];
        s2 += (y[j][0] * y[j][0] + y[j][1] * y[j][1]) + (y[j][2] * y[j][2] + y[j][3] * y[j][3]); }
    if (SECOND) { const float rx = 1.0f / sqrtf(wave_sum(s2) * (1.0f / DM) + RMS_EPS);
        if (U8OUT) {
            float am = 0.f;
#pragma unroll
            for (int j = 0; j < 8; ++j) { const int col = 4 * F.lane + 256 * j; const f32x4 sc = *(LAS f32x4*)(SCL + col), sh = *(LAS f32x4*)(SHL + col);
                y[j] = (y[j] * rx) * sc + sh; }
#pragma unroll
            for (int j = 0; j < 8; ++j) { const f32x4 t = y[j]; const float p0 = t[0] + t[1], p1 = t[0] - t[1], p2 = t[2] + t[3], p3 = t[2] - t[3]; y[j] = (f32x4){p0 + p2, p1 + p3, p0 - p2, p1 - p3}; }
#pragma unroll
            for (int st = 2; st < 8; st <<= 1)
#pragma unroll
                for (int j = 0; j < 8; ++j) if (!(j & st)) { const f32x4 a = y[j], b = y[j + st]; y[j] = a + b; y[j + st] = a - b; }
#pragma unroll
            for (int j = 0; j < 8; ++j) am = fmaxf(am, fmaxf(fmaxf(fabsf(y[j][0]), fabsf(y[j][1])), fmaxf(fabsf(y[j][2]), fabsf(y[j][3]))));
            am = wave_max(am); const float inv = am > 0.f ? 127.0f / am : 0.f;
            unsigned char* U8 = F.ws + WS_U8 + (size_t)row * DM;
#pragma unroll
            for (int j = 0; j < 8; ++j) *(GAS unsigned*)(U8 + 4 * F.lane + 256 * j) = q8x4(y[j], inv);
            if (F.lane == 0) ((float*)(F.ws + WS_SU))[row] = am * (1.0f / 127.0f);
        } else { bf16* U = (bf16*)(F.ws + WS_UZ);
#pragma unroll
            for (int j = 0; j < 8; ++j) { const int col = 4 * F.lane + 256 * j; const f32x4 sc = *(LAS f32x4*)(SCL + col), sh = *(LAS f32x4*)(SHL + col);
                const f32x4 u = (y[j] * rx) * sc + sh; v2u w; w.x = pk2(u[0], u[1]); w.y = pk2(u[2], u[3]);
                *(GAS v2u*)(U + (size_t)row * DM + col) = w; } } }
}
template <int YMODE, bool SECOND, bool U8OUT = false>
__device__ __forceinline__ void row_phase(Frame& F, int l_gate, int q_gate, int ga_idx, int l_mod, int q_shift, int q_scale, int gb_idx) {
    LAS float* gateL = (LAS float*)(F.lds);
    LAS float* shiftL = gateL + 2048;
    LAS float* scaleL = shiftL + 2048;
    LAS unsigned char* stg = F.lds + 32768;
    const bf16* Y = (const bf16*)(F.ws + WS_YF);
    const float* ga = F.inp(I_NORMG) + ga_idx * DM; const float* gb = F.inp(I_NORMG) + gb_idx * DM;
    int cur_b = -1;
    for (int rgi = F.vcu; rgi < F.nb * (SEQ / 32); rgi += F.G) { const int rg = F.b0 * (SEQ / 32) + rgi, b = rg / (SEQ / 32);
        if (b != cur_b) { __syncthreads(); load_mod(F, l_gate, b, q_gate, gateL); if (SECOND) { load_mod(F, l_mod, b, q_shift, shiftL); load_mod(F, l_mod, b, q_scale, scaleL); }
            { const f32x4 a4 = *(const GAS f32x4*)(ga + 4 * F.tid); *(LAS f32x4*)(gateL + 4 * F.tid) = *(LAS f32x4*)(gateL + 4 * F.tid) * a4;
              if (SECOND) { const f32x4 b4 = *(const GAS f32x4*)(gb + 4 * F.tid); *(LAS f32x4*)(scaleL + 4 * F.tid) = (*(LAS f32x4*)(scaleL + 4 * F.tid) + 1.0f) * b4; } }
            cur_b = b; __syncthreads(); }
        if (YMODE == 0) {
#pragma unroll 1
            for (int pr = 0; pr < 2; ++pr) { const int rowA = rg * 32 + F.wave * 4 + 2 * pr, rowB = rowA + 1;
                v2u wa[8], wb[8]; f32x4 xa[8], xb[8];
#pragma unroll
                for (int j = 0; j < 8; ++j) { wa[j] = *(const GAS v2u*)(Y + (size_t)rowA * DM + 4 * F.lane + 256 * j); wb[j] = *(const GAS v2u*)(Y + (size_t)rowB * DM + 4 * F.lane + 256 * j); }
#pragma unroll
                for (int j = 0; j < 8; ++j) { xa[j] = *(const GAS f32x4*)(F.out + (size_t)rowA * DM + 4 * F.lane + 256 * j); xb[j] = *(const GAS f32x4*)(F.out + (size_t)rowB * DM + 4 * F.lane + 256 * j); }
                f32x4 y[8];
#pragma unroll
                for (int j = 0; j < 8; ++j) y[j] = (f32x4){bf_lo(wa[j].x), bf_hi(wa[j].x), bf_lo(wa[j].y), bf_hi(wa[j].y)};
                row_tail<SECOND, U8OUT>(F, rowA, y, xa, gateL, scaleL, shiftL);
                asm volatile("" ::: "memory");
#pragma unroll
                for (int j = 0; j < 8; ++j) y[j] = (f32x4){bf_lo(wb[j].x), bf_hi(wb[j].x), bf_lo(wb[j].y), bf_hi(wb[j].y)};
                row_tail<SECOND, U8OUT>(F, rowB, y, xb, gateL, scaleL, shiftL); }
        } else {
#pragma unroll 1
            for (int half = 0; half < 2; ++half) { const int r0 = rg * 32 + half * 16, t0 = r0 & (SEQ - 1);
                __syncthreads();
                const int lrA = F.wave * 2, rowA = r0 + lrA, rowB = rowA + 1;
                {
                    const int hw = 1 << (F.wave >> 1); const bf16* Yb = Y + (size_t)(r0 - t0) * DM + 4 * F.tid;
                    const f32x4 ps = *(const GAS f32x4*)(F.inp(I_POOLS) + 4 * F.tid);
#define LDV(trow) ({ const int _t = (trow); const bool _ok = _t >= 0 && _t < SEQ; const v2u _w = *(const GAS v2u*)(Yb + (size_t)(_ok ? _t : t0) * DM); const float _m = _ok ? 1.0f : 0.0f; \
                      (f32x4){bf_lo(_w.x) * _m, bf_hi(_w.x) * _m, bf_lo(_w.y) * _m, bf_hi(_w.y) * _m}; })
                    f32x4 s = {0.f, 0.f, 0.f, 0.f};
#pragma unroll 2
                    for (int o = -hw; o < hw; ++o) s += LDV(t0 + o);
#pragma unroll 4
                    for (int i = 0; i < 16; ++i) { const int t = t0 + i; const f32x4 self = LDV(t);
                        const int lo = t - hw < 0 ? 0 : t - hw, hi = t + hw - 1 > SEQ - 1 ? SEQ - 1 : t + hw - 1;
                        const f32x4 yv = (s * (1.0f / (float)(hi - lo + 1)) - self) * ps;
                        v2u w; w.x = pk2(yv[0], yv[1]); w.y = pk2(yv[2], yv[3]);
                        *(LAS v2u*)(stg + i * STG_PITCH + 8 * F.tid) = w;
                        s += LDV(t + hw) - LDV(t - hw); }
#undef LDV
                }
                __syncthreads();
                f32x4 xa[8], xb[8];
#pragma unroll
                for (int j = 0; j < 8; ++j) { xa[j] = *(const GAS f32x4*)(F.out + (size_t)rowA * DM + 4 * F.lane + 256 * j); xb[j] = *(const GAS f32x4*)(F.out + (size_t)rowB * DM + 4 * F.lane + 256 * j); }
                f32x4 y[8];
#pragma unroll
                for (int j = 0; j < 8; ++j) { const v2u w = *(LAS v2u*)(stg + lrA * STG_PITCH + 8 * F.lane + 512 * j); y[j] = (f32x4){bf_lo(w.x), bf_hi(w.x), bf_lo(w.y), bf_hi(w.y)}; }
                row_tail<SECOND, U8OUT>(F, rowA, y, xa, gateL, scaleL, shiftL);
#pragma unroll
                for (int j = 0; j < 8; ++j) { const v2u w = *(LAS v2u*)(stg + (lrA + 1) * STG_PITCH + 8 * F.lane + 512 * j); y[j] = (f32x4){bf_lo(w.x), bf_hi(w.x), bf_lo(w.y), bf_hi(w.y)}; }
                row_tail<SECOND, U8OUT>(F, rowB, y, xb, gateL, scaleL, shiftL);
            }
        }
    }
    __syncthreads();
}

__device__ __forceinline__ void conv_fixup(Frame& F, int l, int pm) {
    const float* cw = F.inp(I_CONV) + (size_t)l * 3 * DFF2; const float* PRE = (const float*)(F.ws + WS_PRE); const float* RAW = (const float*)(F.ws + WS_RAW); bf16* ACT = (bf16*)(F.ws + WS_ACT);
    for (int q = F.tid; q < 2 * (DFF / 4); q += NTHR) { const int e = q / (DFF / 4), f = (q % (DFF / 4)) * 4;
        const bool nbok = e == 0 ? (pm & 15) != 0 : (pm & 15) != 15; const int pmn = e == 0 ? pm - 1 : pm + 1, tap = e == 0 ? 0 : 2;
        f32x4 v = *(const GAS f32x4*)(PRE + ((size_t)(pm * 2 + e) * 2) * DFF + f), g = *(const GAS f32x4*)(PRE + ((size_t)(pm * 2 + e) * 2 + 1) * DFF + f);
        if (nbok) { const f32x4 rv = *(const GAS f32x4*)(RAW + ((size_t)(pmn * 2 + (1 - e)) * 2) * DFF + f), rg = *(const GAS f32x4*)(RAW + ((size_t)(pmn * 2 + (1 - e)) * 2 + 1) * DFF + f);
            const f32x4 kv = *(const GAS f32x4*)(cw + tap * DFF2 + f), kg = *(const GAS f32x4*)(cw + tap * DFF2 + DFF + f); v += kv * rv; g += kg * rg; }
        v2u w; w.x = pk2(g[0] * sigm(g[0]) * v[0], g[1] * sigm(g[1]) * v[1]); w.y = pk2(g[2] * sigm(g[2]) * v[2], g[3] * sigm(g[3]) * v[3]);
        *(GAS v2u*)(ACT + (size_t)(pm * 256 + (e ? 255 : 0)) * DFF + f) = w; }
}

constexpr int CW_TMO = 0, CW_XT = 256, CW_GT = 256 + 64 * 16, CW_FLAG = 256 + 64 * 20;
constexpr int CW_PCNT = 16384;
constexpr int CW_BAR = 4096;
static_assert(CW_BAR + 3 * XCD_BAR_WORDS <= CW_PCNT && (CW_PCNT + 3 * 2048) * 4 <= (int)CTL_ZERO_BYTES, "CTL words inside the memset region");
#ifndef DELAY_MASK
#define DELAY_MASK 0
#endif
#ifndef DELAY_GRP
#define DELAY_GRP 3
#endif
__global__ void __launch_bounds__(NTHR, 2) fwd_kernel(Args args) {
    extern __shared__ __attribute__((aligned(16))) unsigned char lds[];
    Frame F;
    F.lds = (LAS unsigned char*)lds;
    F.tid = threadIdx.x; F.lane = F.tid & 63; F.wave = __builtin_amdgcn_readfirstlane(F.tid >> 6);
    F.out = args.out; F.ws = args.ws;
    volatile LAS unsigned* MISC = (volatile LAS unsigned*)(F.lds + MISC_OFF);
    for (int u = F.tid; u < (LDS_BYTES - LDSCTL_OFF) / 4; u += NTHR) ((LAS unsigned*)(F.lds + LDSCTL_OFF))[u] = 0u;
    __syncthreads();
    if (F.tid < 22) *(const float* LAS*)(F.lds + PTR_OFF + 8 * F.tid) = args.in[F.tid];
    unsigned* ctl = (unsigned*)(F.ws + WS_CTL);
    const unsigned G = gridDim.x, xcc = xb_xcc_id(), grp = (xcc >> 2) & 1u;
    if (F.tid == 0) { MISC[12] = xb_add(&ctl[CW_XT + 64 * xcc], 1u); MISC[13] = xb_add(&ctl[CW_GT + 64 * grp], 1u); }
    __syncthreads();
    { XcdBarrier barG = xcd_barrier_post(ctl + CW_BAR, MISC + 8, G); xcd_barrier(barG); }
    const unsigned n0 = (unsigned)__builtin_amdgcn_readfirstlane((int)xb_ld(&ctl[CW_GT])), n1 = (unsigned)__builtin_amdgcn_readfirstlane((int)xb_ld(&ctl[CW_GT + 64]));
    bool balanced = (G % 8u) == 0u && n0 == n1;
#pragma unroll
    for (int j = 0; j < 8; ++j) balanced = balanced && ((unsigned)__builtin_amdgcn_readfirstlane((int)xb_ld(&ctl[CW_XT + 64 * j])) == G / 8u);
    const bool two = n0 > 0u && n1 > 0u;
    const unsigned lt = (unsigned)__builtin_amdgcn_readfirstlane((int)MISC[12]), gt = (unsigned)__builtin_amdgcn_readfirstlane((int)MISC[13]);
    int nx;
    if (two) { F.b0 = (int)grp; F.nb = 1; F.G = (int)(grp ? n1 : n0); if (balanced) { F.vcu = (int)(lt * 4u + (xcc & 3u)); nx = 4; } else { F.vcu = (int)gt; nx = 1; } }
    else { F.b0 = 0; F.nb = NBATCH; F.G = (int)G; F.vcu = (int)(grp ? n0 + gt : gt); nx = 1; }
    F.vcu = __builtin_amdgcn_readfirstlane(F.vcu); F.G = __builtin_amdgcn_readfirstlane(F.G); F.b0 = __builtin_amdgcn_readfirstlane(F.b0); F.nb = __builtin_amdgcn_readfirstlane(F.nb);
    int mode = __builtin_amdgcn_readfirstlane((two ? 1 : 0) | (int)(grp << 1) | (nx << 2));
    (void)xcd_barrier_post(ctl + CW_BAR + (1 + (two ? grp : 0u)) * XCD_BAR_WORDS, MISC + 10, (unsigned)F.G);
    LAS unsigned char* ring = F.lds + RING_OFF;
#define TWO ((mode & 1) != 0)
#define ROLE_A (!(mode & 1) || !(mode & 2))
#define ROLE_B (!(mode & 1) || (mode & 2))
#define NX (mode >> 2)
#define CTL ((unsigned*)(F.ws + WS_CTL))
#define N_GRP(gi) ((unsigned)__builtin_amdgcn_readfirstlane((int)xb_ld(&CTL[CW_GT + 64 * (gi)])))
#define FENCE() do { asm volatile("" : "+v"(F.tid)); F.lane = F.tid & 63; { int _w = F.tid >> 6; asm volatile("" : "+v"(_w)); F.wave = __builtin_amdgcn_readfirstlane(_w); } \
        asm volatile("" : "+s"(F.vcu), "+s"(F.G), "+s"(F.b0), "+s"(F.nb), "+s"(F.ws), "+s"(F.out), "+s"(F.lds), "+s"(mode)); ring = F.lds + RING_OFF; } while (0)
#if DELAY_MASK
#define PH_T0() const unsigned long long _t0 = __builtin_amdgcn_s_memrealtime()
#define PH_DELAY(k) do { if ((((DELAY_MASK) >> (k)) & 1) && (((DELAY_GRP) >> F.b0) & 1)) { asm volatile("s_waitcnt vmcnt(0)" ::: "memory"); __syncthreads(); const unsigned long long _t1 = __builtin_amdgcn_s_memrealtime(); \
        while (__builtin_amdgcn_s_memrealtime() - _t1 < 4ull * (_t1 - _t0)) __builtin_amdgcn_s_sleep(8); __syncthreads(); } } while (0)
#else
#define PH_T0() do {} while (0)
#define PH_DELAY(k) do {} while (0)
#endif
#define SEAM() do { XcdBarrier _b; _b.bar = CTL + CW_BAR + (1 + (TWO ? ((mode >> 1) & 1) : 0)) * XCD_BAR_WORDS; _b.x = xb_xcc_id(); _b.st = (volatile LAS unsigned*)(F.lds + MISC_OFF) + 10; _b.expect = (unsigned)F.G; xcd_barrier(_b); FENCE(); } while (0)
    FENCE();

    { PH_T0();
      if (ROLE_A) { p0_roleA(F, F.vcu, F.G); }
      if (ROLE_B) { p0_s5_tables(F, F.vcu, F.G); if (TWO) flag_arrive(&CTL[CW_FLAG + 192]);
                    wqd_rows(F, 0, F.vcu, F.G); FENCE(); }
      { constexpr int D3 = TR_I_G; const int lo = ROLE_B ? 0 : D3, hi = ROLE_A ? -1 : D3;
        p0_roleB(F, 0, F.vcu * NWAVES + F.wave, F.G * NWAVES, lo, hi); }
      if (TWO && NX != 4 && ROLE_B) { FENCE(); wqd_rows(F, 1, F.vcu, F.G); p0_roleB(F, 1, F.vcu * NWAVES + F.wave, F.G * NWAVES); }
      PH_DELAY(0); }
    SEAM();
    if (ROLE_A) { mod_finalize(F, F.vcu, F.G); if (TWO) flag_arrive(&CTL[CW_FLAG]); }
    if (ROLE_B && TWO) { flag_arrive(&CTL[CW_FLAG + 64]); if (NX != 4) flag_arrive(&CTL[CW_FLAG + 128]); }
    if (TWO && !ROLE_A) flag_wait(&CTL[CW_FLAG], N_GRP(0), &CTL[CW_TMO]);
    SEAM();
    { PH_T0(); p1_rows(F); PH_DELAY(1); }
    if (TWO && !ROLE_B) flag_wait(&CTL[CW_FLAG + 192], N_GRP(1), &CTL[CW_TMO]);
    SEAM();
    { PH_T0();
        for (int it = F.vcu; it < F.nb * NG; it += F.G) { FENCE(); asm volatile("" : "+s"(it)); const int gi = it / F.nb, b = F.b0 + it % F.nb;
            s5_ctx_carry(F, gi, b);
            { pg8::Gemm g{(const pg8::bf16_t*)(F.ws + WS_A2) + 256, (const pg8::bf16_t*)(F.ws + WS_WIN), 512, 256, 256, (size_t)512 * 512, (size_t)256 * 256};
              pg8::OneUnit S; S.u.pm = b; S.u.pn = 0; S.u.g = gi;
              pg8::EpiScan E{(const float*)(F.ws + WS_A16), (pg8::bf16_t*)(F.ws + WS_A2), (PG8_LAS float*)(F.lds + XCH_OFF)};
              pg8::gemm_phase<pg8::EpiScan, pg8::OneUnit, false, true>(ring, g, S, E, F.tid); }
            VM_WAIT(); __syncthreads(); FENCE();
            { pg8::Gemm g{(const pg8::bf16_t*)(F.ws + WS_A2), (const pg8::bf16_t*)(F.ws + WS_W2), 512, 512, 512, (size_t)512 * 512, (size_t)256 * 512};
              pg8::OneUnit S; S.u.pm = b; S.u.pn = 0; S.u.g = gi;
              pg8::EpiGeluZ E{(pg8::bf16_t*)(F.ws + WS_UZ)};
              pg8::gemm_phase<pg8::EpiGeluZ, pg8::OneUnit, true, true>(ring, g, S, E, F.tid); }
        }
        PH_DELAY(2);
    }
    if (TWO && !ROLE_B) flag_wait(&CTL[CW_FLAG + 64], N_GRP(1), &CTL[CW_TMO]);
    SEAM();
    { PH_T0();
        pg8::Gemm g{(const pg8::bf16_t*)(F.ws + WS_UZ), (const pg8::bf16_t*)(F.ws + WS_WGLU), DM, DM, DM, 0, 0};
        pg8::StaticOrder S; S.init(F.nb * SEQ, 2 * DM, F.G, F.vcu, F.b0 * (SEQ / 256), NX);
        pg8::EpiGlu E{(pg8::bf16_t*)(F.ws + WS_YF), DM};
        pg8::gemm_phase<pg8::EpiGlu, pg8::StaticOrder, true, true>(ring, g, S, E, F.tid);
        PH_DELAY(5);
    } SEAM();
    #ifndef SKIP_P6
    { PH_T0(); row_phase<0, true, true>(F, 0, 2, 1, 0, 3, 4, 2); PH_DELAY(6); }
#endif
    SEAM();
    for (int l = 0; l < 2; ++l) {
        const int pb = l == 0 ? 7 : 13;
        if (l == 1 && TWO) { if (NX == 4) flag_wait(&CTL[CW_FLAG + 128], gridDim.x, &CTL[CW_TMO]); else if (!ROLE_B) flag_wait(&CTL[CW_FLAG + 128], N_GRP(1), &CTL[CW_TMO]); FENCE(); }
        { PH_T0();
            pg8::Gemm g{(const pg8::bf16_t*)(F.ws + WS_U8), (const pg8::bf16_t*)(F.ws + WS_WUP8) + (size_t)l * DFF2 * (DM / 2), DM / 2, DM / 2, DM / 2, 0, 0};
            pg8::StaticOrder S; S.init(F.nb * SEQ, DFF2, F.G, F.vcu, F.b0 * (SEQ / 256), NX);
            pg8::EpiConvGlu E{(pg8::bf16_t*)(F.ws + WS_ACT), F.inp_s(I_CONV) + (size_t)l * 3 * DFF2, F.inp_s(I_CONVB) + (size_t)l * DFF2, (float*)(F.ws + WS_PRE), (float*)(F.ws + WS_RAW), (PG8_LAS float*)(F.lds + XCH_OFF),
                              (const float*)(F.ws + WS_SU), (const float*)(F.ws + WS_SW) + l * DFF2};
            pg8::gemm_phase<pg8::EpiConvGlu, pg8::StaticOrder, true, true>(ring, g, S, E, F.tid);
            FENCE();
            if (!TWO || NX == 4) {
                const int nwg = F.nb * (SEQ / 256) * (DFF2 / 256), rem = nwg % F.G, nidle = rem == 0 ? F.G : F.G - rem, idx = rem == 0 ? F.vcu : F.vcu - rem;
                if (idx >= 0) { const int gsel = TWO ? ((mode >> 1) & 1) : 0, ngrp = TWO ? 2 : 1;
                    if (l == 0) wqd_rows(F, 1, gsel * nidle + idx, ngrp * nidle);
                    else p0_roleB(F, 1, (gsel * nidle + idx) * NWAVES + F.wave, ngrp * nidle * NWAVES); }
                if (TWO) flag_arrive(&CTL[CW_FLAG + (l == 0 ? 128 : 384)]);
            }
            PH_DELAY(pb);
        } SEAM();
        if (l == 1 && TWO && NX == 4) { flag_wait(&CTL[CW_FLAG + 384], gridDim.x, &CTL[CW_TMO]); FENCE(); }
        const bool fuse = F.nb * (SEQ / 256) * (DM / 256) == F.G;
        { PH_T0();
            pg8::Gemm g{(const pg8::bf16_t*)(F.ws + WS_ACT), (const pg8::bf16_t*)(F.ws + WS_WDN) + (size_t)l * DM * DFF, DFF, DFF, DFF, 0, 0};
            pg8::StaticOrder S; S.init(F.nb * SEQ, DM, F.G, F.vcu, F.b0 * (SEQ / 256), NX);
            { pg8::Unit uu; for (int i = 0; S.next(i, uu); ++i) conv_fixup(F, l, uu.pm); VM_WAIT(); __syncthreads(); }
            if (fuse) {
                if (l == 0) { pg8::EpiRms<true> E{F.out, (const float*)(F.ws + WS_FMOD), F.inp_s(I_NORMG), (pg8::bf16_t*)(F.ws + WS_UZ), (float*)(F.ws + WS_XS), CTL + CW_PCNT, CTL + CW_TMO, 0, 5, 3, 1, 0, 1, 4, 0};
                    pg8::gemm_phase<pg8::EpiRms<true>, pg8::StaticOrder, false, true>(ring, g, S, E, F.tid); }
                else { pg8::EpiRms<false> E{F.out, (const float*)(F.ws + WS_FMOD), F.inp_s(I_NORMG), (pg8::bf16_t*)(F.ws + WS_UZ), (float*)(F.ws + WS_XS), CTL + CW_PCNT, CTL + CW_TMO, 1, 5, 7, 0, 0, 0, 0, 2};
                    pg8::gemm_phase<pg8::EpiRms<false>, pg8::StaticOrder, false, true>(ring, g, S, E, F.tid); }
            } else {
                pg8::EpiBf16G E{(pg8::bf16_t*)(F.ws + WS_YF), DM, 0};
                pg8::gemm_phase<pg8::EpiBf16G, pg8::StaticOrder, true, true>(ring, g, S, E, F.tid);
            }
            PH_DELAY(pb + 2);
        }
        if (l == 0) {
            SEAM();
            if (!fuse) { { PH_T0(); row_phase<0, true>(F, 0, 5, 3, 1, 0, 1, 4); PH_DELAY(10); } SEAM(); }
            { PH_T0();
                pg8::Gemm g{(const pg8::bf16_t*)(F.ws + WS_UZ), (const pg8::bf16_t*)(F.ws + WS_WPOOL), DM, 512, 512, (size_t)512, (size_t)512 * 512};
                pg8::GroupedOrder S; S.init(4, F.nb * (SEQ / 256), 2, F.G, F.vcu, F.b0 * (SEQ / 256));
                pg8::EpiBf16G E{(pg8::bf16_t*)(F.ws + WS_YF), DM, (size_t)512};
                pg8::gemm_phase<pg8::EpiBf16G, pg8::GroupedOrder, true, true>(ring, g, S, E, F.tid);
                PH_DELAY(11);
            } SEAM();
            { PH_T0(); row_phase<1, true, true>(F, 1, 2, 5, 1, 3, 4, 6);
              PH_DELAY(12); }
            SEAM();
        } else {
            if (!fuse) { SEAM(); { PH_T0(); row_phase<0, false>(F, 1, 5, 7, 0, 0, 0, 0); PH_DELAY(16); } }
        }
    }
#undef SEAM
}

extern "C" void kernel_launch(void* const* d_in, const int* in_sizes, int n_in, void* d_out, int out_size, void* d_ws, size_t ws_size, hipStream_t stream) {
    static int grid = 0;
    if (grid == 0) {
        if (n_in != 22 || out_size != MT * DM || ws_size < WS_END) { fprintf(stderr, "kernel_launch: unexpected problem (n_in %d, out %d, ws %zu); nothing launched\n", n_in, out_size, ws_size); grid = -1; return; }
        int dev = 0, cus = 0, per_cu = 0;
        if (hipGetDevice(&dev) != hipSuccess || hipDeviceGetAttribute(&cus, hipDeviceAttributeMultiprocessorCount, dev) != hipSuccess) { grid = -1; return; }
        if (hipFuncSetAttribute((const void*)fwd_kernel, hipFuncAttributeMaxDynamicSharedMemorySize, LDS_BYTES) != hipSuccess) { fprintf(stderr, "kernel_launch: hipFuncSetAttribute failed\n"); grid = -1; return; }
        if (hipOccupancyMaxActiveBlocksPerMultiprocessor(&per_cu, (const void*)fwd_kernel, NTHR, LDS_BYTES) != hipSuccess || per_cu < 1) { fprintf(stderr, "kernel_launch: the occupancy query admits %d workgroups per CU for this kernel; nothing launched\n", per_cu); (void)hipGetLastError(); grid = -1; return; }
        (void)hipGetLastError();
        grid = cus;
    }
    if (grid < 0) return;
    if (hipMemsetAsync((char*)d_ws + WS_CTL, 0, CTL_ZERO_BYTES, stream) != hipSuccess) { fprintf(stderr, "kernel_launch: hipMemsetAsync failed\n"); return; }
    Args a{};
    for (int i = 0; i < 22; ++i) a.in[i] = (const float*)d_in[i];
    a.out = (float*)d_out; a.ws = (unsigned char*)d_ws;
    hipLaunchKernelGGL(fwd_kernel, dim3(grid), dim3(NTHR), LDS_BYTES, stream, a);
    const hipError_t le = hipPeekAtLastError();
    if (le != hipSuccess) fprintf(stderr, "kernel_launch: launch failed: %s\n", hipGetErrorName(le));
}
```

```cpp
#include <hip/hip_runtime.h>
#include <cstdio>
#include <cstdint>

#ifndef MK_N_LAUNCHES
#define MK_N_LAUNCHES 1
#endif

namespace pg8 {
#define PG8_LAS __attribute__((address_space(3)))
typedef unsigned short bf16_t;
typedef short bf16x8 __attribute__((ext_vector_type(8)));
typedef float f32x4 __attribute__((ext_vector_type(4)));
typedef float f32x16 __attribute__((ext_vector_type(16)));
typedef unsigned u32x4 __attribute__((ext_vector_type(4)));
typedef unsigned u32x2 __attribute__((ext_vector_type(2)));
typedef int i32x4 __attribute__((ext_vector_type(4)));
template <bool I8> struct AccT { typedef f32x4 T; };
template <> struct AccT<true> { typedef i32x4 T; };
constexpr int BM = 256, BK = 64, HALF = 128, HTB = HALF * BK * 2  , STAGE_BYTES = 8 * HTB, NXCD = 8, WGM = 4;

__host__ __device__ __forceinline__ int lds_byte(int r, int c) { const int st = (r >> 4) * 2 + (c >> 5), rr = r & 15, cc = c & 31, ob = rr * 64 + cc * 2; return st * 1024 + (ob ^ (((ob >> 9) & 1) << 5)); }
__host__ __device__ __forceinline__ void stage_rc(int b, int& R, int& C) { const int st = b / 1024, sb = b % 1024, swz = sb ^ (((sb >> 9) & 1) << 5); R = (st >> 1) * 16 + swz / 64; C = (st & 1) * 32 + (swz % 64) / 2; }
__host__ __device__ __forceinline__ int perm32(int rho) { const int n = rho >> 4, i = rho & 15; return 8 * (i >> 2) + 4 * n + (i & 3); }

struct Unit { int pm, pn, g; };
struct Gemm { const bf16_t* A; const bf16_t* Bt; int lda, ldb, K; size_t gsA, gsB; };

struct StaticOrder {
    int nM, nN, nwg, G, c, pm0, nx;
    __device__ __forceinline__ void init(int M, int N, int G_, int c_, int pm0_, int nx_) { nM = M / BM; nN = N / BM; nwg = nM * nN; G = G_; c = c_; pm0 = pm0_; nx = nx_; }
    __device__ __forceinline__ bool next(int i, Unit& u) const {
        const long L = (long)i * G + c; if (L >= (long)nwg) return false;
        int wgid = (int)L; { const int q = nwg / nx, r = nwg % nx, xcd = wgid % nx, off = wgid / nx; wgid = (xcd < r ? xcd * (q + 1) : r * (q + 1) + (xcd - r) * q) + off; }
        const int nig = WGM * nN, gid = wgid / nig, fm = gid * WGM, gsz = (nM - fm) < WGM ? (nM - fm) : WGM;
        u.pm = pm0 + fm + ((wgid % nig) % gsz); u.pn = (wgid % nig) / gsz; u.g = 0; return true;
    }
};
struct GroupedOrder {
    int nG, nM, nN, G, c, pm0;
    __device__ __forceinline__ void init(int nG_, int nM_, int nN_, int G_, int c_, int pm0_) { nG = nG_; nM = nM_; nN = nN_; G = G_; c = c_; pm0 = pm0_; }
    __device__ __forceinline__ bool next(int i, Unit& u) const {
        const long L = (long)i * G + c; if (L >= (long)nG * nM * nN) return false;
        const int per = nM * nN, r = (int)(L % per); u.g = (int)(L / per); u.pn = r / nM; u.pm = pm0 + r % nM; return true;
    }
};

__device__ __forceinline__ unsigned cvt_pk_bf16(float lo, float hi) { unsigned r; asm volatile("v_cvt_pk_bf16_f32 %0, %1, %2" : "=v"(r) : "v"(lo), "v"(hi)); return r; }
__device__ __forceinline__ float sigmoidf_fast(float x) { return __builtin_amdgcn_rcpf(1.0f + __builtin_amdgcn_exp2f(-1.44269504089f * x)); }
__device__ __forceinline__ float gelu_tanh(float y) { const float z = 0.7978845608f * (y + 0.044715f * y * y * y); return y * sigmoidf_fast(2.0f * z); }

struct EpiF32G {
    static constexpr bool PERM = false, AFTER_DRAIN = false, I8 = false;
    float* C; int ldc; size_t gsC;
    __device__ __forceinline__ void operator()(const f32x4 (&acc)[2][2][4][2], const Unit& u, int wr, int wc, int fr, int fq) const {
        const int row0 = u.pm * BM + wr * 64 + fr, col0 = u.pn * BM + wc * 32 + 4 * fq; float* rowp = C + (size_t)u.g * gsC + (size_t)row0 * ldc + col0;
#pragma unroll
        for (int ai = 0; ai < 2; ++ai) {
#pragma unroll
            for (int m = 0; m < 4; ++m) {
#pragma unroll
                for (int bj = 0; bj < 2; ++bj)
#pragma unroll
                    for (int n = 0; n < 2; ++n) *(f32x4*)(rowp + bj * HALF + n * 16) = acc[ai][bj][m][n];
                asm volatile("" : "+v"(rowp)); rowp += (size_t)16 * ldc; }
            rowp += (size_t)64 * ldc; }
    }
};
struct EpiBf16G {
    static constexpr bool PERM = true, AFTER_DRAIN = false, I8 = false;
    bf16_t* O; int ldc; size_t gsO;
    __device__ __forceinline__ void operator()(const f32x4 (&acc)[2][2][4][2], const Unit& u, int wr, int wc, int fr, int fq) const {
        const int row0 = u.pm * BM + wr * 64 + fr, col0 = u.pn * BM + wc * 32 + 8 * fq; bf16_t* rowp = O + (size_t)u.g * gsO + (size_t)row0 * ldc + col0;
#pragma unroll
        for (int ai = 0; ai < 2; ++ai) {
#pragma unroll
            for (int m = 0; m < 4; ++m) {
#pragma unroll
                for (int bj = 0; bj < 2; ++bj) { const f32x4 v0 = acc[ai][bj][m][0], v1 = acc[ai][bj][m][1];
                    u32x4 w; w.x = cvt_pk_bf16(v0[0], v0[1]); w.y = cvt_pk_bf16(v0[2], v0[3]); w.z = cvt_pk_bf16(v1[0], v1[1]); w.w = cvt_pk_bf16(v1[2], v1[3]);
                    *(u32x4*)(rowp + bj * HALF) = w; }
                asm volatile("" : "+v"(rowp)); rowp += (size_t)16 * ldc; }
            rowp += (size_t)64 * ldc; }
    }
};
struct EpiGeluZ {
    static constexpr bool PERM = true, AFTER_DRAIN = false, I8 = false;
    bf16_t* Z;
    __device__ __forceinline__ void operator()(const f32x4 (&acc)[2][2][4][2], const Unit& u, int wr, int wc, int fr, int fq) const {
        bf16_t* rowp = Z + ((size_t)(u.pm * 4096 + (wr * 64 + fr) * 16 + 2 * wc + (fq >> 1))) * 2048 + u.g * 16 + 8 * (fq & 1);
#pragma unroll
        for (int ai = 0; ai < 2; ++ai) {
#pragma unroll
            for (int m = 0; m < 4; ++m) {
#pragma unroll
                for (int bj = 0; bj < 2; ++bj) {
                    const f32x4 v0 = acc[ai][bj][m][0], v1 = acc[ai][bj][m][1];
                    u32x4 w; w.x = cvt_pk_bf16(gelu_tanh(v0[0]), gelu_tanh(v0[1])); w.y = cvt_pk_bf16(gelu_tanh(v0[2]), gelu_tanh(v0[3]));
                    w.z = cvt_pk_bf16(gelu_tanh(v1[0]), gelu_tanh(v1[1])); w.w = cvt_pk_bf16(gelu_tanh(v1[2]), gelu_tanh(v1[3]));
                    *(u32x4*)(rowp + (size_t)bj * 8 * 2048) = w; }
                asm volatile("" : "+v"(rowp)); rowp += (size_t)16 * 16 * 2048; }
            rowp += (size_t)64 * 16 * 2048; }
    }
};
struct EpiGlu {
    static constexpr bool PERM = true, AFTER_DRAIN = false, I8 = false;
    bf16_t* O; int ldc;
    __device__ __forceinline__ void operator()(const f32x4 (&acc)[2][2][4][2], const Unit& u, int wr, int wc, int fr, int fq) const {
        const int row0 = u.pm * BM + wr * 64 + fr, col0 = u.pn * HALF + wc * 32 + 8 * fq; bf16_t* rowp = O + (size_t)row0 * ldc + col0;
#pragma unroll
        for (int ai = 0; ai < 2; ++ai) {
#pragma unroll
            for (int m = 0; m < 4; ++m) {
                const f32x4 v0 = acc[ai][0][m][0], v1 = acc[ai][0][m][1], g0 = acc[ai][1][m][0], g1 = acc[ai][1][m][1];
                u32x4 w; w.x = cvt_pk_bf16(v0[0] * sigmoidf_fast(g0[0]), v0[1] * sigmoidf_fast(g0[1])); w.y = cvt_pk_bf16(v0[2] * sigmoidf_fast(g0[2]), v0[3] * sigmoidf_fast(g0[3]));
                w.z = cvt_pk_bf16(v1[0] * sigmoidf_fast(g1[0]), v1[1] * sigmoidf_fast(g1[1])); w.w = cvt_pk_bf16(v1[2] * sigmoidf_fast(g1[2]), v1[3] * sigmoidf_fast(g1[3]));
                *(u32x4*)rowp = w;
                asm volatile("" : "+v"(rowp)); rowp += (size_t)16 * ldc; }
            rowp += (size_t)64 * ldc; }
    }
};

__device__ __forceinline__ float dpp_shr1(float old, float src) { return __builtin_bit_cast(float, __builtin_amdgcn_update_dpp(__builtin_bit_cast(int, old), __builtin_bit_cast(int, src), 0x111, 0xF, 0xF, false)); }
__device__ __forceinline__ float dpp_shl1(float old, float src) { return __builtin_bit_cast(float, __builtin_amdgcn_update_dpp(__builtin_bit_cast(int, old), __builtin_bit_cast(int, src), 0x101, 0xF, 0xF, false)); }
__device__ __forceinline__ float dpp_ror1(float src) { return __builtin_bit_cast(float, __builtin_amdgcn_update_dpp(0, __builtin_bit_cast(int, src), 0x121, 0xF, 0xF, false)); }
__device__ __forceinline__ float dpp_ror15(float src) { return __builtin_bit_cast(float, __builtin_amdgcn_update_dpp(0, __builtin_bit_cast(int, src), 0x12F, 0xF, 0xF, false)); }
struct EpiConvGlu {
    static constexpr bool PERM = true, AFTER_DRAIN = false, I8 = true;
    bf16_t* ACT; const float* cw; const float* cb; float* PRE; float* RAW; PG8_LAS float* xch; const float* su; const float* sw;
    __device__ __forceinline__ void operator()(const i32x4 (&acci)[2][2][4][2], const Unit& u, int wr, int wc, int fr_in, int fq_in) const {
        constexpr int DF = 5632;
        int fr = fr_in, fq = fq_in; asm volatile("" : "+v"(fr), "+v"(fq));
        f32x4 acc[2][2][4][2];
#pragma unroll
        for (int ai = 0; ai < 2; ++ai)
#pragma unroll
            for (int m = 0; m < 4; ++m) { const float rs = su[u.pm * BM + ai * HALF + wr * 64 + m * 16 + fr];
#pragma unroll
                for (int bj = 0; bj < 2; ++bj)
#pragma unroll
                    for (int n = 0; n < 2; ++n) { const i32x4 q = acci[ai][bj][m][n]; acc[ai][bj][m][n] = (f32x4){(float)q[0], (float)q[1], (float)q[2], (float)q[3]} * rs; } }
        const int f0 = u.pn * HALF + wc * 32 + 8 * fq;
        PG8_LAS float* coef = xch + 2048;
        { int tid = (wr * 4 + wc) * 64 + fq * 16 + fr; asm volatile("" : "+v"(tid));
          if (tid < 256) { const int which = tid >> 5, ch = tid & 31, t = which & 3; const float* src = (t < 3 ? cw + t * (2 * DF) : cb) + (which >> 2) * DF + u.pn * HALF + 4 * ch;
              f32x4 cv4 = *(const f32x4*)src; if (t < 3) cv4 = cv4 * *(const f32x4*)(sw + u.pn * BM + (which >> 2) * HALF + 4 * ch);
              *(PG8_LAS f32x4*)(coef + which * 128 + 4 * ch) = cv4; }
          else if (tid < 320) { const int h = (tid - 256) >> 5, ch = tid & 31; *(PG8_LAS f32x4*)(coef + 1024 + h * 128 + 4 * ch) = *(const f32x4*)(sw + u.pn * BM + h * HALF + 4 * ch); } }
#pragma unroll
        for (int ai = 0; ai < 2; ++ai) { const int s = 2 * ai + wr;
            if (fr == 0) { PG8_LAS f32x4* q = (PG8_LAS f32x4*)(xch + ((((s * 2 + 0) * 4 + wc) * 4 + fq) * 2) * 8); q[0] = acc[ai][0][0][0]; q[1] = acc[ai][0][0][1]; q[2] = acc[ai][1][0][0]; q[3] = acc[ai][1][0][1]; }
            if (fr == 15) { PG8_LAS f32x4* q = (PG8_LAS f32x4*)(xch + ((((s * 2 + 1) * 4 + wc) * 4 + fq) * 2) * 8); q[0] = acc[ai][0][3][0]; q[1] = acc[ai][0][3][1]; q[2] = acc[ai][1][3][0]; q[3] = acc[ai][1][3][1]; } }
        asm volatile("s_waitcnt lgkmcnt(0)" ::: "memory"); __builtin_amdgcn_s_barrier(); asm volatile("" ::: "memory");
        bf16_t* rowp0 = ACT + (size_t)(u.pm * BM + wr * 64 + fr) * DF + f0;
#define FMAC_DPP(t, src, k, ctrl) asm("v_fmac_f32_dpp %0, %1, %2 " ctrl " row_mask:0xf bank_mask:0xf" : "+v"(t) : "v"(src), "v"(k))
#pragma unroll
        for (int n = 0; n < 2; ++n) {
            asm volatile("" ::: "memory");
            const int cc = wc * 32 + 8 * fq + 4 * n;
            const f32x4 kv0 = *(const PG8_LAS f32x4*)(coef + cc), kv1 = *(const PG8_LAS f32x4*)(coef + 128 + cc), kv2 = *(const PG8_LAS f32x4*)(coef + 256 + cc), bv = *(const PG8_LAS f32x4*)(coef + 384 + cc);
            const f32x4 kg0 = *(const PG8_LAS f32x4*)(coef + 512 + cc), kg1 = *(const PG8_LAS f32x4*)(coef + 640 + cc), kg2 = *(const PG8_LAS f32x4*)(coef + 768 + cc), bg = *(const PG8_LAS f32x4*)(coef + 896 + cc);
            const float m0 = fr == 0 ? 1.0f : 0.0f, m15 = fr == 15 ? 1.0f : 0.0f;
            const f32x4 kv0e = kv0 * m0, kg0e = kg0 * m0, kv2e = kv2 * m15, kg2e = kg2 * m15;
            bf16_t* rowp = rowp0;
#pragma unroll
            for (int ai = 0; ai < 2; ++ai) { const int s = 2 * ai + wr;
#pragma unroll
                for (int m = 0; m < 4; ++m) {
                    const f32x4 cv = acc[ai][0][m][n], cg = acc[ai][1][m][n];
                    f32x4 vv = kv1 * cv + bv, gg = kg1 * cg + bg;
                    f32x4 hpv = {0.f, 0.f, 0.f, 0.f}, hpg = hpv, hnv = hpv, hng = hpv;
                    if (m == 0 && s > 0) { const PG8_LAS f32x4* q = (const PG8_LAS f32x4*)(xch + (((((s - 1) * 2 + 1) * 4 + wc) * 4 + fq) * 2) * 8); hpv = q[n]; hpg = q[2 + n]; }
                    if (m == 3 && s < 3) { const PG8_LAS f32x4* q = (const PG8_LAS f32x4*)(xch + (((((s + 1) * 2 + 0) * 4 + wc) * 4 + fq) * 2) * 8); hnv = q[n]; hng = q[2 + n]; }
#pragma unroll
                    for (int e = 0; e < 4; ++e) {
                        FMAC_DPP(vv[e], cv[e], kv0[e], "row_shr:1"); FMAC_DPP(vv[e], cv[e], kv2[e], "row_shl:1");
                        FMAC_DPP(gg[e], cg[e], kg0[e], "row_shr:1"); FMAC_DPP(gg[e], cg[e], kg2[e], "row_shl:1");
                        if (m > 0) { FMAC_DPP(vv[e], acc[ai][0][m == 0 ? 0 : m - 1][n][e], kv0e[e], "row_ror:1"); FMAC_DPP(gg[e], acc[ai][1][m == 0 ? 0 : m - 1][n][e], kg0e[e], "row_ror:1"); }
                        else { vv[e] += hpv[e] * kv0e[e]; gg[e] += hpg[e] * kg0e[e]; }
                        if (m < 3) { FMAC_DPP(vv[e], acc[ai][0][m == 3 ? 3 : m + 1][n][e], kv2e[e], "row_ror:15"); FMAC_DPP(gg[e], acc[ai][1][m == 3 ? 3 : m + 1][n][e], kg2e[e], "row_ror:15"); }
                        else { vv[e] += hnv[e] * kv2e[e]; gg[e] += hng[e] * kg2e[e]; }
                    }
                    if ((s == 0 && m == 0 && fr == 0) || (s == 3 && m == 3 && fr == 15)) {
                        const size_t eo = ((size_t)(u.pm * 2 + (s == 0 ? 0 : 1)) * 2) * DF + f0 + 4 * n;
                        *(f32x4*)(PRE + eo) = vv; *(f32x4*)(PRE + eo + DF) = gg;
                        *(f32x4*)(RAW + eo) = cv * *(const PG8_LAS f32x4*)(coef + 1024 + cc); *(f32x4*)(RAW + eo + DF) = cg * *(const PG8_LAS f32x4*)(coef + 1152 + cc); }
                    u32x2 w; w.x = cvt_pk_bf16(gg[0] * sigmoidf_fast(gg[0]) * vv[0], gg[1] * sigmoidf_fast(gg[1]) * vv[1]); w.y = cvt_pk_bf16(gg[2] * sigmoidf_fast(gg[2]) * vv[2], gg[3] * sigmoidf_fast(gg[3]) * vv[3]);
                    *(u32x2*)(rowp + 4 * n) = w; asm volatile("" : "+v"(rowp)); rowp += (size_t)16 * DF;
                }
                rowp += (size_t)64 * DF;
            }
        }
#undef FMAC_DPP
    }
};


struct OneUnit { Unit u; __device__ bool next(int i, Unit& o) const { if (i != 0) return false; o = u; return true; } };
struct EpiScan {
    static constexpr bool PERM = false, AFTER_DRAIN = true, I8 = false;
    const float* A16; bf16_t* A2; PG8_LAS float* xc;
    __device__ __forceinline__ void operator()(const f32x4 (&)[2][2][4][2], const Unit&, int, int, int, int) const {}
    __device__ __forceinline__ void fused(const f32x4 (&acc)[2][2][4][2], const Unit& u, int wr, int wc, int fr, int fq, PG8_LAS unsigned char* lds, int wid, int lane) const {
        PG8_LAS float* SL = (PG8_LAS float*)lds; const int p = lane, ch = wid;
#pragma unroll
        for (int d = 0; d < 2; ++d) {
#pragma unroll
            for (int ai = 0; ai < 2; ++ai)
#pragma unroll
                for (int m = 0; m < 4; ++m) { const int row = ai * HALF + wr * 64 + m * 16 + fr;
#pragma unroll
                    for (int n = 0; n < 2; ++n) { const int c = wc * 32 + n * 16 + 4 * fq; *(PG8_LAS f32x4*)(SL + row * 128 + (c ^ ((row & 7) << 2))) = acc[ai][d][m][n]; } }
            asm volatile("s_waitcnt lgkmcnt(0)" ::: "memory"); __builtin_amdgcn_s_barrier(); asm volatile("" ::: "memory");
            const float* a16 = A16 + ((size_t)(d * 128 + u.g) * 64 + p) * 2; const float ar = a16[0], ai_ = a16[1];
            const int row0 = d == 0 ? ch * 32 : 255 - ch * 32, rst = d == 0 ? 1 : -1;
            float sr = 0.f, si = 0.f;
#pragma unroll 8
            for (int i = 0; i < 32; ++i) { const int row = row0 + rst * i, sw = (row & 7) << 2; const float xr = SL[row * 128 + (p ^ sw)], xi = SL[row * 128 + ((64 + p) ^ sw)];
                const float nr = ar * sr - ai_ * si + xr, ni = ar * si + ai_ * sr + xi; sr = nr; si = ni; }
            xc[(ch * 64 + p) * 2] = sr; xc[(ch * 64 + p) * 2 + 1] = si;
            asm volatile("s_waitcnt lgkmcnt(0)" ::: "memory"); __builtin_amdgcn_s_barrier(); asm volatile("" ::: "memory");
            float pr = ar, pi = ai_;
#pragma unroll
            for (int k = 0; k < 5; ++k) { const float nr = pr * pr - pi * pi, ni = 2.f * pr * pi; pr = nr; pi = ni; }
            float cr = xc[1024 + (d * 64 + p) * 2], ci = xc[1024 + (d * 64 + p) * 2 + 1];
            for (int q = 0; q < ch; ++q) { const float er = xc[(q * 64 + p) * 2], ei = xc[(q * 64 + p) * 2 + 1]; const float nr = pr * cr - pi * ci + er, ni = pr * ci + pi * cr + ei; cr = nr; ci = ni; }
            bf16_t* OUT = A2 + ((size_t)u.g * 512 + (size_t)u.pm * 256) * 512 + d * 128 + p;
#pragma unroll 8
            for (int i = 0; i < 32; ++i) { const int row = row0 + rst * i, sw = (row & 7) << 2; const float xr = SL[row * 128 + (p ^ sw)], xi = SL[row * 128 + ((64 + p) ^ sw)];
                const unsigned pk = cvt_pk_bf16(cr, ci); OUT[(size_t)row * 512] = (bf16_t)(pk & 0xffffu); OUT[(size_t)row * 512 + 64] = (bf16_t)(pk >> 16);
                const float nr = ar * cr - ai_ * ci + xr, ni = ar * ci + ai_ * cr + xi; cr = nr; ci = ni; }
            asm volatile("s_waitcnt lgkmcnt(0)" ::: "memory"); __builtin_amdgcn_s_barrier(); asm volatile("" ::: "memory");
        }
    }
};

template <bool SECOND> struct EpiRms {
    static constexpr bool PERM = false, AFTER_DRAIN = true, I8 = false;
    float* X; const float* fmod; const float* ng; bf16_t* U; float* xs; unsigned* cnt; unsigned* tmo;
    int lg, qg, iga, lm, qsh, qsc, igb, bank;
    __device__ __forceinline__ void operator()(const f32x4 (&)[2][2][4][2], const Unit&, int, int, int, int) const {}
    __device__ __forceinline__ void stats(const f32x4 (&v)[2][2][4][2], const Unit& u, int bk, int wr, int wc, int fr, int fq, PG8_LAS unsigned char* lds, int wid, int lane) const {
        PG8_LAS float* P = (PG8_LAS float*)lds; PG8_LAS float* S = P + 1024; const int tid = wid * 64 + lane;
        float* xb = xs + (size_t)bk * 65536 + (size_t)u.pm * 2048; unsigned* cb = cnt + bk * 2048 + 64 * u.pm;
#pragma unroll
        for (int ai = 0; ai < 2; ++ai)
#pragma unroll
            for (int m = 0; m < 4; ++m) { float q = 0.f;
#pragma unroll
                for (int bj = 0; bj < 2; ++bj)
#pragma unroll
                    for (int n = 0; n < 2; ++n) { const f32x4 x = v[ai][bj][m][n]; q += (x[0] * x[0] + x[1] * x[1]) + (x[2] * x[2] + x[3] * x[3]); }
                { const int ln = fq * 16 + fr;
                  q += __builtin_bit_cast(float, __builtin_amdgcn_ds_bpermute((ln ^ 16) << 2, __builtin_bit_cast(int, q)));
                  q += __builtin_bit_cast(float, __builtin_amdgcn_ds_bpermute((ln ^ 32) << 2, __builtin_bit_cast(int, q))); }
                if (fq == 0) P[(ai * HALF + wr * 64 + m * 16 + fr) * 4 + wc] = q; }
        asm volatile("s_waitcnt lgkmcnt(0)" ::: "memory"); __builtin_amdgcn_s_barrier(); asm volatile("" ::: "memory");
        if (tid < 256) { const f32x4 p4 = *(PG8_LAS f32x4*)(P + tid * 4); const float t = (p4[0] + p4[1]) + (p4[2] + p4[3]);
            __hip_atomic_store((unsigned*)(xb + tid * 8 + u.pn), __builtin_bit_cast(unsigned, t), __ATOMIC_RELAXED, __HIP_MEMORY_SCOPE_AGENT); }
        asm volatile("s_waitcnt vmcnt(0)" ::: "memory");
        if (wid < 4 && lane == 0) __hip_atomic_fetch_add(cb, 1u, __ATOMIC_RELAXED, __HIP_MEMORY_SCOPE_AGENT);
        if (wid == 0) { unsigned sp = 0;
            while ((unsigned)__builtin_amdgcn_readfirstlane((int)__hip_atomic_load(cb, __ATOMIC_RELAXED, __HIP_MEMORY_SCOPE_AGENT)) < 32u) { __builtin_amdgcn_s_sleep(2);
                if ((++sp & 255u) == 0u) { if (__hip_atomic_load(tmo, __ATOMIC_RELAXED, __HIP_MEMORY_SCOPE_AGENT)) break; if (sp > (1u << 22)) { if (lane == 0) atomicAdd(tmo, 1u); break; } } }
            __builtin_amdgcn_fence(__ATOMIC_ACQUIRE, "agent"); }
        asm volatile("s_waitcnt vmcnt(0) lgkmcnt(0)" ::: "memory"); __builtin_amdgcn_s_barrier(); asm volatile("" ::: "memory");
        if (tid < 256) { float t = 0.f;
#pragma unroll
            for (int k = 0; k < 8; ++k) t += __builtin_bit_cast(float, __hip_atomic_load((unsigned*)(xb + tid * 8 + k), __ATOMIC_RELAXED, __HIP_MEMORY_SCOPE_AGENT));
            S[tid] = 1.0f / sqrtf(t * (1.0f / 2048.0f) + 1e-6f); }
        asm volatile("s_waitcnt lgkmcnt(0)" ::: "memory"); __builtin_amdgcn_s_barrier(); asm volatile("" ::: "memory");
    }
    __device__ __forceinline__ void fused(f32x4 (&acc)[2][2][4][2], const Unit& u, int wr, int wc, int fr, int fq, PG8_LAS unsigned char* lds, int wid, int lane) const {
        const PG8_LAS float* S = (const PG8_LAS float*)lds + 1024;
        const int b = u.pm >> 4, col0 = u.pn * BM + wc * 32 + 4 * fq;
        const float* gate = fmod + ((size_t)(lg * 3 + b) * 6 + qg) * 2048; const float* ga = ng + iga * 2048;
        f32x4 GG[2][2];
#pragma unroll
        for (int bj = 0; bj < 2; ++bj)
#pragma unroll
            for (int n = 0; n < 2; ++n) { const int c = col0 + bj * HALF + n * 16; GG[bj][n] = *(const f32x4*)(gate + c) * *(const f32x4*)(ga + c); }
        float pf0, pf1, pf2, pf3;
        { const int tid = wid * 64 + lane; const float* xt = X + (size_t)(u.pm * BM) * 2048 + u.pn * BM + (tid & 7) * 32 + (size_t)(tid >> 3) * 2048;
          pf0 = xt[0]; pf1 = xt[(size_t)64 * 2048]; pf2 = xt[(size_t)128 * 2048]; pf3 = xt[(size_t)192 * 2048]; }
        stats(acc, u, bank, wr, wc, fr, fq, lds, wid, lane);
        asm volatile("" :: "v"(pf0), "v"(pf1), "v"(pf2), "v"(pf3));
#pragma unroll
        for (int ai = 0; ai < 2; ++ai)
#pragma unroll
            for (int m = 0; m < 4; ++m) { const int r = ai * HALF + wr * 64 + m * 16 + fr; const float ry = S[r]; float* xp = X + (size_t)(u.pm * BM + r) * 2048 + col0;
#pragma unroll
                for (int bj = 0; bj < 2; ++bj)
#pragma unroll
                    for (int n = 0; n < 2; ++n) { const f32x4 x = *(const f32x4*)(xp + bj * HALF + n * 16); acc[ai][bj][m][n] = x + GG[bj][n] * (acc[ai][bj][m][n] * ry); *(f32x4*)(xp + bj * HALF + n * 16) = acc[ai][bj][m][n]; }
                asm volatile("" : "+v"(acc[ai][0][m][0]), "+v"(acc[ai][0][m][1]), "+v"(acc[ai][1][m][0]), "+v"(acc[ai][1][m][1]));
                if (m & 1) asm volatile("" ::: "memory"); }
        if (SECOND) {
            stats(acc, u, bank + 1, wr, wc, fr, fq, lds, wid, lane);
            const float* sh = fmod + ((size_t)(lm * 3 + b) * 6 + qsh) * 2048; const float* sc = fmod + ((size_t)(lm * 3 + b) * 6 + qsc) * 2048; const float* gb = ng + igb * 2048;
            f32x4 SC[2][2], SH[2][2];
#pragma unroll
            for (int bj = 0; bj < 2; ++bj)
#pragma unroll
                for (int n = 0; n < 2; ++n) { const int c = col0 + bj * HALF + n * 16; SC[bj][n] = (*(const f32x4*)(sc + c) + 1.0f) * *(const f32x4*)(gb + c); SH[bj][n] = *(const f32x4*)(sh + c); }
#pragma unroll
            for (int ai = 0; ai < 2; ++ai)
#pragma unroll
                for (int m = 0; m < 4; ++m) { const int r = ai * HALF + wr * 64 + m * 16 + fr; const float rx = S[r]; bf16_t* up = U + (size_t)(u.pm * BM + r) * 2048 + col0;
#pragma unroll
                    for (int bj = 0; bj < 2; ++bj)
#pragma unroll
                        for (int n = 0; n < 2; ++n) { const f32x4 uu = (acc[ai][bj][m][n] * rx) * SC[bj][n] + SH[bj][n]; u32x2 w; w.x = cvt_pk_bf16(uu[0], uu[1]); w.y = cvt_pk_bf16(uu[2], uu[3]); *(u32x2*)(up + bj * HALF + n * 16) = w; } }
        }
    }
};

__device__ __forceinline__ f32x4 mma_one(bf16x8 b, bf16x8 a, f32x4 c) { return __builtin_amdgcn_mfma_f32_16x16x32_bf16(b, a, c, 0, 0, 0); }
__device__ __forceinline__ i32x4 mma_one(bf16x8 b, bf16x8 a, i32x4 c) { return __builtin_amdgcn_mfma_i32_16x16x64_i8(__builtin_bit_cast(i32x4, b), __builtin_bit_cast(i32x4, a), c, 0, 0, 0); }
template <class Epi, class Sched, bool ALIGN_EPI = false, bool SP2 = false>
__device__ __forceinline__ void gemm_phase(PG8_LAS unsigned char* lds, const Gemm g, const Sched& S, const Epi& E, const int tid) {
    const int wid = __builtin_amdgcn_readfirstlane(tid >> 6), lane = tid & 63, wr = wid >> 2, wc = wid & 3, fr = lane & 15, fq = lane >> 4;
    const int K = g.K, nt = K / BK;
    unsigned voffA[2], voffB[2];
#pragma unroll
    for (int i = 0; i < 2; ++i) { int R, C; stage_rc(tid * 16 + i * 8192, R, C); const int Rb = Epi::PERM ? ((R & ~31) + perm32(R & 31)) : R;
        voffA[i] = (unsigned)(R * g.lda + C) * 2u; voffB[i] = (unsigned)(Rb * g.ldb + C) * 2u; }
    const size_t kstep = (size_t)(BK * 2);
    const size_t hstepA = (size_t)HALF * g.lda * 2, hstepB = (size_t)HALF * g.ldb * 2;
    const size_t tstepA = 2 * hstepA, tstepB = 2 * hstepB;
    const unsigned ldsw = (unsigned)wid * 1024u;
    const int aoff = lds_byte(wr * 64 + fr, fq * 8), boff = lds_byte(wc * 32 + fr, fq * 8);
#define PG8_SA(b, h) (((b) * 2 + (h)) * HTB)
#define PG8_SB(b, h) ((4 + (b) * 2 + (h)) * HTB)
#define PG8_STAGE(bufoff, gbase, voff) do { _Pragma("unroll") for (int _i = 0; _i < 2; ++_i) \
        __builtin_amdgcn_global_load_lds((const unsigned*)((const char*)(gbase) + (voff)[_i]), (PG8_LAS unsigned*)(lds + (bufoff) + ldsw + _i * 8192), 16, 0, 0); } while (0)
#define PG8_LDA(dst, b, h) do { _Pragma("unroll") for (int m = 0; m < 4; ++m) _Pragma("unroll") for (int k = 0; k < 2; ++k) dst[m][k] = *(const PG8_LAS bf16x8*)(lds + PG8_SA(b, h) + aoff + m * 2048 + k * 1024); } while (0)
#define PG8_LDB(dst, b, h) do { _Pragma("unroll") for (int n = 0; n < 2; ++n) _Pragma("unroll") for (int k = 0; k < 2; ++k) dst[n][k] = *(const PG8_LAS bf16x8*)(lds + PG8_SB(b, h) + boff + n * 2048 + k * 1024); } while (0)
#define PG8_MMA(ai, bj, At, Bt) do { __builtin_amdgcn_s_setprio(1); _Pragma("unroll") for (int m = 0; m < 4; ++m) _Pragma("unroll") for (int n = 0; n < 2; ++n) _Pragma("unroll") for (int k = 0; k < 2; ++k) \
        acc[ai][bj][m][n] = mma_one(Bt[n][k], At[m][k], acc[ai][bj][m][n]); __builtin_amdgcn_s_setprio(0); } while (0)
#define PG8_WAIT_V(n) asm volatile("s_waitcnt vmcnt(" #n ")" ::: "memory")
#define PG8_WAIT_L(n) asm volatile("s_waitcnt lgkmcnt(" #n ")" ::: "memory")
#define PG8_BAR __builtin_amdgcn_s_barrier()
#define PG8_SCHED __builtin_amdgcn_sched_barrier(0)
    Unit cur, nxt; int ui = 0;
    if (!S.next(0, cur)) return;
    typedef typename AccT<Epi::I8>::T acc_t; const acc_t acc_zero = {};
    acc_t acc[2][2][4][2];
#pragma unroll
    for (int a = 0; a < 2; ++a)
#pragma unroll
        for (int b = 0; b < 2; ++b)
#pragma unroll
            for (int m = 0; m < 4; ++m)
#pragma unroll
                for (int n = 0; n < 2; ++n) acc[a][b][m][n] = acc_zero;
    bf16x8 At[4][2], B0[2][2], B1[2][2];
    const char* cA = (const char*)g.A + ((size_t)cur.g * g.gsA) * 2 + (size_t)cur.pm * tstepA; const char* cB = (const char*)g.Bt + ((size_t)cur.g * g.gsB) * 2 + (size_t)cur.pn * tstepB;
    if constexpr (SP2) {
        PG8_STAGE(PG8_SB(0, 0), cB, voffB); PG8_STAGE(PG8_SB(0, 1), cB + hstepB, voffB); PG8_STAGE(PG8_SA(0, 0), cA, voffA); PG8_STAGE(PG8_SA(0, 1), cA + hstepA, voffA);
        if (wr == 1) PG8_BAR;
        PG8_WAIT_V(2); PG8_BAR;
        PG8_STAGE(PG8_SB(1, 0), cB + kstep, voffB); PG8_STAGE(PG8_SA(1, 0), cA + kstep, voffA); PG8_STAGE(PG8_SB(1, 1), cB + hstepB + kstep, voffB);
        PG8_WAIT_V(6); PG8_BAR;
    } else {
        PG8_STAGE(PG8_SB(0, 0), cB, voffB); PG8_STAGE(PG8_SA(0, 0), cA, voffA); PG8_STAGE(PG8_SB(0, 1), cB + hstepB, voffB); PG8_STAGE(PG8_SA(0, 1), cA + hstepA, voffA);
        if (wr == 1) PG8_BAR;
        PG8_WAIT_V(4); PG8_BAR;
        PG8_STAGE(PG8_SB(1, 0), cB + kstep, voffB); PG8_STAGE(PG8_SA(1, 0), cA + kstep, voffA); PG8_STAGE(PG8_SB(1, 1), cB + hstepB + kstep, voffB);
        PG8_WAIT_V(6); PG8_BAR;
    }
    for (;;) {
        const bool has_next = S.next(ui + 1, nxt);
        const char* nA = has_next ? (const char*)g.A + ((size_t)nxt.g * g.gsA) * 2 + (size_t)nxt.pm * tstepA : cA; const char* nB = has_next ? (const char*)g.Bt + ((size_t)nxt.g * g.gsB) * 2 + (size_t)nxt.pn * tstepB : cB;
        for (int t = 0; t < nt; t += 2) {
            const bool last = (t == nt - 2);
            const char* a1 = cA + (size_t)(t + 1) * kstep;
            const char* a2 = last ? nA : cA + (size_t)(t + 2) * kstep; const char* b2 = last ? nB : cB + (size_t)(t + 2) * kstep;
            const char* a3 = a2 + kstep; const char* b3 = b2 + kstep;
            if constexpr (SP2) {
            PG8_LDB(B0, 0, 0); PG8_LDB(B1, 0, 1); PG8_SCHED; PG8_LDA(At, 0, 0); PG8_STAGE(PG8_SA(1, 1), a1 + hstepA, voffA);
            PG8_WAIT_V(8); PG8_WAIT_L(0); PG8_BAR; PG8_MMA(0, 0, At, B0); PG8_MMA(0, 1, At, B1); PG8_BAR; PG8_SCHED;
            PG8_LDA(At, 0, 1); PG8_STAGE(PG8_SB(0, 0), b2, voffB); PG8_STAGE(PG8_SB(0, 1), b2 + hstepB, voffB); PG8_STAGE(PG8_SA(0, 0), a2, voffA);
            PG8_WAIT_V(8); PG8_WAIT_L(0); PG8_BAR; PG8_MMA(1, 0, At, B0); PG8_MMA(1, 1, At, B1); PG8_BAR; PG8_SCHED;
            PG8_LDB(B0, 1, 0); PG8_LDB(B1, 1, 1); PG8_SCHED; PG8_LDA(At, 1, 0); PG8_STAGE(PG8_SA(0, 1), a2 + hstepA, voffA);
            PG8_WAIT_V(8); PG8_WAIT_L(0); PG8_BAR; PG8_MMA(0, 0, At, B0); PG8_MMA(0, 1, At, B1); PG8_BAR; PG8_SCHED;
            PG8_LDA(At, 1, 1); PG8_STAGE(PG8_SB(1, 0), b3, voffB); PG8_STAGE(PG8_SB(1, 1), b3 + hstepB, voffB); PG8_STAGE(PG8_SA(1, 0), a3, voffA);
            PG8_WAIT_V(8); PG8_WAIT_L(0); PG8_BAR; PG8_MMA(1, 0, At, B0); PG8_MMA(1, 1, At, B1); PG8_BAR; PG8_SCHED;
            } else {
            PG8_LDB(B0, 0, 0); PG8_SCHED; PG8_LDA(At, 0, 0); PG8_STAGE(PG8_SA(1, 1), a1 + hstepA, voffA);
            PG8_WAIT_L(8); PG8_BAR; PG8_WAIT_L(0); PG8_MMA(0, 0, At, B0); PG8_BAR; PG8_SCHED;
            PG8_LDB(B1, 0, 1); PG8_STAGE(PG8_SB(0, 0), b2, voffB);
            PG8_BAR; PG8_WAIT_L(0); PG8_MMA(0, 1, At, B1); PG8_BAR;
            PG8_LDA(At, 0, 1); PG8_STAGE(PG8_SA(0, 0), a2, voffA);
            PG8_BAR; PG8_WAIT_L(0); PG8_MMA(1, 0, At, B0); PG8_BAR; PG8_SCHED;
            PG8_STAGE(PG8_SB(0, 1), b2 + hstepB, voffB);
            PG8_WAIT_V(6); PG8_BAR; PG8_MMA(1, 1, At, B1); PG8_BAR;
            PG8_LDB(B0, 1, 0); PG8_SCHED; PG8_LDA(At, 1, 0); PG8_STAGE(PG8_SA(0, 1), a2 + hstepA, voffA);
            PG8_WAIT_L(8); PG8_BAR; PG8_WAIT_L(0); PG8_MMA(0, 0, At, B0); PG8_BAR; PG8_SCHED;
            PG8_LDB(B1, 1, 1); PG8_STAGE(PG8_SB(1, 0), b3, voffB);
            PG8_BAR; PG8_WAIT_L(0); PG8_MMA(0, 1, At, B1); PG8_BAR;
            PG8_LDA(At, 1, 1); PG8_STAGE(PG8_SA(1, 0), a3, voffA);
            PG8_BAR; PG8_WAIT_L(0); PG8_MMA(1, 0, At, B0); PG8_BAR; PG8_SCHED;
            PG8_STAGE(PG8_SB(1, 1), b3 + hstepB, voffB);
            PG8_WAIT_V(6); PG8_BAR; PG8_MMA(1, 1, At, B1); PG8_BAR;
            }
        }
        if constexpr (ALIGN_EPI) { if (wr == 0) PG8_BAR; }
        if constexpr (!Epi::AFTER_DRAIN) E(acc, cur, wr, wc, fr, fq);
        if (!has_next) break;
#pragma unroll
        for (int a = 0; a < 2; ++a)
#pragma unroll
            for (int b = 0; b < 2; ++b)
#pragma unroll
                for (int m = 0; m < 4; ++m)
#pragma unroll
                    for (int n = 0; n < 2; ++n) acc[a][b][m][n] = acc_zero;
        cur = nxt; cA = nA; cB = nB; ++ui;
        if constexpr (ALIGN_EPI) { if (wr == 1) PG8_BAR; }
    }
    PG8_WAIT_V(0);
    if constexpr (!ALIGN_EPI) { if (wr == 0) PG8_BAR; }
    PG8_BAR;
    if constexpr (Epi::AFTER_DRAIN) E.fused(acc, cur, wr, wc, fr, fq, lds, wid, lane);
#undef PG8_SA
#undef PG8_SB
#undef PG8_STAGE
#undef PG8_LDA
#undef PG8_LDB
#undef PG8_MMA
#undef PG8_WAIT_V
#undef PG8_WAIT_L
#undef PG8_BAR
#undef PG8_SCHED
}
}

constexpr int NWAVES = 8, NTHR = NWAVES * 64;
constexpr int DM = 2048, NBATCH = 2, SEQ = 4096, CTX = 256, MT = NBATCH * SEQ, MC = NBATCH * CTX, DFF = 5632, DFF2 = 2 * DFF, NMODC = 6 * DM, NG = 128;
constexpr float RMS_EPS = 1e-6f;
constexpr int NPHASE = 17;

constexpr size_t MiB = 1u << 20;
constexpr size_t WS_CTL = 0, CTL_ZERO_BYTES = 1 * MiB;
constexpr size_t WS_MODP = 1 * MiB;
constexpr size_t WS_A16 = 4 * MiB;
constexpr size_t WS_WGLU = 5 * MiB;
constexpr size_t WS_WUP = 21 * MiB;
constexpr size_t WS_WDN = 109 * MiB;
constexpr size_t WS_WPOOL = 153 * MiB;
constexpr size_t WS_UZ = 155 * MiB;
constexpr size_t WS_YF = 187 * MiB;
constexpr size_t WS_ACT = 219 * MiB;
constexpr size_t WS_WIN = 307 * MiB;
constexpr size_t WS_W2 = 323 * MiB;
constexpr size_t WS_A2 = 355 * MiB;
constexpr size_t WS_UCG = 419 * MiB;
constexpr size_t WS_SLOC = 421 * MiB;
constexpr size_t WS_SCLOC = 485 * MiB;
constexpr size_t WS_PRE = 489 * MiB;
constexpr size_t WS_RAW = 493 * MiB;
constexpr size_t WS_FMOD = 497 * MiB;
constexpr size_t WS_XS = 498 * MiB;
constexpr size_t WS_WUP8 = 499 * MiB;
constexpr size_t WS_U8 = 543 * MiB;
constexpr size_t WS_SU = 559 * MiB;
constexpr size_t WS_SW = 559 * MiB + 65536;
constexpr size_t WS_END = 560 * MiB;
static_assert(WS_SCLOC + (size_t)NG * 32 * 256 * 4 <= WS_PRE && WS_PRE + (size_t)32 * 2 * 2 * DFF * 4 <= WS_RAW && WS_RAW + (size_t)32 * 2 * 2 * DFF * 4 <= WS_FMOD && WS_XS + 3 * 262144 <= WS_WUP8 && WS_WUP8 + (size_t)2 * DFF2 * DM <= WS_U8 && WS_U8 + (size_t)MT * DM <= WS_SU && WS_SW + 2 * DFF2 * 4 <= WS_END, "d_ws map");

constexpr int RING_OFF = 0, RING_BYTES = 131072;
constexpr int LDSCTL_OFF = RING_BYTES, MISC_OFF = LDSCTL_OFF + 320, PTR_OFF = LDSCTL_OFF + 1024;
constexpr int XCH_OFF = LDSCTL_OFF + 2048;
constexpr int LDS_BYTES = 163840;

#define GAS __attribute__((address_space(1)))
#define LAS __attribute__((address_space(3)))
typedef unsigned short bf16;
typedef unsigned v4u __attribute__((ext_vector_type(4)));
typedef unsigned v2u __attribute__((ext_vector_type(2)));
typedef float f32x4 __attribute__((ext_vector_type(4)));
typedef short bf16x8 __attribute__((ext_vector_type(8)));
typedef float f32x16 __attribute__((ext_vector_type(16)));
#define LDS_WAIT() asm volatile("s_waitcnt lgkmcnt(0)" ::: "memory")
#define VM_WAIT() asm volatile("s_waitcnt vmcnt(0)" ::: "memory")
__device__ __forceinline__ unsigned f2bf(float f) { unsigned u = __builtin_bit_cast(unsigned, f); return (u + 0x7fffu + ((u >> 16) & 1u)) >> 16; }
__device__ __forceinline__ unsigned pk2(float lo, float hi) { return f2bf(lo) | (f2bf(hi) << 16); }
__device__ __forceinline__ float bf_lo(unsigned w) { return __builtin_bit_cast(float, w << 16); }
__device__ __forceinline__ float bf_hi(unsigned w) { return __builtin_bit_cast(float, w & 0xffff0000u); }
__device__ __forceinline__ void st_wt16(float* p, f32x4 v) { __builtin_nontemporal_store(v, (GAS f32x4*)p); }
__device__ __forceinline__ void st_wt16u(void* p, v4u v) { __builtin_nontemporal_store(v, (GAS v4u*)p); }
__device__ __forceinline__ void st_wt8u(void* p, v2u v) { __builtin_nontemporal_store(v, (GAS v2u*)p); }
__device__ __forceinline__ void st_wt4u(void* p, unsigned v) { __builtin_nontemporal_store(v, (GAS unsigned*)p); }
__device__ __forceinline__ float sigm(float x) { return __builtin_amdgcn_rcpf(1.0f + __builtin_amdgcn_exp2f(-1.44269504089f * x)); }

#define XB_TMO      128
#define XB_XCNT(j)  (256  + 64 * (j))
#define XB_XSUB(j)  (1280 + 64 * (j))
#define XB_XGEN(j)  (2304 + 64 * (j))
#define XB_TOP      3328
#define XB_TOPGEN   3392
#define XCD_BAR_WORDS 3456
#define XB_SPIN_CAP (1u << 20)
__device__ __forceinline__ unsigned xb_ld(unsigned* p)              { return __hip_atomic_load(p, __ATOMIC_RELAXED, __HIP_MEMORY_SCOPE_AGENT); }
__device__ __forceinline__ unsigned xb_add(unsigned* p, unsigned v) { return __hip_atomic_fetch_add(p, v, __ATOMIC_RELAXED, __HIP_MEMORY_SCOPE_AGENT); }
__device__ __forceinline__ unsigned xb_xcc_id() { return (unsigned)__builtin_amdgcn_s_getreg((3 << 11) | 20) & 0xFu; }
#define XB_SPIN(cond, bar) do { unsigned _sp = 0; while (cond) { __builtin_amdgcn_s_sleep(1); \
    if ((++_sp & 255u) == 0u) { if (xb_ld(&(bar)[XB_TMO])) break; if (_sp > XB_SPIN_CAP) { atomicAdd(&(bar)[XB_TMO], 1u); break; } } } } while (0)
struct XcdBarrier { unsigned* bar; unsigned x; volatile LAS unsigned* st; unsigned expect; };
__device__ __forceinline__ XcdBarrier xcd_barrier_post(unsigned* bar, volatile LAS unsigned* st, unsigned expect) {
    XcdBarrier b; b.bar = bar; b.x = xb_xcc_id(); b.st = st; b.expect = expect;
    if (threadIdx.x == 0) (void)xb_add(&bar[XB_XCNT(b.x)], 1u);
    return b;
}
__device__ __forceinline__ void xcd_barrier_complete(unsigned* bar, unsigned x, unsigned& nloc, unsigned& nx, const unsigned G) {
    unsigned sum, cnt, mine, sp = 0u;
    for (;;) {
        sum = 0u; cnt = 0u; mine = 0u;
#pragma unroll
        for (unsigned j = 0; j < 16; ++j) { const unsigned c = xb_ld(&bar[XB_XCNT(j)]); sum += c; cnt += (c > 0u) ? 1u : 0u; mine = (j == x) ? c : mine; }
        if (sum == G) break;
        __builtin_amdgcn_s_sleep(1);
        if ((++sp & 255u) == 0u) { if (xb_ld(&bar[XB_TMO])) break; if (sp > XB_SPIN_CAP) { atomicAdd(&bar[XB_TMO], 1u); break; } }
    }
    nloc = mine > 0u ? mine : 1u; nx = cnt > 0u ? cnt : 1u;
}
__device__ __forceinline__ void xcd_barrier(const XcdBarrier& b) {
    asm volatile("s_waitcnt vmcnt(0)" ::: "memory");
    __syncthreads();
    if (threadIdx.x == 0) {
        unsigned* bar = b.bar;
        __builtin_amdgcn_s_waitcnt(0);
        unsigned nloc = b.st[0], nx = b.st[1];
        if (nloc == 0u) { xcd_barrier_complete(bar, b.x, nloc, nx, b.expect); b.st[0] = nloc; b.st[1] = nx; }
        const unsigned old = xb_add(&bar[XB_XSUB(b.x)], 1u);
        const unsigned gen = old / nloc;
        if (old + 1u == (gen + 1u) * nloc) {
            __builtin_amdgcn_fence(__ATOMIC_RELEASE, "agent");
            asm volatile("s_waitcnt vmcnt(0)" ::: "memory");
            const unsigned og = xb_add(&bar[XB_TOP], 1u);
            const unsigned tg = og / nx;
            if (og + 1u == (tg + 1u) * nx) xb_add(&bar[XB_TOPGEN], 1u);
            else XB_SPIN(xb_ld(&bar[XB_TOPGEN]) == tg, bar);
            __builtin_amdgcn_fence(__ATOMIC_ACQUIRE, "agent");
            xb_add(&bar[XB_XGEN(b.x)], 1u);
            asm volatile("s_waitcnt vmcnt(0)" ::: "memory");
        } else {
            XB_SPIN(xb_ld(&bar[XB_XGEN(b.x)]) == gen, bar);
            __builtin_amdgcn_fence(__ATOMIC_ACQUIRE, "agent");
            asm volatile("s_waitcnt vmcnt(0)" ::: "memory");
        }
    }
    __syncthreads();
}

struct Args { const float* in[22]; float* out; unsigned char* ws; int ph_lo, ph_hi, li, pad; };
struct Frame {
    LAS unsigned char* lds;
    int tid, lane, wave, vcu, G;
    int b0, nb;
    float* out; unsigned char* ws;
    __device__ __forceinline__ const float* inp(int i) const { return *(const float* LAS*)(lds + PTR_OFF + 8 * i); }
    __device__ __forceinline__ const float* inp_s(int i) const { const unsigned long long p = (unsigned long long)inp(i);
        return (const float*)(((unsigned long long)(unsigned)__builtin_amdgcn_readfirstlane((int)(p >> 32)) << 32) | (unsigned)__builtin_amdgcn_readfirstlane((int)p)); }
};
enum { I_X = 0, I_C, I_CTX, I_CCTX, I_ADAW, I_ADAB, I_NORMG, I_LAMRE, I_LAMIM, I_LOGSTEP, I_BRE, I_BIM, I_CRE, I_CIM, I_S5D, I_GLUW, I_POOLW, I_POOLS, I_UP, I_CONV, I_CONVB, I_DOWN };

__device__ __forceinline__ float wave_sum(float v) {
    v += __builtin_bit_cast(float, __builtin_amdgcn_update_dpp(0, __builtin_bit_cast(int, v), 0xB1, 0xF, 0xF, false));
    v += __builtin_bit_cast(float, __builtin_amdgcn_update_dpp(0, __builtin_bit_cast(int, v), 0x4E, 0xF, 0xF, false));
    v += __builtin_bit_cast(float, __builtin_amdgcn_update_dpp(0, __builtin_bit_cast(int, v), 0x141, 0xF, 0xF, false));
    v += __builtin_bit_cast(float, __builtin_amdgcn_update_dpp(0, __builtin_bit_cast(int, v), 0x140, 0xF, 0xF, false));
    const int iv = __builtin_bit_cast(int, v);
    const float a = __builtin_bit_cast(float, __builtin_amdgcn_readlane(iv, 0)), b = __builtin_bit_cast(float, __builtin_amdgcn_readlane(iv, 16)),
                c = __builtin_bit_cast(float, __builtin_amdgcn_readlane(iv, 32)), d = __builtin_bit_cast(float, __builtin_amdgcn_readlane(iv, 48));
    return (a + b) + (c + d);
}

__device__ __forceinline__ float wave_max(float v) {
    v = fmaxf(v, __builtin_bit_cast(float, __builtin_amdgcn_update_dpp(0, __builtin_bit_cast(int, v), 0xB1, 0xF, 0xF, false)));
    v = fmaxf(v, __builtin_bit_cast(float, __builtin_amdgcn_update_dpp(0, __builtin_bit_cast(int, v), 0x4E, 0xF, 0xF, false)));
    v = fmaxf(v, __builtin_bit_cast(float, __builtin_amdgcn_update_dpp(0, __builtin_bit_cast(int, v), 0x141, 0xF, 0xF, false)));
    v = fmaxf(v, __builtin_bit_cast(float, __builtin_amdgcn_update_dpp(0, __builtin_bit_cast(int, v), 0x140, 0xF, 0xF, false)));
    const int iv = __builtin_bit_cast(int, v);
    const float a = __builtin_bit_cast(float, __builtin_amdgcn_readlane(iv, 0)), b = __builtin_bit_cast(float, __builtin_amdgcn_readlane(iv, 16)),
                c = __builtin_bit_cast(float, __builtin_amdgcn_readlane(iv, 32)), d = __builtin_bit_cast(float, __builtin_amdgcn_readlane(iv, 48));
    return fmaxf(fmaxf(a, b), fmaxf(c, d));
}
__device__ __forceinline__ unsigned q8x4(f32x4 v, float inv) {
    const float M = 12582912.0f;
    const unsigned a = __builtin_bit_cast(unsigned, __builtin_fmaf(v[0], inv, M)), b = __builtin_bit_cast(unsigned, __builtin_fmaf(v[1], inv, M)),
                   c = __builtin_bit_cast(unsigned, __builtin_fmaf(v[2], inv, M)), d = __builtin_bit_cast(unsigned, __builtin_fmaf(v[3], inv, M));
    return __builtin_amdgcn_perm(b, a, 0x0c0c0400u) | __builtin_amdgcn_perm(d, c, 0x04000c0cu);
}

__device__ __forceinline__ void sincos_d(double x, double& s, double& c) {
    const double q = __builtin_rint(x * 0.63661977236758134308);
    double r = __builtin_fma(-q, 1.57079632679489655800e+00, x); r = __builtin_fma(-q, 6.12323399573676603587e-17, r);
    const int iq = ((int)q) & 3; const double r2 = r * r;
    double sp = 1.0 / 6227020800.0; sp = sp * r2 - 1.0 / 39916800.0; sp = sp * r2 + 1.0 / 362880.0; sp = sp * r2 - 1.0 / 5040.0; sp = sp * r2 + 1.0 / 120.0; sp = sp * r2 - 1.0 / 6.0; sp = sp * r2 + 1.0; sp *= r;
    double cp = -1.0 / 87178291200.0; cp = cp * r2 + 1.0 / 479001600.0; cp = cp * r2 - 1.0 / 3628800.0; cp = cp * r2 + 1.0 / 40320.0; cp = cp * r2 - 1.0 / 720.0; cp = cp * r2 + 1.0 / 24.0; cp = cp * r2 - 0.5; cp = cp * r2 + 1.0;
    s = (iq == 0) ? sp : (iq == 1) ? cp : (iq == 2) ? -sp : -cp;
    c = (iq == 0) ? cp : (iq == 1) ? -sp : (iq == 2) ? -cp : sp;
}
__device__ __forceinline__ double exp_d(double x) {
    const double n = __builtin_rint(x * 1.44269504088896340736);
    double r = __builtin_fma(-n, 6.93147180369123816490e-01, x); r = __builtin_fma(-n, 1.90821492927058770002e-10, r);
    double p = 1.0 / 479001600.0;
    p = p * r + 1.0 / 39916800.0; p = p * r + 1.0 / 3628800.0; p = p * r + 1.0 / 362880.0; p = p * r + 1.0 / 40320.0; p = p * r + 1.0 / 5040.0; p = p * r + 1.0 / 720.0;
    p = p * r + 1.0 / 120.0; p = p * r + 1.0 / 24.0; p = p * r + 1.0 / 6.0; p = p * r + 0.5; p = p * r + 1.0; p = p * r + 1.0;
    return __builtin_ldexp(p, (int)n);
}

struct TrItem { const float* W; bf16* WT; int K, N, mode, item; };
__device__ __forceinline__ void tr_load(const TrItem& d, int lane, float (&v)[64]) {
    const int nblk = d.N / 64, kb = d.item / nblk, nb = d.item % nblk; const float* src = d.W + (size_t)(64 * kb) * d.N + 64 * nb + lane;
#pragma unroll
    for (int i = 0; i < 64; ++i) v[i] = *(const GAS float*)(src + (size_t)i * d.N);
}
__device__ __forceinline__ void tr_finish(const TrItem& d, int lane, const float (&v)[64], LAS unsigned* scr) {
    const int nblk = d.N / 64, kb = d.item / nblk, nb = d.item % nblk, k0 = 64 * kb, n0 = 64 * nb;
#pragma unroll
    for (int i = 0; i < 32; ++i) scr[i * 65 + lane] = pk2(v[2 * i], v[2 * i + 1]);
    LDS_WAIT(); asm volatile("" ::: "memory");
    const int c = lane & 7;
    int r0 = n0;
    if (d.mode == 1) { r0 = (n0 < 2048) ? (256 * (n0 >> 7) + (n0 & 127)) : (256 * ((n0 - 2048) >> 7) + 128 + ((n0 - 2048) & 127)); }
#pragma unroll
    for (int j = 0; j < 8; ++j) { const int n = (lane >> 3) + 8 * j; const LAS unsigned* q = scr + (4 * c) * 65 + n;
        v4u o; o.x = q[0]; o.y = q[65]; o.z = q[130]; o.w = q[195];
        *(GAS v4u*)(d.WT + (size_t)(r0 + n) * d.K + k0 + 8 * c) = o; }
    LDS_WAIT(); asm volatile("" ::: "memory");
}

__device__ __forceinline__ void p0_ada_item(Frame& F, int it) {
    LAS float* cond = (LAS float*)(F.lds);
    LAS float* red = (LAS float*)(F.lds + 24576);
    const int l = it / 384, r = it % 384, s = r / 48, ct = r % 48, k0 = s * 256 + F.wave * 32, n0 = ct * 256;
    const float* W = F.inp(I_ADAW) + (size_t)l * DM * NMODC + (size_t)k0 * NMODC + n0 + 4 * F.lane;
    f32x4 a0 = {0.f, 0.f, 0.f, 0.f}, a1 = a0, a2 = a0;
    f32x4 wv[32];
#pragma unroll
    for (int i = 0; i < 32; ++i) wv[i] = *(const GAS f32x4*)(W + (size_t)i * NMODC);
#pragma unroll
    for (int i = 0; i < 32; ++i) { const float c0 = cond[k0 + i], c1 = cond[2048 + k0 + i], c2 = cond[4096 + k0 + i];
        a0 += wv[i] * c0; a1 += wv[i] * c1; a2 += wv[i] * c2; }
    *(LAS f32x4*)(red + (F.wave * 3 + 0) * 256 + 4 * F.lane) = a0;
    *(LAS f32x4*)(red + (F.wave * 3 + 1) * 256 + 4 * F.lane) = a1;
    *(LAS f32x4*)(red + (F.wave * 3 + 2) * 256 + 4 * F.lane) = a2;
    __syncthreads();
    float* MODP = (float*)(F.ws + WS_MODP);
    for (int o = F.tid; o < 768; o += NTHR) { const int v = o >> 8, col = o & 255; float sum = 0.f;
#pragma unroll
        for (int w = 0; w < 8; ++w) sum += red[(w * 3 + v) * 256 + col];
        MODP[((size_t)(l * 8 + s) * 3 + v) * NMODC + n0 + col] = sum; }
    __syncthreads();
}

__device__ __forceinline__ void p0_s5_item(Frame& F, int g) {
    constexpr int AP = 68;
    LAS float* APR = (LAS float*)(F.lds);
    LAS float* API = APR + 2 * 17 * AP;
    LAS float* BBR = API + 2 * 17 * AP;
    LAS float* BBI = BBR + 2048;
    LAS float* CCR = BBI + 2048;
    LAS float* CCI = CCR + 2048;
    LAS float* CTR = CCI + 2048;
    LAS float* CTI = CTR + 2048;
    LAS float* KT = CTI + 2048;
    LAS float* DSK = KT + 8192;
    LAS double* LD = (LAS double*)(DSK + 16);
    static_assert(((2 * 2 * 17 * AP + 6 * 2048 + 8192 + 16) * 4) % 8 == 0, "LD alignment");
    float bre[4], bim[4], cre[4], cim[4];
#pragma unroll
    for (int i = 0; i < 4; ++i) { const int idx = F.tid + NTHR * i, c = idx & 15, dp = idx >> 4, d = dp >> 6, p = dp & 63;
        const size_t bi = ((size_t)(d * NG + g) * 64 + p) * 16 + c; bre[i] = F.inp(I_BRE)[bi]; bim[i] = F.inp(I_BIM)[bi];
        const int cc = idx >> 6, pp = idx & 63, d2 = cc >> 4, c2 = cc & 15; const size_t ci = ((size_t)(d2 * NG + g) * 16 + c2) * 64 + pp;
        cre[i] = F.inp(I_CRE)[ci]; cim[i] = F.inp(I_CIM)[ci]; }
    if (F.tid < 128) { const int d = F.tid >> 6, p = F.tid & 63;
        const double dt = exp_d((double)F.inp(I_LOGSTEP)[d * NG + g]); const double lr = (double)F.inp(I_LAMRE)[(d * NG + g) * 64 + p], li = (double)F.inp(I_LAMIM)[(d * NG + g) * 64 + p];
        const double mag = exp_d(lr * dt); double sn, cs; sincos_d(li * dt, sn, cs);
        const double nr = mag * cs - 1.0, ni = mag * sn, den = lr * lr + li * li;
        LD[F.tid] = lr * dt; LD[128 + F.tid] = li * dt; LD[256 + F.tid] = (nr * lr + ni * li) / den; LD[384 + F.tid] = (ni * lr - nr * li) / den; }
    if (F.tid < 16) DSK[F.tid] = F.inp(I_S5D)[g * 16 + F.tid];
#pragma unroll
    for (int i = 0; i < 4; ++i) { const int idx = F.tid + NTHR * i, cc = idx >> 6, pp = idx & 63, d2 = cc >> 4, c2 = cc & 15;
        CCR[idx] = cre[i]; CCI[idx] = cim[i]; CTR[(d2 * 64 + pp) * 16 + c2] = cre[i]; CTI[(d2 * 64 + pp) * 16 + c2] = cim[i]; }
    __syncthreads();
    for (int idx = F.tid; idx < 2176; idx += NTHR) { const int p = idx & 63, dk = idx >> 6, d = dk / 17, k = dk % 17;
        const double mag = exp_d((double)k * LD[d * 64 + p]); double sn, cs; sincos_d((double)k * LD[128 + d * 64 + p], sn, cs);
        APR[dk * AP + p] = (float)(mag * cs); API[dk * AP + p] = (float)(mag * sn); }
#pragma unroll
    for (int i = 0; i < 4; ++i) { const int idx = F.tid + NTHR * i, dp = idx >> 4; const double fr = LD[256 + dp], fi = LD[384 + dp], br = (double)bre[i], bm = (double)bim[i];
        BBR[idx] = (float)(fr * br - fi * bm); BBI[idx] = (float)(fr * bm + fi * br); }
    __syncthreads();
    bf16* WIN = (bf16*)(F.ws + WS_WIN) + (size_t)g * 256 * 256;
    for (int q = F.tid; q < 8192; q += NTHR) { const int n = q >> 5, kc = q & 31, d = n >> 7, part = (n >> 6) & 1, p = n & 63, j = kc >> 1, c0 = 8 * (kc & 1);
        const int e = d == 0 ? 15 - j : j; const float ar = APR[(d * 17 + e) * AP + p], ai = API[(d * 17 + e) * AP + p];
        const LAS f32x4* br = (const LAS f32x4*)(BBR + (d * 64 + p) * 16 + c0); const LAS f32x4* bi = (const LAS f32x4*)(BBI + (d * 64 + p) * 16 + c0);
        const f32x4 r0 = br[0], r1 = br[1], i0 = bi[0], i1 = bi[1];
        const f32x4 v0 = part == 0 ? r0 * ar - i0 * ai : i0 * ar + r0 * ai, v1 = part == 0 ? r1 * ar - i1 * ai : i1 * ar + r1 * ai;
        v4u o; o.x = pk2(v0[0], v0[1]); o.y = pk2(v0[2], v0[3]); o.z = pk2(v1[0], v1[1]); o.w = pk2(v1[2], v1[3]);
        *(GAS v4u*)(WIN + (size_t)n * 256 + 8 * kc) = o; }
    { const int cp = F.tid & 15, tau = (F.tid >> 4) & 15, d = F.tid >> 8; f32x4 s0 = {0.f, 0.f, 0.f, 0.f}, s1 = s0, s2 = s0, s3 = s0;
#pragma unroll 4
      for (int p = 0; p < 64; ++p) { const float cr = CTR[(d * 64 + p) * 16 + cp], ci = CTI[(d * 64 + p) * 16 + cp], ar = APR[(d * 17 + tau) * AP + p], ai = API[(d * 17 + tau) * AP + p];
          const float mr = cr * ar - ci * ai, mi = cr * ai + ci * ar; const LAS f32x4* br = (const LAS f32x4*)(BBR + (d * 64 + p) * 16); const LAS f32x4* bi = (const LAS f32x4*)(BBI + (d * 64 + p) * 16);
          s0 += br[0] * mr - bi[0] * mi; s1 += br[1] * mr - bi[1] * mi; s2 += br[2] * mr - bi[2] * mi; s3 += br[3] * mr - bi[3] * mi; }
      LAS f32x4* o = (LAS f32x4*)(KT + ((d * 16 + tau) * 16 + cp) * 16); o[0] = s0; o[1] = s1; o[2] = s2; o[3] = s3; }
    __syncthreads();
    bf16* W2 = (bf16*)(F.ws + WS_W2) + (size_t)g * 256 * 512;
    for (int q = F.tid; q < 8192; q += NTHR) { const int n = q >> 5, kc = q & 31, jp = n >> 4, cp = n & 15;
        const int d = kc >> 4, part = (kc >> 3) & 1, p0 = 8 * (kc & 7), e = d == 0 ? jp + 1 : 16 - jp;
        const LAS f32x4* cr = (const LAS f32x4*)(CCR + (d * 16 + cp) * 64 + p0); const LAS f32x4* ci = (const LAS f32x4*)(CCI + (d * 16 + cp) * 64 + p0);
        const LAS f32x4* ar = (const LAS f32x4*)(APR + (d * 17 + e) * AP + p0); const LAS f32x4* ai = (const LAS f32x4*)(API + (d * 17 + e) * AP + p0);
        const f32x4 cr0 = cr[0], cr1 = cr[1], ci0 = ci[0], ci1 = ci[1], ar0 = ar[0], ar1 = ar[1], ai0 = ai[0], ai1 = ai[1];
        const f32x4 v0 = part == 0 ? cr0 * ar0 - ci0 * ai0 : -(cr0 * ai0 + ci0 * ar0), v1 = part == 0 ? cr1 * ar1 - ci1 * ai1 : -(cr1 * ai1 + ci1 * ar1);
        v4u o; o.x = pk2(v0[0], v0[1]); o.y = pk2(v0[2], v0[3]); o.z = pk2(v1[0], v1[1]); o.w = pk2(v1[2], v1[3]);
        *(GAS v4u*)(W2 + (size_t)n * 512 + 8 * kc) = o; }
    for (int q = F.tid; q < 8192; q += NTHR) { const int n = q >> 5, kc = q & 31, jp = n >> 4, cp = n & 15, j = kc >> 1, c0 = 8 * (kc & 1);
        const int tf = jp - j < 0 ? 0 : jp - j, tb = j - jp < 0 ? 0 : j - jp; const float mf = j <= jp ? 1.0f : 0.0f, mb = j >= jp ? 1.0f : 0.0f;
        const LAS f32x4* kf = (const LAS f32x4*)(KT + ((0 * 16 + tf) * 16 + cp) * 16 + c0); const LAS f32x4* kb = (const LAS f32x4*)(KT + ((1 * 16 + tb) * 16 + cp) * 16 + c0);
        f32x4 v0 = kf[0] * mf + kb[0] * mb, v1 = kf[1] * mf + kb[1] * mb;
        if (j == jp && (cp >> 3) == (kc & 1)) { const float dv = DSK[cp]; const int x = cp & 7;
            if (x < 4) v0[x] += dv; else v1[x - 4] += dv; }
        v4u o; o.x = pk2(v0[0], v0[1]); o.y = pk2(v0[2], v0[3]); o.z = pk2(v1[0], v1[1]); o.w = pk2(v1[2], v1[3]);
        *(GAS v4u*)(W2 + (size_t)n * 512 + 256 + 8 * kc) = o; }
    if (F.tid < 128) { const int d = F.tid >> 6, p = F.tid & 63; float* A16 = (float*)(F.ws + WS_A16) + ((size_t)(d * NG + g) * 64 + p) * 2;
        A16[0] = APR[(d * 17 + 16) * AP + p]; A16[1] = API[(d * 17 + 16) * AP + p]; }
    __syncthreads();
}

__device__ __forceinline__ void p0_s5_tables(Frame& F, int ia, int nA) { for (int g = ia; g < NG; g += nA) p0_s5_item(F, g); }
__device__ __forceinline__ int ada_item_of(int j) {
    if (j < 128) return (j >> 4) * 48 + (j & 15);
    j -= 128; if (j < 384) return 384 + j;
    j -= 384; return (j >> 5) * 48 + 16 + (j & 31);
}
__device__ __forceinline__ void p0_roleA(Frame& F, int ia, int nA, int jlo = 0, int jhi = 768) {
    { LAS float* cond = (LAS float*)(F.lds);
      for (int i = F.tid; i < 3 * DM; i += NTHR) { const float x = i < 2 * DM ? F.inp(I_C)[i] : F.inp(I_CCTX)[i - 2 * DM]; cond[i] = x * sigm(x); }
      __syncthreads();
      for (int j = jlo + ia; j < jhi; j += nA) p0_ada_item(F, ada_item_of(j)); }
    __syncthreads();
}
__device__ __forceinline__ TrItem tr_decode(Frame& F, int part, int it) {
    constexpr int I_G = (DM / 64) * (2 * DM / 64), I_D = (DFF / 64) * (DM / 64), I_P = (512 / 64) * (512 / 64);
    TrItem d;
    if (part == 0) { int r = it;
        if (r < I_G) { d.W = F.inp(I_GLUW); d.WT = (bf16*)(F.ws + WS_WGLU); d.K = DM; d.N = 2 * DM; d.mode = 1; d.item = r; return d; } r -= I_G;
        if (r < I_D) { d.W = F.inp(I_DOWN); d.WT = (bf16*)(F.ws + WS_WDN); d.K = DFF; d.N = DM; d.mode = 0; d.item = r; return d; } r -= I_D;
        const int gi = r / I_P; d.W = F.inp(I_POOLW) + (size_t)gi * 512 * 512; d.WT = (bf16*)(F.ws + WS_WPOOL) + (size_t)gi * 512 * 512; d.K = 512; d.N = 512; d.mode = 0; d.item = r % I_P; return d;
    }
    d.W = F.inp(I_DOWN) + (size_t)DFF * DM; d.WT = (bf16*)(F.ws + WS_WDN) + (size_t)DM * DFF; d.K = DFF; d.N = DM; d.mode = 0; d.item = it; return d;
}
constexpr int TR_I_G = (DM / 64) * (2 * DM / 64), TR_I_D = (DFF / 64) * (DM / 64), TR_I_P = (512 / 64) * (512 / 64);
__device__ __forceinline__ void p0_roleB(Frame& F, int part, int wi, int nw, int lo = 0, int hi = -1) {
    LAS unsigned* scr = (LAS unsigned*)(F.lds + F.wave * 16384);
    const int nit = hi >= 0 ? hi : (part == 0 ? TR_I_G + TR_I_D + 4 * TR_I_P : TR_I_D);
    float va[64], vb[64];
    int it = lo + wi;
    if (it < nit) { TrItem da = tr_decode(F, part, it); tr_load(da, F.lane, va);
        for (;;) {
            const int itb = it + nw; TrItem db = da; const bool hb = itb < nit;
            if (hb) { db = tr_decode(F, part, itb); tr_load(db, F.lane, vb); }
            tr_finish(da, F.lane, va, scr);
            if (!hb) break;
            const int ita = itb + nw; const bool ha = ita < nit;
            if (ha) { da = tr_decode(F, part, ita); tr_load(da, F.lane, va); }
            tr_finish(db, F.lane, vb, scr);
            if (!ha) break;
            it = ita;
        }
    }
    LDS_WAIT(); __syncthreads();
}
__device__ __forceinline__ void flag_arrive(unsigned* word) {
    VM_WAIT(); __syncthreads();
    if (threadIdx.x == 0) { __builtin_amdgcn_fence(__ATOMIC_RELEASE, "agent"); asm volatile("s_waitcnt vmcnt(0)" ::: "memory"); (void)xb_add(word, 1u); }
}
__device__ __forceinline__ void flag_wait(unsigned* word, unsigned expect, unsigned* tmo) {
    if (threadIdx.x == 0) { unsigned sp = 0;
        while (xb_ld(word) < expect) { __builtin_amdgcn_s_sleep(2); if ((++sp & 255u) == 0u) { if (xb_ld(tmo)) break; if (sp > (1u << 22)) { atomicAdd(tmo, 1u); break; } } }
        __builtin_amdgcn_fence(__ATOMIC_ACQUIRE, "agent"); asm volatile("s_waitcnt vmcnt(0)" ::: "memory"); }
    __syncthreads();
}

__device__ __forceinline__ void wqd_item(Frame& F, int l, int item) {
    const float* W = F.inp(I_UP) + (size_t)l * DM * DFF2; unsigned char* Q = F.ws + WS_WUP8 + (size_t)l * DFF2 * DM; float* SW = (float*)(F.ws + WS_SW) + l * DFF2;
    LAS float* red = (LAS float*)(F.lds);
    const int n4 = F.tid & 7, kq = F.tid >> 3, n0 = item * 32 + 4 * n4;
    const float* src = W + (size_t)(8 * kq) * DFF2 + n0;
    f32x4 v[4][2][4];
#pragma unroll
    for (int i = 0; i < 4; ++i)
#pragma unroll
        for (int kk = 0; kk < 2; ++kk)
#pragma unroll
            for (int e = 0; e < 4; ++e) v[i][kk][e] = *(const GAS f32x4*)(src + (size_t)(512 * i + 4 * kk + e) * DFF2);
#pragma unroll
    for (int i = 0; i < 4; ++i)
#pragma unroll
        for (int kk = 0; kk < 2; ++kk) { const f32x4 p0 = v[i][kk][0] + v[i][kk][1], p1 = v[i][kk][0] - v[i][kk][1], p2 = v[i][kk][2] + v[i][kk][3], p3 = v[i][kk][2] - v[i][kk][3];
            v[i][kk][0] = p0 + p2; v[i][kk][1] = p1 + p3; v[i][kk][2] = p0 - p2; v[i][kk][3] = p1 - p3; }
#pragma unroll
    for (int st = 1; st < 4; st <<= 1)
#pragma unroll
        for (int i = 0; i < 4; ++i) if (!(i & st))
#pragma unroll
            for (int kk = 0; kk < 2; ++kk)
#pragma unroll
                for (int e = 0; e < 4; ++e) { const f32x4 a2 = v[i][kk][e], b2 = v[i + st][kk][e]; v[i][kk][e] = a2 + b2; v[i + st][kk][e] = a2 - b2; }
    f32x4 am = {0.f, 0.f, 0.f, 0.f};
#pragma unroll
    for (int i = 0; i < 4; ++i)
#pragma unroll
        for (int kk = 0; kk < 2; ++kk)
#pragma unroll
            for (int e = 0; e < 4; ++e)
#pragma unroll
                for (int c = 0; c < 4; ++c) am[c] = fmaxf(am[c], fabsf(v[i][kk][e][c]));
#pragma unroll
    for (int c = 0; c < 4; ++c) { float x = am[c];
        x = fmaxf(x, __builtin_bit_cast(float, __builtin_amdgcn_update_dpp(0, __builtin_bit_cast(int, x), 0x128, 0xF, 0xF, false)));
        x = fmaxf(x, __builtin_bit_cast(float, __builtin_amdgcn_ds_bpermute((F.lane ^ 16) << 2, __builtin_bit_cast(int, x))));
        x = fmaxf(x, __builtin_bit_cast(float, __builtin_amdgcn_ds_bpermute((F.lane ^ 32) << 2, __builtin_bit_cast(int, x))));
        am[c] = x; }
    if (F.lane < 8) *(LAS f32x4*)(red + F.wave * 32 + 4 * n4) = am;
    __syncthreads();
#pragma unroll
    for (int w = 0; w < 8; ++w) { const f32x4 o = *(const LAS f32x4*)(red + w * 32 + 4 * n4);
#pragma unroll
        for (int c = 0; c < 4; ++c) am[c] = fmaxf(am[c], o[c]); }
    const int r0 = n0 < DFF ? 256 * (n0 >> 7) + (n0 & 127) : 256 * ((n0 - DFF) >> 7) + 128 + ((n0 - DFF) & 127);
    unsigned char* dst = Q + (size_t)r0 * DM + 8 * kq;
#pragma unroll
    for (int c = 0; c < 4; ++c) { const float inv = am[c] > 0.f ? 127.0f / am[c] : 0.f;
#pragma unroll
        for (int i = 0; i < 4; ++i) { v2u o; o.x = q8x4((f32x4){v[i][0][0][c], v[i][0][1][c], v[i][0][2][c], v[i][0][3][c]}, inv); o.y = q8x4((f32x4){v[i][1][0][c], v[i][1][1][c], v[i][1][2][c], v[i][1][3][c]}, inv);
            *(GAS v2u*)(dst + (size_t)c * DM + 512 * i) = o; } }
    if (kq == 0) *(GAS f32x4*)(SW + r0) = am * (1.0f / (127.0f * 16.0f));
    __syncthreads();
}
__device__ __forceinline__ void wqd_rows(Frame& F, int l, int idx, int n) {
    for (int it = idx; it < DFF2 / 32; it += n) { asm volatile("" : "+s"(it)); wqd_item(F, l, (it & 3) * (DFF2 / 128) + (it >> 2)); } }
__device__ __forceinline__ void load_mod(Frame& F, int l, int v, int q, LAS float* dst) {
    *(LAS f32x4*)(dst + 4 * F.tid) = *(const GAS f32x4*)((const float*)(F.ws + WS_FMOD) + (size_t)(l * 3 + v) * NMODC + q * DM + 4 * F.tid);
}
__device__ __forceinline__ void load_mod_sum(Frame& F, int l, int v, int q, LAS float* dst) {
    const float* MODP = (const float*)(F.ws + WS_MODP); const int col = q * DM + 4 * F.tid;
    f32x4 sum = *(const GAS f32x4*)(F.inp(I_ADAB) + l * NMODC + col);
#pragma unroll
    for (int sl = 0; sl < 8; ++sl) sum += *(const GAS f32x4*)(MODP + ((size_t)(l * 8 + sl) * 3 + v) * NMODC + col);
    *(LAS f32x4*)(dst + 4 * F.tid) = sum;
}
__device__ __forceinline__ void mod_finalize(Frame& F, int idx, int n) {
    const float* MODP = (const float*)(F.ws + WS_MODP); float* FM = (float*)(F.ws + WS_FMOD);
    for (int o = idx * NTHR + F.tid; o < 2 * 3 * (NMODC / 4); o += n * NTHR) { const int lv = o / (NMODC / 4), col = (o % (NMODC / 4)) * 4, l = lv / 3, v = lv % 3;
        f32x4 sum = *(const GAS f32x4*)(F.inp(I_ADAB) + l * NMODC + col);
#pragma unroll
        for (int sl = 0; sl < 8; ++sl) sum += *(const GAS f32x4*)(MODP + ((size_t)(l * 8 + sl) * 3 + v) * NMODC + col);
        *(GAS f32x4*)(FM + (size_t)lv * NMODC + col) = sum; }
}

constexpr int STG_PITCH = 4112;
__device__ __forceinline__ void p1_rows(Frame& F) {
    LAS float* shiftL = (LAS float*)(F.lds + 98304);
    LAS float* scaleL = shiftL + 2048;
    LAS unsigned char* stg = F.lds;
    const float* g0 = F.inp(I_NORMG);
    int cur_vec = -1;
    f32x4 vr[2][8];
    auto load_unit = [&](int un) { const int bb = F.b0 + un / 272, rr272 = un % 272; const bool ctx = rr272 >= 256; const int bl = ctx ? rr272 - 256 : rr272;
#pragma unroll
        for (int rr = 0; rr < 2; ++rr) { const int t = bl * 16 + F.wave + 8 * rr;
            const float* src = ctx ? F.inp(I_CTX) + ((size_t)(bb * CTX + t)) * DM : F.inp(I_X) + ((size_t)(bb * SEQ + t)) * DM;
#pragma unroll
            for (int j = 0; j < 8; ++j) vr[rr][j] = *(const GAS f32x4*)(src + 4 * F.lane + 256 * j); } };
    f32x4 gw[8];
#pragma unroll
    for (int j = 0; j < 8; ++j) gw[j] = *(const GAS f32x4*)(g0 + 4 * F.lane + 256 * j);
    if (F.vcu < F.nb * 272) load_unit(F.vcu);
    for (int ui = F.vcu; ui < F.nb * 272; ui += F.G) {
        const int b = F.b0 + ui / 272, r272 = ui % 272; const bool is_ctx = r272 >= 256; const int blk = is_ctx ? r272 - 256 : r272;
        const int vec = is_ctx ? 2 : b;
        if (vec != cur_vec) { __syncthreads(); load_mod_sum(F, 0, vec, 0, shiftL); load_mod_sum(F, 0, vec, 1, scaleL); cur_vec = vec; }
        __syncthreads();
#pragma unroll
        for (int rr = 0; rr < 2; ++rr) { const int row = F.wave + 8 * rr, t = blk * 16 + row;
            f32x4 v[8]; float ss = 0.f;
#pragma unroll
            for (int j = 0; j < 8; ++j) v[j] = vr[rr][j];
            if (!is_ctx) { const float prow = (float)(t >> 6), pcol = (float)(t & 63);
#pragma unroll
                for (int j = 0; j < 8; ++j) { const float pos = j < 4 ? prow : pcol; const bool is_cos = (j & 2) != 0;
#pragma unroll
                    for (int e = 0; e < 4; ++e) { const int i = (4 * F.lane + 256 * j + e) & 511;
                        const float omega = __builtin_amdgcn_exp2f(-(float)i * (13.287712379549449f / 512.0f));
                        const float rev = pos * omega * 0.15915494309189535f;
                        v[j][e] += is_cos ? __builtin_amdgcn_cosf(rev) : __builtin_amdgcn_sinf(rev); } }
            }
#pragma unroll
            for (int j = 0; j < 8; ++j) ss += (v[j][0] * v[j][0] + v[j][1] * v[j][1]) + (v[j][2] * v[j][2] + v[j][3] * v[j][3]);
            const float rstd = 1.0f / sqrtf(wave_sum(ss) * (1.0f / DM) + RMS_EPS);
#pragma unroll
            for (int j = 0; j < 8; ++j) { const int col = 4 * F.lane + 256 * j; const f32x4 gg = gw[j], sc = *(LAS f32x4*)(scaleL + col), sh = *(LAS f32x4*)(shiftL + col);
                const f32x4 u = (v[j] * rstd * gg) * (sc + 1.0f) + sh;
                v2u w; w.x = pk2(u[0], u[1]); w.y = pk2(u[2], u[3]);
                *(LAS v2u*)(stg + row * STG_PITCH + col * 2) = w; } }
        if (ui + F.G < F.nb * 272) load_unit(ui + F.G);
        __syncthreads();
        for (int q = F.tid; q < 4096; q += NTHR) { const int g = q >> 5, jh = q & 31, j = jh >> 1, h = jh & 1;
            const v4u w = *(LAS v4u*)(stg + j * STG_PITCH + g * 32 + h * 16);
            bf16* dst = is_ctx ? (bf16*)(F.ws + WS_UCG) + ((size_t)g * 32 + b * 16 + blk) * 256 + jh * 8
                               : (bf16*)(F.ws + WS_A2) + ((size_t)g * 512 + b * 256 + blk) * 512 + 256 + jh * 8;
            st_wt16u(dst, w); }
    }
    __syncthreads();
}

__device__ __forceinline__ void s5_ctx_carry(Frame& F, int g, int b) {
    const bf16* A = (const bf16*)(F.ws + WS_UCG) + ((size_t)g * 32 + b * 16) * 256; const bf16* Bt = (const bf16*)(F.ws + WS_WIN) + (size_t)g * 256 * 256;
    LAS float* CT = (LAS float*)(F.lds); LAS float* xc = (LAS float*)(F.lds + XCH_OFF);
    const int r = F.lane & 15, q = F.lane >> 4; f32x4 c0 = {0.f, 0.f, 0.f, 0.f}, c1 = c0;
#pragma unroll
    for (int ks = 0; ks < 8; ++ks) { const bf16x8 a = *(const GAS bf16x8*)(A + r * 256 + ks * 32 + 8 * q);
        const bf16x8 b0 = *(const GAS bf16x8*)(Bt + (size_t)(32 * F.wave + r) * 256 + ks * 32 + 8 * q), b1 = *(const GAS bf16x8*)(Bt + (size_t)(32 * F.wave + 16 + r) * 256 + ks * 32 + 8 * q);
        c0 = __builtin_amdgcn_mfma_f32_16x16x32_bf16(a, b0, c0, 0, 0, 0); c1 = __builtin_amdgcn_mfma_f32_16x16x32_bf16(a, b1, c1, 0, 0, 0); }
#pragma unroll
    for (int i = 0; i < 4; ++i) { CT[(4 * q + i) * 256 + 32 * F.wave + r] = c0[i]; CT[(4 * q + i) * 256 + 32 * F.wave + 16 + r] = c1[i]; }
    __syncthreads();
    if (F.tid < 128) { const int d = F.tid >> 6, p = F.tid & 63; const float* a16 = (const float*)(F.ws + WS_A16) + ((size_t)(d * NG + g) * 64 + p) * 2; const float ar = a16[0], ai = a16[1];
        float cr = 0.f, ci = 0.f;
#pragma unroll
        for (int k = 0; k < 16; ++k) { const int row = d == 0 ? k : 15 - k; const float xr = CT[row * 256 + d * 128 + p], xi = CT[row * 256 + d * 128 + 64 + p];
            const float nr = ar * cr - ai * ci + xr, ni = ar * ci + ai * cr + xi; cr = nr; ci = ni; }
        xc[1024 + (d * 64 + p) * 2] = cr; xc[1024 + (d * 64 + p) * 2 + 1] = ci; }
    __syncthreads();
}

template <bool SECOND, bool U8OUT>
__device__ __forceinline__ void row_tail(Frame& F, int row, f32x4 (&y)[8], const f32x4 (&x)[8], LAS float* GGL, LAS float* SCL, LAS float* SHL) {
    float ss = 0.f;
#pragma unroll
    for (int j = 0; j < 8; ++j) ss += (y[j][0] * y[j][0] + y[j][1] * y[j][1]) + (y[j][2] * y[j][2] + y[j][3] * y[j][3]);
    const float ry = 1.0f / sqrtf(wave_sum(ss) * (1.0f / DM) + RMS_EPS);
    float* xrow = F.out + (size_t)row * DM; float s2 = 0.f;
#pragma unroll
    for (int j = 0; j < 8; ++j) { const int col = 4 * F.lane + 256 * j; const f32x4 gg = *(LAS f32x4*)(GGL + col);
        y[j] = x[j] + (y[j] * ry) * gg;
        st_wt16(xrow + col, y[j]);
        s2 += (y[j][0] * y[j][0] + y[j][1] * y[j][1]) + (y[j][2] * y[j][2] + y[j][3] * y[j][3]); }
    if (SECOND) { const float rx = 1.0f / sqrtf(wave_sum(s2) * (1.0f / DM) + RMS_EPS);
        if (U8OUT) {
            float am = 0.f;
#pragma unroll
            for (int j = 0; j < 8; ++j) { const int col = 4 * F.lane + 256 * j; const f32x4 sc = *(LAS f32x4*)(SCL + col), sh = *(LAS f32x4*)(SHL + col);
                y[j] = (y[j] * rx) * sc + sh; }
#pragma unroll
            for (int j = 0; j < 8; ++j) { const f32x4 t = y[j]; const float p0 = t[0] + t[1], p1 = t[0] - t[1], p2 = t[2] + t[3], p3 = t[2] - t[3]; y[j] = (f32x4){p0 + p2, p1 + p3, p0 - p2, p1 - p3}; }
#pragma unroll
            for (int st = 2; st < 8; st <<= 1)
#pragma unroll
                for (int j = 0; j < 8; ++j) if (!(j & st)) { const f32x4 a = y[j], b = y[j + st]; y[j] = a + b; y[j + st] = a - b; }
#pragma unroll
            for (int j = 0; j < 8; ++j) am = fmaxf(am, fmaxf(fmaxf(fabsf(y[j][0]), fabsf(y[j][1])), fmaxf(fabsf(y[j][2]), fabsf(y[j][3]))));
            am = wave_max(am); const float inv = am > 0.f ? 127.0f / am : 0.f;
            unsigned char* U8 = F.ws + WS_U8 + (size_t)row * DM;
#pragma unroll
            for (int j = 0; j < 8; ++j) *(GAS unsigned*)(U8 + 4 * F.lane + 256 * j) = q8x4(y[j], inv);
            if (F.lane == 0) ((float*)(F.ws + WS_SU))[row] = am * (1.0f / 127.0f);
        } else { bf16* U = (bf16*)(F.ws + WS_UZ);
#pragma unroll
            for (int j = 0; j < 8; ++j) { const int col = 4 * F.lane + 256 * j; const f32x4 sc = *(LAS f32x4*)(SCL + col), sh = *(LAS f32x4*)(SHL + col);
                const f32x4 u = (y[j] * rx) * sc + sh; v2u w; w.x = pk2(u[0], u[1]); w.y = pk2(u[2], u[3]);
                st_wt8u(U + (size_t)row * DM + col, w); } } }
}
__device__ __forceinline__ void add_pos(Frame& F, int t, f32x4 (&v)[8]) {
    const float prow = (float)(t >> 6), pcol = (float)(t & 63);
#pragma unroll
    for (int j = 0; j < 8; ++j) { const float pos = j < 4 ? prow : pcol; const bool is_cos = (j & 2) != 0;
#pragma unroll
        for (int e = 0; e < 4; ++e) { const int i = (4 * F.lane + 256 * j + e) & 511;
            const float omega = __builtin_amdgcn_exp2f(-(float)i * (13.287712379549449f / 512.0f));
            const float rev = pos * omega * 0.15915494309189535f;
            v[j][e] += is_cos ? __builtin_amdgcn_cosf(rev) : __builtin_amdgcn_sinf(rev); } }
}
template <int YMODE, bool SECOND, bool U8OUT = false, bool XPOS = false>
__device__ __forceinline__ void row_phase(Frame& F, int l_gate, int q_gate, int ga_idx, int l_mod, int q_shift, int q_scale, int gb_idx, bool xaff = false) {
    LAS float* gateL = (LAS float*)(F.lds);
    LAS float* shiftL = gateL + 2048;
    LAS float* scaleL = shiftL + 2048;
    LAS unsigned char* stg = F.lds + 32768;
    const bf16* Y = (const bf16*)(F.ws + WS_YF);
    const float* ga = F.inp(I_NORMG) + ga_idx * DM; const float* gb = F.inp(I_NORMG) + gb_idx * DM;
    int cur_b = -1;
    for (int rgi = F.vcu; rgi < F.nb * (SEQ / 32); rgi += F.G) { const int rg = F.b0 * (SEQ / 32) + (xaff ? (rgi & 7) * 32 + (rgi >> 3) : rgi), b = rg / (SEQ / 32);
        if (b != cur_b) { __syncthreads(); load_mod(F, l_gate, b, q_gate, gateL); if (SECOND) { load_mod(F, l_mod, b, q_shift, shiftL); load_mod(F, l_mod, b, q_scale, scaleL); }
            { const f32x4 a4 = *(const GAS f32x4*)(ga + 4 * F.tid); *(LAS f32x4*)(gateL + 4 * F.tid) = *(LAS f32x4*)(gateL + 4 * F.tid) * a4;
              if (SECOND) { const f32x4 b4 = *(const GAS f32x4*)(gb + 4 * F.tid); *(LAS f32x4*)(scaleL + 4 * F.tid) = (*(LAS f32x4*)(scaleL + 4 * F.tid) + 1.0f) * b4; } }
            cur_b = b; __syncthreads(); }
        if (YMODE == 0) {
#pragma unroll 1
            for (int pr = 0; pr < 2; ++pr) { const int rowA = rg * 32 + F.wave * 4 + 2 * pr, rowB = rowA + 1;
                v2u wa[8], wb[8]; f32x4 xa[8], xb[8];
#pragma unroll
                for (int j = 0; j < 8; ++j) { wa[j] = *(const GAS v2u*)(Y + (size_t)rowA * DM + 4 * F.lane + 256 * j); wb[j] = *(const GAS v2u*)(Y + (size_t)rowB * DM + 4 * F.lane + 256 * j); }
#pragma unroll
                for (int j = 0; j < 8; ++j) { const float* xs = XPOS ? F.inp(I_X) : F.out; xa[j] = __builtin_nontemporal_load((const GAS f32x4*)(xs + (size_t)rowA * DM + 4 * F.lane + 256 * j)); xb[j] = __builtin_nontemporal_load((const GAS f32x4*)(xs + (size_t)rowB * DM + 4 * F.lane + 256 * j)); }
                f32x4 y[8];
                if (XPOS) add_pos(F, rowA & (SEQ - 1), xa);
#pragma unroll
                for (int j = 0; j < 8; ++j) y[j] = (f32x4){bf_lo(wa[j].x), bf_hi(wa[j].x), bf_lo(wa[j].y), bf_hi(wa[j].y)};
                row_tail<SECOND, U8OUT>(F, rowA, y, xa, gateL, scaleL, shiftL);
                asm volatile("" ::: "memory");
                if (XPOS) add_pos(F, rowB & (SEQ - 1), xb);
#pragma unroll
                for (int j = 0; j < 8; ++j) y[j] = (f32x4){bf_lo(wb[j].x), bf_hi(wb[j].x), bf_lo(wb[j].y), bf_hi(wb[j].y)};
                row_tail<SECOND, U8OUT>(F, rowB, y, xb, gateL, scaleL, shiftL); }
        } else {
#pragma unroll 1
            for (int half = 0; half < 2; ++half) { const int r0 = rg * 32 + half * 16, t0 = r0 & (SEQ - 1);
                __syncthreads();
                const int lrA = F.wave * 2, rowA = r0 + lrA, rowB = rowA + 1;
                {
                    const int hw = 1 << (F.wave >> 1); const bf16* Yb = Y + (size_t)(r0 - t0) * DM + 4 * F.tid;
                    const f32x4 ps = *(const GAS f32x4*)(F.inp(I_POOLS) + 4 * F.tid);
#define LDV(trow) ({ const int _t = (trow); const bool _ok = _t >= 0 && _t < SEQ; const v2u _w = *(const GAS v2u*)(Yb + (size_t)(_ok ? _t : t0) * DM); const float _m = _ok ? 1.0f : 0.0f; \
                      (f32x4){bf_lo(_w.x) * _m, bf_hi(_w.x) * _m, bf_lo(_w.y) * _m, bf_hi(_w.y) * _m}; })
                    f32x4 s = {0.f, 0.f, 0.f, 0.f};
#pragma unroll 2
                    for (int o = -hw; o < hw; ++o) s += LDV(t0 + o);
#pragma unroll 4
                    for (int i = 0; i < 16; ++i) { const int t = t0 + i; const f32x4 self = LDV(t);
                        const int lo = t - hw < 0 ? 0 : t - hw, hi = t + hw - 1 > SEQ - 1 ? SEQ - 1 : t + hw - 1;
                        const f32x4 yv = (s * (1.0f / (float)(hi - lo + 1)) - self) * ps;
                        v2u w; w.x = pk2(yv[0], yv[1]); w.y = pk2(yv[2], yv[3]);
                        *(LAS v2u*)(stg + i * STG_PITCH + 8 * F.tid) = w;
                        s += LDV(t + hw) - LDV(t - hw); }
#undef LDV
                }
                __syncthreads();
                f32x4 xa[8], xb[8];
#pragma unroll
                for (int j = 0; j < 8; ++j) { xa[j] = __builtin_nontemporal_load((const GAS f32x4*)(F.out + (size_t)rowA * DM + 4 * F.lane + 256 * j)); xb[j] = __builtin_nontemporal_load((const GAS f32x4*)(F.out + (size_t)rowB * DM + 4 * F.lane + 256 * j)); }
                f32x4 y[8];
#pragma unroll
                for (int j = 0; j < 8; ++j) { const v2u w = *(LAS v2u*)(stg + lrA * STG_PITCH + 8 * F.lane + 512 * j); y[j] = (f32x4){bf_lo(w.x), bf_hi(w.x), bf_lo(w.y), bf_hi(w.y)}; }
                row_tail<SECOND, U8OUT>(F, rowA, y, xa, gateL, scaleL, shiftL);
#pragma unroll
                for (int j = 0; j < 8; ++j) { const v2u w = *(LAS v2u*)(stg + (lrA + 1) * STG_PITCH + 8 * F.lane + 512 * j); y[j] = (f32x4){bf_lo(w.x), bf_hi(w.x), bf_lo(w.y), bf_hi(w.y)}; }
                row_tail<SECOND, U8OUT>(F, rowB, y, xb, gateL, scaleL, shiftL);
            }
        }
    }
    __syncthreads();
}

__device__ __forceinline__ void conv_fixup(Frame& F, int l, int pm) {
    const float* cw = F.inp(I_CONV) + (size_t)l * 3 * DFF2; const float* PRE = (const float*)(F.ws + WS_PRE); const float* RAW = (const float*)(F.ws + WS_RAW); bf16* ACT = (bf16*)(F.ws + WS_ACT);
    constexpr int NIT = (2 * (DFF / 4) + NTHR - 1) / NTHR;
    f32x4 v[NIT], g[NIT], rv[NIT], rg[NIT], kv[NIT], kg[NIT];
#pragma unroll
    for (int it = 0; it < NIT; ++it) { const int q0 = F.tid + it * NTHR, q = q0 < 2 * (DFF / 4) ? q0 : 0, e = q / (DFF / 4), f = (q % (DFF / 4)) * 4;
        const bool nbok = e == 0 ? (pm & 15) != 0 : (pm & 15) != 15; const int pmn = nbok ? (e == 0 ? pm - 1 : pm + 1) : pm, tap = e == 0 ? 0 : 2;
        v[it] = *(const GAS f32x4*)(PRE + ((size_t)(pm * 2 + e) * 2) * DFF + f); g[it] = *(const GAS f32x4*)(PRE + ((size_t)(pm * 2 + e) * 2 + 1) * DFF + f);
        rv[it] = *(const GAS f32x4*)(RAW + ((size_t)(pmn * 2 + (1 - e)) * 2) * DFF + f); rg[it] = *(const GAS f32x4*)(RAW + ((size_t)(pmn * 2 + (1 - e)) * 2 + 1) * DFF + f);
        kv[it] = *(const GAS f32x4*)(cw + tap * DFF2 + f); kg[it] = *(const GAS f32x4*)(cw + tap * DFF2 + DFF + f); }
#pragma unroll
    for (int it = 0; it < NIT; ++it) { const int q = F.tid + it * NTHR; if (q < 2 * (DFF / 4)) { const int e = q / (DFF / 4), f = (q % (DFF / 4)) * 4;
        const bool nbok = e == 0 ? (pm & 15) != 0 : (pm & 15) != 15; const float m = nbok ? 1.0f : 0.0f;
        const f32x4 vv = v[it] + (kv[it] * m) * rv[it], gg = g[it] + (kg[it] * m) * rg[it];
        v2u w; w.x = pk2(gg[0] * sigm(gg[0]) * vv[0], gg[1] * sigm(gg[1]) * vv[1]); w.y = pk2(gg[2] * sigm(gg[2]) * vv[2], gg[3] * sigm(gg[3]) * vv[3]);
        *(GAS v2u*)(ACT + (size_t)(pm * 256 + (e ? 255 : 0)) * DFF + f) = w; } }
}

constexpr int CW_TMO = 0, CW_XT = 256, CW_GT = 256 + 64 * 16, CW_FLAG = 256 + 64 * 20;
constexpr int CW_PCNT = 16384;
constexpr int CW_BAR = 4096;
static_assert(CW_BAR + 3 * XCD_BAR_WORDS <= CW_PCNT && (CW_PCNT + 3 * 2048) * 4 <= (int)CTL_ZERO_BYTES, "CTL words inside the memset region");
#ifndef DELAY_MASK
#define DELAY_MASK 0
#endif
#ifndef DELAY_GRP
#define DELAY_GRP 3
#endif
__global__ void __launch_bounds__(NTHR, 2) fwd_kernel(Args args) {
    extern __shared__ __attribute__((aligned(16))) unsigned char lds[];
    Frame F;
    F.lds = (LAS unsigned char*)lds;
    F.tid = threadIdx.x; F.lane = F.tid & 63; F.wave = __builtin_amdgcn_readfirstlane(F.tid >> 6);
    F.out = args.out; F.ws = args.ws;
    volatile LAS unsigned* MISC = (volatile LAS unsigned*)(F.lds + MISC_OFF);
    for (int u = F.tid; u < (LDS_BYTES - LDSCTL_OFF) / 4; u += NTHR) ((LAS unsigned*)(F.lds + LDSCTL_OFF))[u] = 0u;
    __syncthreads();
    if (F.tid < 22) *(const float* LAS*)(F.lds + PTR_OFF + 8 * F.tid) = args.in[F.tid];
    unsigned* ctl = (unsigned*)(F.ws + WS_CTL);
    const unsigned G = gridDim.x, xcc = xb_xcc_id(), grp = (xcc >> 2) & 1u;
    if (F.tid == 0) { MISC[12] = xb_add(&ctl[CW_XT + 64 * xcc], 1u); MISC[13] = xb_add(&ctl[CW_GT + 64 * grp], 1u); }
    __syncthreads();
    {
        XcdBarrier barG = xcd_barrier_post(ctl + CW_BAR, MISC + 8, G);
        const int bid = (int)blockIdx.x, nA = G >= 2u ? (int)(G / 2u) : 1, nB = G >= 2u ? (int)G - nA : 1;
        const bool rA = G < 2u || bid < nA, rB = G < 2u || bid >= nA; const int ia = rA ? (G < 2u ? 0 : bid) : 0, ib = rB ? (G < 2u ? 0 : bid - nA) : 0;
        F.b0 = 0; F.nb = NBATCH; F.G = (int)G;
        unsigned* flagP = &ctl[CW_FLAG + 448];
        if (rA) { p0_roleA(F, ia, nA, 0, 128); if (ia < 128) flag_arrive(flagP);
                  p0_roleA(F, ia, nA, 128, 768); p0_roleB(F, 0, ia * NWAVES + F.wave, nA * NWAVES); }
        if (rB) { p0_s5_tables(F, ib, nB); wqd_rows(F, 0, ib, nB); }
        F.vcu = G >= 2u ? (rB ? ib : nB + ia) : 0;
        flag_wait(flagP, (unsigned)(nA < 128 ? nA : 128), &ctl[CW_TMO]);
        p1_rows(F);
        xcd_barrier(barG);
    }
    const unsigned n0 = (unsigned)__builtin_amdgcn_readfirstlane((int)xb_ld(&ctl[CW_GT])), n1 = (unsigned)__builtin_amdgcn_readfirstlane((int)xb_ld(&ctl[CW_GT + 64]));
    bool balanced = (G % 8u) == 0u && n0 == n1;
#pragma unroll
    for (int j = 0; j < 8; ++j) balanced = balanced && ((unsigned)__builtin_amdgcn_readfirstlane((int)xb_ld(&ctl[CW_XT + 64 * j])) == G / 8u);
    const bool two = false && n0 > 0u && n1 > 0u;
    const unsigned lt = (unsigned)__builtin_amdgcn_readfirstlane((int)MISC[12]), gt = (unsigned)__builtin_amdgcn_readfirstlane((int)MISC[13]);
    int nx;
    if (two) { F.b0 = (int)grp; F.nb = 1; F.G = (int)(grp ? n1 : n0); if (balanced) { F.vcu = (int)(lt * 4u + (xcc & 3u)); nx = 4; } else { F.vcu = (int)gt; nx = 1; } }
    else { F.b0 = 0; F.nb = NBATCH; F.G = (int)G; if (balanced) { F.vcu = (int)(lt * 8u + xcc); nx = 8; } else { F.vcu = (int)(grp ? n0 + gt : gt); nx = 1; } }
    F.vcu = __builtin_amdgcn_readfirstlane(F.vcu); F.G = __builtin_amdgcn_readfirstlane(F.G); F.b0 = __builtin_amdgcn_readfirstlane(F.b0); F.nb = __builtin_amdgcn_readfirstlane(F.nb);
    int mode = __builtin_amdgcn_readfirstlane((two ? 1 : 0) | (int)(grp << 1) | (nx << 2));
    (void)xcd_barrier_post(ctl + CW_BAR + (1 + (two ? grp : 0u)) * XCD_BAR_WORDS, MISC + 10, (unsigned)F.G);
    LAS unsigned char* ring = F.lds + RING_OFF;
#define TWO ((mode & 1) != 0)
#define ROLE_A (!(mode & 1) || !(mode & 2))
#define ROLE_B (!(mode & 1) || (mode & 2))
#define NX (mode >> 2)
#define CTL ((unsigned*)(F.ws + WS_CTL))
#define N_GRP(gi) ((unsigned)__builtin_amdgcn_readfirstlane((int)xb_ld(&CTL[CW_GT + 64 * (gi)])))
#define FENCE() do { asm volatile("" : "+v"(F.tid)); F.lane = F.tid & 63; { int _w = F.tid >> 6; asm volatile("" : "+v"(_w)); F.wave = __builtin_amdgcn_readfirstlane(_w); } \
        asm volatile("" : "+s"(F.vcu), "+s"(F.G), "+s"(F.b0), "+s"(F.nb), "+s"(F.ws), "+s"(F.out), "+s"(F.lds), "+s"(mode)); ring = F.lds + RING_OFF; } while (0)
#if DELAY_MASK
#define PH_T0() const unsigned long long _t0 = __builtin_amdgcn_s_memrealtime()
#define PH_DELAY(k) do { if ((((DELAY_MASK) >> (k)) & 1) && (((DELAY_GRP) >> F.b0) & 1)) { asm volatile("s_waitcnt vmcnt(0)" ::: "memory"); __syncthreads(); const unsigned long long _t1 = __builtin_amdgcn_s_memrealtime(); \
        while (__builtin_amdgcn_s_memrealtime() - _t1 < 4ull * (_t1 - _t0)) __builtin_amdgcn_s_sleep(8); __syncthreads(); } } while (0)
#else
#define PH_T0() do {} while (0)
#define PH_DELAY(k) do {} while (0)
#endif
#ifndef TLP
#define TLP 0
#endif
#if TLP
#define TL_PROBE(k) do { if ((k) == TLP && (((DELAY_GRP) >> F.b0) & 1)) { asm volatile("s_waitcnt vmcnt(0)" ::: "memory"); __syncthreads(); const unsigned long long _e = __builtin_amdgcn_s_memrealtime() - tl_start; const unsigned long long _t1 = __builtin_amdgcn_s_memrealtime(); \
        while (__builtin_amdgcn_s_memrealtime() - _t1 < _e) __builtin_amdgcn_s_sleep(8); __syncthreads(); } } while (0)
#else
#define TL_PROBE(k) do {} while (0)
#endif
#define SEAM() do { XcdBarrier _b; _b.bar = CTL + CW_BAR + (1 + (TWO ? ((mode >> 1) & 1) : 0)) * XCD_BAR_WORDS; _b.x = xb_xcc_id(); _b.st = (volatile LAS unsigned*)(F.lds + MISC_OFF) + 10; _b.expect = (unsigned)F.G; xcd_barrier(_b); FENCE(); } while (0)
    FENCE();
#if TLP
    const unsigned long long tl_start = __builtin_amdgcn_s_memrealtime();
#endif

    if (TWO && NX != 4 && ROLE_B) { p0_roleB(F, 1, F.vcu * NWAVES + F.wave, F.G * NWAVES); flag_arrive(&CTL[CW_FLAG + 384]); FENCE(); }
    if (ROLE_A) { mod_finalize(F, F.vcu, F.G); if (TWO) flag_arrive(&CTL[CW_FLAG]); }
    if (TWO && !ROLE_A) flag_wait(&CTL[CW_FLAG], N_GRP(0), &CTL[CW_TMO]);
    TL_PROBE(1);
    { PH_T0();
        for (int it = F.vcu; it < F.nb * NG; it += F.G) { FENCE(); asm volatile("" : "+s"(it)); int gi = it / F.nb, b = F.b0 + it % F.nb;
            if (!TWO && NX == 8 && F.G == 256 && F.nb == 2) {
                const int lt = it >> 3, xc = it & 7;
                gi = ((xc + 8 * (lt >> 3)) << 2) + (lt & 3); b = (lt >> 2) & 1; }
            s5_ctx_carry(F, gi, b);
            { pg8::Gemm g{(const pg8::bf16_t*)(F.ws + WS_A2) + 256, (const pg8::bf16_t*)(F.ws + WS_WIN), 512, 256, 256, (size_t)512 * 512, (size_t)256 * 256};
              pg8::OneUnit S; S.u.pm = b; S.u.pn = 0; S.u.g = gi;
              pg8::EpiScan E{(const float*)(F.ws + WS_A16), (pg8::bf16_t*)(F.ws + WS_A2), (PG8_LAS float*)(F.lds + XCH_OFF)};
              pg8::gemm_phase<pg8::EpiScan, pg8::OneUnit, false, true>(ring, g, S, E, F.tid); }
            VM_WAIT(); __syncthreads(); FENCE();
            { pg8::Gemm g{(const pg8::bf16_t*)(F.ws + WS_A2), (const pg8::bf16_t*)(F.ws + WS_W2), 512, 512, 512, (size_t)512 * 512, (size_t)256 * 512};
              pg8::OneUnit S; S.u.pm = b; S.u.pn = 0; S.u.g = gi;
              pg8::EpiGeluZ E{(pg8::bf16_t*)(F.ws + WS_UZ)};
              pg8::gemm_phase<pg8::EpiGeluZ, pg8::OneUnit, true, true>(ring, g, S, E, F.tid); }
        }
        PH_DELAY(2);
    }
    SEAM();
    TL_PROBE(2);
    { PH_T0();
        pg8::Gemm g{(const pg8::bf16_t*)(F.ws + WS_UZ), (const pg8::bf16_t*)(F.ws + WS_WGLU), DM, DM, DM, 0, 0};
        pg8::StaticOrder S; S.init(F.nb * SEQ, 2 * DM, F.G, F.vcu, F.b0 * (SEQ / 256), NX);
        pg8::EpiGlu E{(pg8::bf16_t*)(F.ws + WS_YF), DM};
        pg8::gemm_phase<pg8::EpiGlu, pg8::StaticOrder, true, true>(ring, g, S, E, F.tid);
        PH_DELAY(5);
    } SEAM();
    #ifndef SKIP_P6
    { PH_T0(); row_phase<0, true, true, true>(F, 0, 2, 1, 0, 3, 4, 2, !TWO && NX == 8 && F.G == 256 && F.nb == 2); PH_DELAY(6); }
#endif
    SEAM();
    for (int l = 0; l < 2; ++l) {
        const int pb = l == 0 ? 7 : 13;
        if (l == 1 && TWO) { if (NX == 4) flag_wait(&CTL[CW_FLAG + 128], gridDim.x, &CTL[CW_TMO]); else if (!ROLE_B) flag_wait(&CTL[CW_FLAG + 128], N_GRP(1), &CTL[CW_TMO]); FENCE(); }
        TL_PROBE(l == 0 ? 3 : 5);
        { PH_T0();
            pg8::Gemm g{(const pg8::bf16_t*)(F.ws + WS_U8), (const pg8::bf16_t*)(F.ws + WS_WUP8) + (size_t)l * DFF2 * (DM / 2), DM / 2, DM / 2, DM / 2, 0, 0};
            pg8::StaticOrder S; S.init(F.nb * SEQ, DFF2, F.G, F.vcu, F.b0 * (SEQ / 256), NX);
            pg8::EpiConvGlu E{(pg8::bf16_t*)(F.ws + WS_ACT), F.inp_s(I_CONV) + (size_t)l * 3 * DFF2, F.inp_s(I_CONVB) + (size_t)l * DFF2, (float*)(F.ws + WS_PRE), (float*)(F.ws + WS_RAW), (PG8_LAS float*)(F.lds + XCH_OFF),
                              (const float*)(F.ws + WS_SU), (const float*)(F.ws + WS_SW) + l * DFF2};
            pg8::gemm_phase<pg8::EpiConvGlu, pg8::StaticOrder, true, true>(ring, g, S, E, F.tid);
            FENCE();
            if (!TWO || NX == 4) {
                const int nwg = F.nb * (SEQ / 256) * (DFF2 / 256), rem = nwg % F.G, nidle = rem == 0 ? F.G : F.G - rem, idx = rem == 0 ? F.vcu : F.vcu - rem;
                if (idx >= 0) { const int gsel = TWO ? ((mode >> 1) & 1) : 0, ngrp = TWO ? 2 : 1;
                    if (l == 0) wqd_rows(F, 1, gsel * nidle + idx, ngrp * nidle);
                    else p0_roleB(F, 1, (gsel * nidle + idx) * NWAVES + F.wave, ngrp * nidle * NWAVES); }
                if (TWO) flag_arrive(&CTL[CW_FLAG + (l == 0 ? 128 : 384)]);
            }
            PH_DELAY(pb);
        } SEAM();
        if (l == 1 && TWO && NX == 4) { flag_wait(&CTL[CW_FLAG + 384], gridDim.x, &CTL[CW_TMO]); FENCE(); }
        const bool fuse = F.nb * (SEQ / 256) * (DM / 256) == F.G;
        TL_PROBE(l == 0 ? 4 : 6);
        { PH_T0();
            pg8::Gemm g{(const pg8::bf16_t*)(F.ws + WS_ACT), (const pg8::bf16_t*)(F.ws + WS_WDN) + (size_t)l * DM * DFF, DFF, DFF, DFF, 0, 0};
            pg8::StaticOrder S; S.init(F.nb * SEQ, DM, F.G, F.vcu, F.b0 * (SEQ / 256), NX);
            { pg8::Unit uu; for (int i = 0; S.next(i, uu); ++i) conv_fixup(F, l, uu.pm); VM_WAIT(); __syncthreads(); }
            if (fuse) {
                if (l == 0) { pg8::EpiRms<true> E{F.out, (const float*)(F.ws + WS_FMOD), F.inp_s(I_NORMG), (pg8::bf16_t*)(F.ws + WS_UZ), (float*)(F.ws + WS_XS), CTL + CW_PCNT, CTL + CW_TMO, 0, 5, 3, 1, 0, 1, 4, 0};
                    pg8::gemm_phase<pg8::EpiRms<true>, pg8::StaticOrder, false, true>(ring, g, S, E, F.tid); }
                else { pg8::EpiRms<false> E{F.out, (const float*)(F.ws + WS_FMOD), F.inp_s(I_NORMG), (pg8::bf16_t*)(F.ws + WS_UZ), (float*)(F.ws + WS_XS), CTL + CW_PCNT, CTL + CW_TMO, 1, 5, 7, 0, 0, 0, 0, 2};
                    pg8::gemm_phase<pg8::EpiRms<false>, pg8::StaticOrder, false, true>(ring, g, S, E, F.tid); }
            } else {
                pg8::EpiBf16G E{(pg8::bf16_t*)(F.ws + WS_YF), DM, 0};
                pg8::gemm_phase<pg8::EpiBf16G, pg8::StaticOrder, true, true>(ring, g, S, E, F.tid);
            }
            PH_DELAY(pb + 2);
        }
        if (l == 0) {
            SEAM();
            if (!fuse) { { PH_T0(); row_phase<0, true>(F, 0, 5, 3, 1, 0, 1, 4); PH_DELAY(10); } SEAM(); }
            { PH_T0();
                pg8::Gemm g{(const pg8::bf16_t*)(F.ws + WS_UZ), (const pg8::bf16_t*)(F.ws + WS_WPOOL), DM, 512, 512, (size_t)512, (size_t)512 * 512};
                pg8::GroupedOrder S; S.init(4, F.nb * (SEQ / 256), 2, F.G, F.vcu, F.b0 * (SEQ / 256));
                pg8::EpiBf16G E{(pg8::bf16_t*)(F.ws + WS_YF), DM, (size_t)512};
                pg8::gemm_phase<pg8::EpiBf16G, pg8::GroupedOrder, true, true>(ring, g, S, E, F.tid);
                PH_DELAY(11);
            } SEAM();
            { PH_T0(); row_phase<1, true, true>(F, 1, 2, 5, 1, 3, 4, 6, !TWO && NX == 8 && F.G == 256 && F.nb == 2);
              PH_DELAY(12); }
            SEAM();
        } else {
            if (!fuse) { SEAM(); { PH_T0(); row_phase<0, false>(F, 1, 5, 7, 0, 0, 0, 0); PH_DELAY(16); } }
        }
    }
    TL_PROBE(7);
#undef SEAM
}

extern "C" void kernel_launch(void* const* d_in, const int* in_sizes, int n_in, void* d_out, int out_size, void* d_ws, size_t ws_size, hipStream_t stream) {
    static int grid = 0;
    if (grid == 0) {
        if (n_in != 22 || out_size != MT * DM || ws_size < WS_END) { fprintf(stderr, "kernel_launch: unexpected problem (n_in %d, out %d, ws %zu); nothing launched\n", n_in, out_size, ws_size); grid = -1; return; }
        int dev = 0, cus = 0, per_cu = 0;
        if (hipGetDevice(&dev) != hipSuccess || hipDeviceGetAttribute(&cus, hipDeviceAttributeMultiprocessorCount, dev) != hipSuccess) { grid = -1; return; }
        if (hipFuncSetAttribute((const void*)fwd_kernel, hipFuncAttributeMaxDynamicSharedMemorySize, LDS_BYTES) != hipSuccess) { fprintf(stderr, "kernel_launch: hipFuncSetAttribute failed\n"); grid = -1; return; }
        if (hipOccupancyMaxActiveBlocksPerMultiprocessor(&per_cu, (const void*)fwd_kernel, NTHR, LDS_BYTES) != hipSuccess || per_cu < 1) { fprintf(stderr, "kernel_launch: the occupancy query admits %d workgroups per CU for this kernel; nothing launched\n", per_cu); (void)hipGetLastError(); grid = -1; return; }
        (void)hipGetLastError();
        grid = cus;
    }
    if (grid < 0) return;
    if (hipMemsetAsync((char*)d_ws + WS_CTL, 0, CTL_ZERO_BYTES, stream) != hipSuccess) { fprintf(stderr, "kernel_launch: hipMemsetAsync failed\n"); return; }
    Args a{};
    for (int i = 0; i < 22; ++i) a.in[i] = (const float*)d_in[i];
    a.out = (float*)d_out; a.ws = (unsigned char*)d_ws;
    hipLaunchKernelGGL(fwd_kernel, dim3(grid), dim3(NTHR), LDS_BYTES, stream, a);
    const hipError_t le = hipPeekAtLastError();
    if (le != hipSuccess) fprintf(stderr, "kernel_launch: launch failed: %s\n", hipGetErrorName(le));
}
```
